# Optimizing an MI355X kernel written in HIP

```python
import jax, jax.numpy as jnp
from jax import lax
import numpy as np

D_MODEL = 2048
BATCH = 2
SEQ = 4096
DEPTH = 4

GRID_W = 64
CTX_LEN = 256
EPS = 1e-6

D_MIX = D_MODEL
GLA_HEADS = 4
GLA_DK = 128
GLA_DV = 128
GLA_W = GLA_HEADS * GLA_DV
GLA_GATE_RANK = 16
GLA_GATE_NORM = 16.0
GLA_CHUNK = 64
CONF_W = 512
CONF_KERNEL = 31
SC_W = 512
SC_KERNEL = 3
MLA_HEADS = 4
MLA_NOPE = 128
MLA_ROPE = 64
MLA_V = 128
MLA_W = MLA_HEADS * MLA_V
MLA_Q_RANK = 384
MLA_KV_RANK = 128
Q_BLOCK = 128
AXIS_DIM = MLA_ROPE // 2
ROPE_FREQS = AXIS_DIM // 2
ROPE_BASE = 10000.0
D_FF = -(-8 * D_MODEL // (3 * 256)) * 256

IN_SIZES = (GLA_HEADS * GLA_DK, GLA_HEADS * GLA_DK, GLA_W, GLA_W, GLA_GATE_RANK, GLA_GATE_RANK,
            CONF_W, CONF_W,
            SC_W, SC_W, SC_W,
            MLA_Q_RANK, MLA_KV_RANK, MLA_ROPE)
IN_W = sum(IN_SIZES)
IN_SPLITS = tuple(int(s) for s in np.cumsum(IN_SIZES)[:-1])

kernel_name = "hybrid_parallel_heads_dit_trunk"


def rms_norm(x, g):
    xf = x.astype(jnp.float32)
    y = xf * lax.rsqrt(jnp.mean(xf * xf, axis=-1, keepdims=True) + EPS)
    return (y * g.astype(jnp.float32)).astype(x.dtype)


def layer_norm(x, g, b):
    xf = x.astype(jnp.float32)
    mu = jnp.mean(xf, axis=-1, keepdims=True)
    xc = xf - mu
    y = xc * lax.rsqrt(jnp.mean(xc * xc, axis=-1, keepdims=True) + EPS)
    return (y * g.astype(jnp.float32) + b.astype(jnp.float32)).astype(x.dtype)


def depthwise_conv(u, w):
    return lax.conv_general_dilated(u, w[:, None, :].astype(u.dtype), window_strides=(1,), padding='SAME',
                                    dimension_numbers=('NWC', 'WIO', 'NWC'),
                                    feature_group_count=u.shape[-1])


def to_heads(t, d):
    return jnp.swapaxes(t.reshape(t.shape[0], t.shape[1], -1, d), 1, 2)


def rope_tables(L):
    rows = L // GRID_W
    row = jnp.repeat(jnp.arange(rows, dtype=jnp.float32), GRID_W)
    col = jnp.tile(jnp.arange(GRID_W, dtype=jnp.float32), rows)
    inv = ROPE_BASE ** (-jnp.arange(ROPE_FREQS, dtype=jnp.float32) * 2.0 / AXIS_DIM)
    ang = jnp.stack([row[:, None] * inv, col[:, None] * inv], axis=1)
    return jnp.cos(ang), jnp.sin(ang)


def apply_rope(t, cos, sin):
    tr = t.reshape(t.shape[:-1] + (2, 2, ROPE_FREQS)).astype(jnp.float32)
    t1, t2 = tr[..., 0, :], tr[..., 1, :]
    out = jnp.stack([t1 * cos - t2 * sin, t2 * cos + t1 * sin], axis=-2)
    return out.reshape(t.shape).astype(t.dtype)


def gla_chunked(q, k, v, logd, s0):
    q, k, v, logd = (t.astype(jnp.float32) for t in (q, k, v, logd))
    b_, h_, L, _ = q.shape
    n = L // GLA_CHUNK

    def chunks(t):
        return jnp.moveaxis(t.reshape(b_, h_, n, GLA_CHUNK, t.shape[-1]), 2, 0)

    idx = jnp.arange(GLA_CHUNK)
    lower = (idx[:, None] >= idx[None, :])[..., None]

    def step(s, inp):
        qi, ki, vi, gi = inp
        bcum = jnp.cumsum(gi, axis=2)
        o_inter = jnp.einsum('bhcd,bhde->bhce', qi * jnp.exp(bcum), s)
        diff = bcum[:, :, :, None, :] - bcum[:, :, None, :, :]
        decay = jnp.where(lower, jnp.exp(jnp.minimum(diff, 0.0)), 0.0)
        scores = jnp.einsum('bhid,bhjd,bhijd->bhij', qi, ki, decay)
        o_intra = jnp.einsum('bhij,bhje->bhie', scores, vi)
        blast = bcum[:, :, -1:, :]
        s_new = jnp.exp(blast[:, :, 0, :])[..., None] * s + jnp.einsum(
            'bhcd,bhce->bhde', ki * jnp.exp(blast - bcum), vi)
        return s_new, o_inter + o_intra

    s_fin, oc = lax.scan(step, s0.astype(jnp.float32), (chunks(q), chunks(k), chunks(v), chunks(logd)))
    return jnp.moveaxis(oc, 0, 2).reshape(b_, h_, L, -1), s_fin


def gla_mixer(zc, zl, fg_up, fg_b, onorm_g, need_ctx):
    def prep(z):
        q, k, v, g, lr_f, lr_b = z
        q = to_heads(q, GLA_DK) * (GLA_DK ** -0.5)
        lds = [to_heads(jax.nn.log_sigmoid((lr @ fg_up[d] + fg_b[d]).astype(jnp.float32)) / GLA_GATE_NORM,
                        GLA_DK) for d, lr in enumerate((lr_f, lr_b))]
        return q, to_heads(k, GLA_DK), to_heads(v, GLA_DV), g, lds

    qc, kc, vc, gc, ldc = prep(zc)
    ql, kl, vl, gl, ldl = prep(zl)
    flip = lambda t: jnp.flip(t, axis=2)
    zero = jnp.zeros(qc.shape[:2] + (GLA_DK, GLA_DV), jnp.float32)
    oc_f, s_cf = gla_chunked(qc, kc, vc, ldc[0], zero)
    ol_f, _ = gla_chunked(ql, kl, vl, ldl[0], s_cf)
    oc_b, s_cb = gla_chunked(flip(qc), flip(kc), flip(vc), flip(ldc[1]), zero)
    ol_b, _ = gla_chunked(flip(ql), flip(kl), flip(vl), flip(ldl[1]), s_cb)

    def finish(o, g):
        o = rms_norm(o, onorm_g)
        o = jnp.swapaxes(o, 1, 2).reshape(g.shape[0], g.shape[1], GLA_W)
        return (o * jax.nn.silu(g.astype(jnp.float32))).astype(g.dtype)

    out_l = finish(ol_f + flip(ol_b), gl)
    out_c = finish(oc_f + flip(oc_b), gc) if need_ctx else None
    return out_c, out_l


def conformer_conv(a, gate, dw, dw_b, ln_g, ln_b):
    u = a * jax.nn.sigmoid(gate)
    u = depthwise_conv(u, dw) + dw_b
    return jax.nn.silu(layer_norm(u, ln_g, ln_b))


def short_conv(bg, cg, h, dw):
    return bg * depthwise_conv(cg * h, dw)


def block_attention(qn, qr, kn, kr, v):
    b_, lq, h_, _ = qn.shape
    nb = lq // Q_BLOCK
    scale = (MLA_NOPE + MLA_ROPE) ** -0.5

    def blk(args):
        qn_b, qr_b = args
        s = jnp.einsum('bqhd,bkhd->bhqk', qn_b, kn) + jnp.einsum('bqhr,bkr->bhqk', qr_b, kr)
        p = jax.nn.softmax(s.astype(jnp.float32) * scale, axis=-1).astype(v.dtype)
        return jnp.einsum('bhqk,bkhd->bqhd', p, v)

    split = lambda t: jnp.moveaxis(t.reshape(b_, nb, Q_BLOCK, h_, t.shape[-1]), 1, 0)
    out = lax.map(blk, (split(qn), split(qr)))
    return jnp.moveaxis(out, 0, 1).reshape(b_, lq, h_ * MLA_V)


def mla_mixer(zc, zl, q_norm_g, kv_norm_g, w_uq, w_ukv, cos, sin, need_ctx):
    def project(z):
        cq, ckv, kr = z
        b_, n = cq.shape[:2]
        q = (rms_norm(cq, q_norm_g) @ w_uq).reshape(b_, n, MLA_HEADS, MLA_NOPE + MLA_ROPE)
        kv = (rms_norm(ckv, kv_norm_g) @ w_ukv).reshape(b_, n, MLA_HEADS, MLA_NOPE + MLA_V)
        return q[..., :MLA_NOPE], q[..., MLA_NOPE:], kv[..., :MLA_NOPE], kr, kv[..., MLA_NOPE:]

    qn_c, qr_c, kn_c, kr_c, v_c = project(zc)
    qn_l, qr_l, kn_l, kr_l, v_l = project(zl)
    qr_l = apply_rope(qr_l, cos[:, None], sin[:, None])
    kr_l = apply_rope(kr_l, cos, sin)
    out_l = block_attention(qn_l, qr_l, jnp.concatenate([kn_c, kn_l], axis=1),
                            jnp.concatenate([kr_c, kr_l], axis=1), jnp.concatenate([v_c, v_l], axis=1))
    out_c = block_attention(qn_c, qr_c, kn_c, kr_c, v_c) if need_ctx else None
    return out_c, out_l


def swiglu(h, w1, w3, w2):
    return (jax.nn.silu(h @ w1) * (h @ w3)) @ w2


def trunk_layer(x, ctx, mod_l, mod_c, p, cos, sin, need_ctx):
    sh1, sc1, g1, sh2, sc2, g2 = jnp.split(mod_l[:, None, :], 6, axis=-1)
    csh1, csc1, cg1, csh2, csc2, cg2 = jnp.split(mod_c, 6, axis=-1)
    n_ctx = ctx.shape[1]
    hl = rms_norm(x, p['norm1_g']) * (1 + sc1) + sh1
    hc = rms_norm(ctx, p['norm1_g']) * (1 + csc1) + csh1
    z = jnp.concatenate([hc, hl], axis=1) @ p['w_in']
    zc = jnp.split(z[:, :n_ctx], IN_SPLITS, axis=-1)
    zl = jnp.split(z[:, n_ctx:], IN_SPLITS, axis=-1)

    gla_c, gla_l = gla_mixer(zc[0:6], zl[0:6], p['gla_fg_up'], p['gla_fg_b'], p['gla_onorm_g'], need_ctx)
    conf = lambda zz: conformer_conv(zz[6], zz[7], p['conf_dw'], p['conf_dw_b'], p['conf_ln_g'], p['conf_ln_b'])
    sconv = lambda zz: short_conv(zz[8], zz[9], zz[10], p['sc_dw'])
    mla_c, mla_l = mla_mixer(zc[11:14], zl[11:14], p['mla_q_norm_g'], p['mla_kv_norm_g'],
                             p['mla_w_uq'], p['mla_w_ukv'], cos, sin, need_ctx)

    o_l = jnp.concatenate([gla_l, conf(zl), sconv(zl), mla_l], axis=-1) @ p['w_out']
    x = x + g1 * o_l
    x = x + g2 * swiglu(rms_norm(x, p['norm2_g']) * (1 + sc2) + sh2, p['ffn_w1'], p['ffn_w3'], p['ffn_w2'])
    if need_ctx:
        o_c = jnp.concatenate([gla_c, conf(zc), sconv(zc), mla_c], axis=-1) @ p['w_out']
        ctx = ctx + cg1 * o_c
        ctx = ctx + cg2 * swiglu(rms_norm(ctx, p['norm2_g']) * (1 + csc2) + csh2,
                                 p['ffn_w1'], p['ffn_w3'], p['ffn_w2'])
    return x, ctx


def setup_inputs(seed: int = 0) -> dict:
    key = jax.random.key(seed)
    ks = iter(jax.random.split(key, 32))
    D = D_MODEL
    nrm = lambda shape, scale: jax.random.normal(next(ks), shape, jnp.float32) * scale
    gain = lambda shape: 1.0 + nrm(shape, 0.05)
    return {
        "x": nrm((BATCH, SEQ, D), 1.0),
        "c": nrm((BATCH, D), 1.0),
        "ctx": nrm((BATCH, CTX_LEN, D), 1.0),
        "c_ctx": nrm((D,), 1.0),
        "norm1_g": gain((DEPTH, D)),
        "w_mod": nrm((DEPTH, D, 6 * D), 0.5 * D ** -0.5),
        "b_mod": nrm((DEPTH, 6 * D), 0.02),
        "w_in": nrm((DEPTH, D, IN_W), D ** -0.5),
        "gla_fg_up": nrm((DEPTH, 2, GLA_GATE_RANK, GLA_HEADS * GLA_DK), GLA_GATE_RANK ** -0.5),
        "gla_fg_b": nrm((DEPTH, 2, GLA_HEADS * GLA_DK), 0.1),
        "gla_onorm_g": gain((DEPTH, GLA_DV)),
        "conf_dw": nrm((DEPTH, CONF_KERNEL, CONF_W), CONF_KERNEL ** -0.5),
        "conf_dw_b": nrm((DEPTH, CONF_W), 0.02),
        "conf_ln_g": gain((DEPTH, CONF_W)),
        "conf_ln_b": nrm((DEPTH, CONF_W), 0.02),
        "sc_dw": nrm((DEPTH, SC_KERNEL, SC_W), SC_KERNEL ** -0.5),
        "mla_q_norm_g": gain((DEPTH, MLA_Q_RANK)),
        "mla_kv_norm_g": gain((DEPTH, MLA_KV_RANK)),
        "mla_w_uq": nrm((DEPTH, MLA_Q_RANK, MLA_HEADS * (MLA_NOPE + MLA_ROPE)), MLA_Q_RANK ** -0.5),
        "mla_w_ukv": nrm((DEPTH, MLA_KV_RANK, MLA_HEADS * (MLA_NOPE + MLA_V)), MLA_KV_RANK ** -0.5),
        "w_out": nrm((DEPTH, D_MIX, D), D_MIX ** -0.5),
        "norm2_g": gain((DEPTH, D)),
        "ffn_w1": nrm((DEPTH, D, D_FF), D ** -0.5),
        "ffn_w3": nrm((DEPTH, D, D_FF), D ** -0.5),
        "ffn_w2": nrm((DEPTH, D_FF, D), D_FF ** -0.5),
        "final_norm_g": gain((D,)),
    }


def reference(x, c, ctx, c_ctx, norm1_g, w_mod, b_mod, w_in, gla_fg_up, gla_fg_b, gla_onorm_g,
              conf_dw, conf_dw_b, conf_ln_g, conf_ln_b, sc_dw, mla_q_norm_g, mla_kv_norm_g,
              mla_w_uq, mla_w_ukv, w_out, norm2_g, ffn_w1, ffn_w3, ffn_w2, final_norm_g):
    cos, sin = rope_tables(x.shape[1])
    c_act = jax.nn.silu(c)
    cc_act = jax.nn.silu(c_ctx)
    for i in range(DEPTH):
        mod_l = c_act @ w_mod[i] + b_mod[i]
        mod_c = cc_act @ w_mod[i] + b_mod[i]
        p = dict(norm1_g=norm1_g[i], w_in=w_in[i], gla_fg_up=gla_fg_up[i], gla_fg_b=gla_fg_b[i],
                 gla_onorm_g=gla_onorm_g[i], conf_dw=conf_dw[i], conf_dw_b=conf_dw_b[i],
                 conf_ln_g=conf_ln_g[i], conf_ln_b=conf_ln_b[i], sc_dw=sc_dw[i],
                 mla_q_norm_g=mla_q_norm_g[i], mla_kv_norm_g=mla_kv_norm_g[i], mla_w_uq=mla_w_uq[i],
                 mla_w_ukv=mla_w_ukv[i], w_out=w_out[i], norm2_g=norm2_g[i], ffn_w1=ffn_w1[i],
                 ffn_w3=ffn_w3[i], ffn_w2=ffn_w2[i])
        x, ctx = trunk_layer(x, ctx, mod_l, mod_c, p, cos, sin, need_ctx=(i < DEPTH - 1))
    return rms_norm(x, final_norm_g)
```

```cpp
#include <hip/hip_runtime.h>
#include <cstdio>
#include <cstdint>

#ifndef MK_MULTI
#define MK_MULTI 1
#endif

#ifndef PH_MASK
#define PH_MASK 0xFFFFFFFFu
#endif
#define PHM(b) ((PH_MASK >> (b)) & 1u)
#define LAS __attribute__((address_space(3)))
#define GAS __attribute__((address_space(1)))
typedef unsigned short bf16_t;
typedef short bf16x8 __attribute__((ext_vector_type(8)));
typedef short s16x4 __attribute__((ext_vector_type(4)));
typedef float f32x4 __attribute__((ext_vector_type(4)));
typedef float f32x2 __attribute__((ext_vector_type(2)));
typedef float f32x16 __attribute__((ext_vector_type(16)));
typedef unsigned u32x4 __attribute__((ext_vector_type(4)));
typedef unsigned u32x2 __attribute__((ext_vector_type(2)));

constexpr int DM = 2048, NB = 2, SEQ = 4096, CTX = 256, DEPTH = 4, DFF = 5632;
constexpr int ML = NB * SEQ, MC = NB * CTX, MT = ML + MC;
constexpr int INW = 5216, INWP = 5376;
constexpr int ZQ = 0, ZK = 512, ZV = 1024, ZG = 1536, ZLR = 2048, ZCA = 2080, ZCG = 2592, ZSB = 3104, ZSC = 3616, ZSH = 4128, ZCQ = 4640, ZCKV = 5024, ZKR = 5152;
constexpr int NUP = 1792, KUP = 512;
constexpr int NCH = 68;
constexpr float EPS = 1e-6f;

constexpr size_t al256(size_t x) { return (x + 255) / 256 * 256; }
constexpr size_t WS_CTL = 0, CTL_BYTES = 1u << 20;
constexpr size_t WS_ROPE = WS_CTL + CTL_BYTES;
constexpr size_t WS_MODP = WS_ROPE + 8192;
constexpr size_t WS_MODV = WS_MODP + al256((size_t)8 * 4 * 3 * 12288 * 4);
constexpr size_t WS_RSTAT = WS_MODV + al256((size_t)4 * 3 * 6 * 2048 * 4);
constexpr size_t WS_WIN = WS_RSTAT + al256((size_t)4 * MT * 2 * 4);
constexpr size_t WS_WOUT = WS_WIN + (size_t)4 * INWP * DM * 2;
constexpr size_t WS_W13 = WS_WOUT + (size_t)4 * DM * DM * 2;
constexpr size_t WS_W2 = WS_W13 + (size_t)4 * 2 * DFF * DM * 2;
constexpr size_t WS_WUP = WS_W2 + (size_t)4 * DM * DFF * 2;
constexpr size_t WS_XRES = WS_WUP + (size_t)4 * NUP * KUP * 2;
constexpr size_t WS_H = WS_XRES + (size_t)MT * DM * 4;
constexpr size_t WS_Z = WS_H + (size_t)MT * DM * 2;
constexpr size_t WS_QKV = WS_Z + (size_t)MT * INWP * 2;
constexpr size_t WS_MIX = WS_QKV + (size_t)MT * NUP * 2;
constexpr size_t WS_U = WS_MIX + (size_t)MT * DM * 2;
constexpr size_t WS_GU = WS_U + (size_t)MT * DFF * 2;
constexpr size_t WS_GD = WS_GU + (size_t)16 * NCH * 16384 * 4;
constexpr size_t WS_GS = WS_GD + (size_t)16 * NCH * 128 * 4;
constexpr size_t WS_OP = WS_GS + (size_t)16 * NCH * 16384 * 2;
constexpr size_t WS_LSE = WS_OP + (size_t)2 * ML * 512 * 4;
constexpr size_t WS_END = WS_LSE + (size_t)2 * ML * 4 * 4;

constexpr int LDS_MAIN = 131072, LDS_MISC = LDS_MAIN, LDS_BYTES = LDS_MAIN + 1024;

__device__ __forceinline__ unsigned cvt_pk_bf16(float lo, float hi) { unsigned r; asm volatile("v_cvt_pk_bf16_f32 %0, %1, %2" : "=v"(r) : "v"(lo), "v"(hi)); return r; }
__device__ __forceinline__ float bf2f(unsigned short b) { return __uint_as_float(((unsigned)b) << 16); }
__device__ __forceinline__ float bflo(unsigned w) { return __uint_as_float(w << 16); }
__device__ __forceinline__ float bfhi(unsigned w) { return __uint_as_float(w & 0xffff0000u); }
__device__ __forceinline__ unsigned short f2bf(float f) { return (unsigned short)(cvt_pk_bf16(f, 0.f) & 0xffffu); }
__device__ __forceinline__ float wave_sum(float v) {
#pragma unroll
    for (int o = 1; o < 64; o <<= 1) v += __shfl_xor(v, o);
    return v;
}
__device__ __forceinline__ float sigmoidf_(float x) { return 1.0f / (1.0f + __expf(-x)); }
__device__ __forceinline__ float siluf_(float x) { return x / (1.0f + __expf(-x)); }
__device__ __forceinline__ float dot4(const f32x4& v) { return (v[0] * v[0] + v[1] * v[1]) + (v[2] * v[2] + v[3] * v[3]); }
#define LDS_WAIT() asm volatile("s_waitcnt lgkmcnt(0)" ::: "memory")
#define VM_WAIT() asm volatile("s_waitcnt vmcnt(0)" ::: "memory")

namespace pg8 {
#define PG8_LAS __attribute__((address_space(3)))
constexpr int BM = 256, BK = 64, HALF = 128, HTB = HALF * BK * 2, STAGE_BYTES = 8 * HTB, NXCD = 8, WGM = 8;
__host__ __device__ __forceinline__ int lds_byte(int r, int c) { const int st = (r >> 4) * 2 + (c >> 5), rr = r & 15, cc = c & 31, ob = rr * 64 + cc * 2; return st * 1024 + (ob ^ (((ob >> 9) & 1) << 5)); }
__host__ __device__ __forceinline__ void stage_rc(int b, int& R, int& C) { const int st = b / 1024, sb = b % 1024, swz = sb ^ (((sb >> 9) & 1) << 5); R = (st >> 1) * 16 + swz / 64; C = (st & 1) * 32 + (swz % 64) / 2; }
__host__ __device__ __forceinline__ int perm32(int rho) { const int n = rho >> 4, i = rho & 15; return 8 * (i >> 2) + 4 * n + (i & 3); }
struct Unit { int pm, pn; };
struct Gemm { const bf16_t* A; const bf16_t* Bt; int M, N, K, lda, ldb; };
struct StaticOrder {
    int nM, nN, nwg, G, c;
    __host__ __device__ void init(int M, int N, int G_, int c_) { nM = M / BM; nN = N / BM; nwg = nM * nN; G = G_; c = c_; }
    __host__ __device__ bool next(int i, Unit& u) const {
        const long L = (long)i * G + c; if (L >= nwg) return false;
        int wgid = (int)L; { const int q = nwg / NXCD, r = nwg % NXCD, xcd = wgid % NXCD, off = wgid / NXCD; wgid = (xcd < r ? xcd * (q + 1) : r * (q + 1) + (xcd - r) * q) + off; }
        const int nig = WGM * nN, gid = wgid / nig, fm = gid * WGM, gsz = (nM - fm) < WGM ? (nM - fm) : WGM;
        u.pm = fm + ((wgid % nig) % gsz); u.pn = (wgid % nig) / gsz; return true;
    }
    __device__ __forceinline__ void a_ready(const Unit&) const {}
    __device__ __forceinline__ void done(const Unit&) const {}
};
template <class Epi, class Sched, bool ALIGN_EPI = true, bool SP2 = true>
__device__ __forceinline__ void gemm_phase(PG8_LAS unsigned char* lds, const Gemm g, const Sched& S, const Epi& E, const int tid) {
    const int wid = __builtin_amdgcn_readfirstlane(tid >> 6), lane = tid & 63, wr = wid >> 2, wc = wid & 3, fr = lane & 15, fq = lane >> 4;
    const int K = g.K, nt = K / BK;
    unsigned voffA[2], voffB[2];
#pragma unroll
    for (int i = 0; i < 2; ++i) { int R, C; stage_rc(tid * 16 + i * 8192, R, C); const int Rb = Epi::PERM ? ((R & ~31) + perm32(R & 31)) : R;
        voffA[i] = (unsigned)(R * g.lda + C) * 2u; voffB[i] = (unsigned)(Rb * g.ldb + C) * 2u; }
    const size_t kstep = (size_t)(BK * 2);
    const size_t hstepA = (size_t)HALF * g.lda * 2, hstepB = (size_t)HALF * g.ldb * 2;
    const size_t tstepA = 2 * hstepA, tstepB = 2 * hstepB;
    const unsigned ldsw = (unsigned)wid * 1024u;
    const int aoff = lds_byte(wr * 64 + fr, fq * 8), boff = lds_byte(wc * 32 + fr, fq * 8);
#define PG8_SA(b, h) (((b) * 2 + (h)) * HTB)
#define PG8_SB(b, h) ((4 + (b) * 2 + (h)) * HTB)
#define PG8_STAGE(bufoff, gbase, voff) do { _Pragma("unroll") for (int _i = 0; _i < 2; ++_i) \
        __builtin_amdgcn_global_load_lds((const unsigned*)((const char*)(gbase) + (voff)[_i]), (PG8_LAS unsigned*)(lds + (bufoff) + ldsw + _i * 8192), 16, 0, 0); } while (0)
#define PG8_LDA(dst, b, h) do { _Pragma("unroll") for (int m = 0; m < 4; ++m) _Pragma("unroll") for (int k = 0; k < 2; ++k) dst[m][k] = *(const PG8_LAS bf16x8*)(lds + PG8_SA(b, h) + aoff + m * 2048 + k * 1024); } while (0)
#define PG8_LDB(dst, b, h) do { _Pragma("unroll") for (int n = 0; n < 2; ++n) _Pragma("unroll") for (int k = 0; k < 2; ++k) dst[n][k] = *(const PG8_LAS bf16x8*)(lds + PG8_SB(b, h) + boff + n * 2048 + k * 1024); } while (0)
#define PG8_MMA(ai, bj, At, Bt) do { __builtin_amdgcn_s_setprio(1); _Pragma("unroll") for (int m = 0; m < 4; ++m) _Pragma("unroll") for (int n = 0; n < 2; ++n) _Pragma("unroll") for (int k = 0; k < 2; ++k) \
        acc[ai][bj][m][n] = __builtin_amdgcn_mfma_f32_16x16x32_bf16(Bt[n][k], At[m][k], acc[ai][bj][m][n], 0, 0, 0); __builtin_amdgcn_s_setprio(0); } while (0)
#define PG8_WAIT_V(n) asm volatile("s_waitcnt vmcnt(" #n ")" ::: "memory")
#define PG8_WAIT_L(n) asm volatile("s_waitcnt lgkmcnt(" #n ")" ::: "memory")
#define PG8_BAR __builtin_amdgcn_s_barrier()
#define PG8_SCHED __builtin_amdgcn_sched_barrier(0)
    Unit cur, nxt; int ui = 0;
    if (!S.next(0, cur)) return;
    f32x4 acc[2][2][4][2];
#pragma unroll
    for (int a = 0; a < 2; ++a)
#pragma unroll
        for (int b = 0; b < 2; ++b)
#pragma unroll
            for (int m = 0; m < 4; ++m)
#pragma unroll
                for (int n = 0; n < 2; ++n) acc[a][b][m][n] = (f32x4){0.f, 0.f, 0.f, 0.f};
    bf16x8 At[4][2], B0[2][2], B1[2][2];
    const char* cA = (const char*)g.A + (size_t)cur.pm * tstepA; const char* cB = (const char*)g.Bt + (size_t)cur.pn * tstepB;
    S.a_ready(cur);
    if constexpr (SP2) {
        PG8_STAGE(PG8_SB(0, 0), cB, voffB); PG8_STAGE(PG8_SB(0, 1), cB + hstepB, voffB); PG8_STAGE(PG8_SA(0, 0), cA, voffA); PG8_STAGE(PG8_SA(0, 1), cA + hstepA, voffA);
        if (wr == 1) PG8_BAR;
        PG8_WAIT_V(2); PG8_BAR;
        PG8_STAGE(PG8_SB(1, 0), cB + kstep, voffB); PG8_STAGE(PG8_SA(1, 0), cA + kstep, voffA); PG8_STAGE(PG8_SB(1, 1), cB + hstepB + kstep, voffB);
        PG8_WAIT_V(6); PG8_BAR;
    } else {
        PG8_STAGE(PG8_SB(0, 0), cB, voffB); PG8_STAGE(PG8_SA(0, 0), cA, voffA); PG8_STAGE(PG8_SB(0, 1), cB + hstepB, voffB); PG8_STAGE(PG8_SA(0, 1), cA + hstepA, voffA);
        if (wr == 1) PG8_BAR;
        PG8_WAIT_V(4); PG8_BAR;
        PG8_STAGE(PG8_SB(1, 0), cB + kstep, voffB); PG8_STAGE(PG8_SA(1, 0), cA + kstep, voffA); PG8_STAGE(PG8_SB(1, 1), cB + hstepB + kstep, voffB);
        PG8_WAIT_V(6); PG8_BAR;
    }
    for (;;) {
        const bool has_next = S.next(ui + 1, nxt);
        const char* nA = has_next ? (const char*)g.A + (size_t)nxt.pm * tstepA : cA; const char* nB = has_next ? (const char*)g.Bt + (size_t)nxt.pn * tstepB : cB;
        for (int t = 0; t < nt; t += 2) {
            const bool last = (t == nt - 2);
            const char* a1 = cA + (size_t)(t + 1) * kstep;
            const char* a2 = last ? nA : cA + (size_t)(t + 2) * kstep; const char* b2 = last ? nB : cB + (size_t)(t + 2) * kstep;
            const char* a3 = a2 + kstep; const char* b3 = b2 + kstep;
            if (last && has_next) S.a_ready(nxt);
            if constexpr (SP2) {
            PG8_LDB(B0, 0, 0); PG8_LDB(B1, 0, 1); PG8_SCHED; PG8_LDA(At, 0, 0); PG8_STAGE(PG8_SA(1, 1), a1 + hstepA, voffA);
            PG8_WAIT_V(8); PG8_WAIT_L(0); PG8_BAR; PG8_MMA(0, 0, At, B0); PG8_MMA(0, 1, At, B1); PG8_BAR; PG8_SCHED;
            PG8_LDA(At, 0, 1); PG8_STAGE(PG8_SB(0, 0), b2, voffB); PG8_STAGE(PG8_SB(0, 1), b2 + hstepB, voffB); PG8_STAGE(PG8_SA(0, 0), a2, voffA);
            PG8_WAIT_V(8); PG8_WAIT_L(0); PG8_BAR; PG8_MMA(1, 0, At, B0); PG8_MMA(1, 1, At, B1); PG8_BAR; PG8_SCHED;
            PG8_LDB(B0, 1, 0); PG8_LDB(B1, 1, 1); PG8_SCHED; PG8_LDA(At, 1, 0); PG8_STAGE(PG8_SA(0, 1), a2 + hstepA, voffA);
            PG8_WAIT_V(8); PG8_WAIT_L(0); PG8_BAR; PG8_MMA(0, 0, At, B0); PG8_MMA(0, 1, At, B1); PG8_BAR; PG8_SCHED;
            PG8_LDA(At, 1, 1); PG8_STAGE(PG8_SB(1, 0), b3, voffB); PG8_STAGE(PG8_SB(1, 1), b3 + hstepB, voffB); PG8_STAGE(PG8_SA(1, 0), a3, voffA);
            PG8_WAIT_V(8); PG8_WAIT_L(0); PG8_BAR; PG8_MMA(1, 0, At, B0); PG8_MMA(1, 1, At, B1); PG8_BAR; PG8_SCHED;
            } else {
            PG8_LDB(B0, 0, 0); PG8_SCHED; PG8_LDA(At, 0, 0); PG8_STAGE(PG8_SA(1, 1), a1 + hstepA, voffA);
            PG8_WAIT_L(8); PG8_BAR; PG8_WAIT_L(0); PG8_MMA(0, 0, At, B0); PG8_BAR; PG8_SCHED;
            PG8_LDB(B1, 0, 1); PG8_STAGE(PG8_SB(0, 0), b2, voffB);
            PG8_BAR; PG8_WAIT_L(0); PG8_MMA(0, 1, At, B1); PG8_BAR;
            PG8_LDA(At, 0, 1); PG8_STAGE(PG8_SA(0, 0), a2, voffA);
            PG8_BAR; PG8_WAIT_L(0); PG8_MMA(1, 0, At, B0); PG8_BAR; PG8_SCHED;
            PG8_STAGE(PG8_SB(0, 1), b2 + hstepB, voffB);
            PG8_WAIT_V(6); PG8_BAR; PG8_MMA(1, 1, At, B1); PG8_BAR;
            PG8_LDB(B0, 1, 0); PG8_SCHED; PG8_LDA(At, 1, 0); PG8_STAGE(PG8_SA(0, 1), a2 + hstepA, voffA);
            PG8_WAIT_L(8); PG8_BAR; PG8_WAIT_L(0); PG8_MMA(0, 0, At, B0); PG8_BAR; PG8_SCHED;
            PG8_LDB(B1, 1, 1); PG8_STAGE(PG8_SB(1, 0), b3, voffB);
            PG8_BAR; PG8_WAIT_L(0); PG8_MMA(0, 1, At, B1); PG8_BAR;
            PG8_LDA(At, 1, 1); PG8_STAGE(PG8_SA(1, 0), a3, voffA);
            PG8_BAR; PG8_WAIT_L(0); PG8_MMA(1, 0, At, B0); PG8_BAR; PG8_SCHED;
            PG8_STAGE(PG8_SB(1, 1), b3 + hstepB, voffB);
            PG8_WAIT_V(6); PG8_BAR; PG8_MMA(1, 1, At, B1); PG8_BAR;
            }
        }
        if constexpr (ALIGN_EPI) { if (wr == 0) PG8_BAR; }
        E(acc, cur, wr, wc, fr, fq);
        if (!has_next) break;
#pragma unroll
        for (int a = 0; a < 2; ++a)
#pragma unroll
            for (int b = 0; b < 2; ++b)
#pragma unroll
                for (int m = 0; m < 4; ++m)
#pragma unroll
                    for (int n = 0; n < 2; ++n) acc[a][b][m][n] = (f32x4){0.f, 0.f, 0.f, 0.f};
        cur = nxt; cA = nA; cB = nB; ++ui;
        if constexpr (ALIGN_EPI) { if (wr == 1) PG8_BAR; }
    }
    PG8_WAIT_V(0);
    if constexpr (!ALIGN_EPI) { if (wr == 0) PG8_BAR; }
    PG8_BAR;
#undef PG8_SA
#undef PG8_SB
#undef PG8_STAGE
#undef PG8_LDA
#undef PG8_LDB
#undef PG8_MMA
#undef PG8_WAIT_V
#undef PG8_WAIT_L
#undef PG8_BAR
#undef PG8_SCHED
}

__device__ __forceinline__ void rope8(f32x4& v0, f32x4& v1, const f32x2* cs) {
    const f32x2 c0 = cs[0], c1 = cs[1], c2 = cs[2], c3 = cs[3];
    float a, b;
    a = v0[0]; b = v0[1]; v0[0] = a * c0.x - b * c0.y; v0[1] = b * c0.x + a * c0.y;
    a = v0[2]; b = v0[3]; v0[2] = a * c1.x - b * c1.y; v0[3] = b * c1.x + a * c1.y;
    a = v1[0]; b = v1[1]; v1[0] = a * c2.x - b * c2.y; v1[1] = b * c2.x + a * c2.y;
    a = v1[2]; b = v1[3]; v1[2] = a * c3.x - b * c3.y; v1[3] = b * c3.x + a * c3.y;
}

struct EpiIn {
    static constexpr bool PERM = true;
    bf16_t* Z; float* rstat; const f32x2* rope;
    __device__ __forceinline__ void operator()(const f32x4 (&acc)[2][2][4][2], const Unit& u, int wr, int wc, int fr, int fq) const {
        const int row0 = u.pm * BM + wr * 64 + fr; const int colw0 = u.pn * BM + wc * 32;
        const bool special = (u.pn >= 18);
#pragma unroll
        for (int ai = 0; ai < 2; ++ai)
#pragma unroll
            for (int m = 0; m < 4; ++m) {
                const int row = row0 + ai * HALF + m * 16;
                bf16_t* rowp = Z + (size_t)row * INWP + colw0 + 8 * fq;
                float sq = 0.f, skv = 0.f;
#pragma unroll
                for (int bj = 0; bj < 2; ++bj) {
                    f32x4 v0 = acc[ai][bj][m][0], v1 = acc[ai][bj][m][1];
                    if (special) {
                        const int colw = colw0 + bj * HALF;
                        if (colw >= ZCQ && colw < ZCKV) sq += dot4(v0) + dot4(v1);
                        else if (colw >= ZCKV && colw < ZKR) skv += dot4(v0) + dot4(v1);
                        else if (colw >= ZKR && colw < INW && u.pm < 32) {
                            const int axis = (colw - ZKR) >> 5, t = row & (SEQ - 1), pos = axis ? (t & 63) : (t >> 6);
                            rope8(v0, v1, rope + pos * 16 + 4 * fq);
                        }
                    }
                    u32x4 w; w.x = cvt_pk_bf16(v0[0], v0[1]); w.y = cvt_pk_bf16(v0[2], v0[3]); w.z = cvt_pk_bf16(v1[0], v1[1]); w.w = cvt_pk_bf16(v1[2], v1[3]);
                    *(u32x4*)(rowp + bj * HALF) = w;
                }
                if (special) {
                    sq += __shfl_xor(sq, 16); sq += __shfl_xor(sq, 32); skv += __shfl_xor(skv, 16); skv += __shfl_xor(skv, 32);
                    if (fq == 0) { if (sq != 0.f) atomicAdd(rstat + (size_t)row * 2, sq); if (skv != 0.f) atomicAdd(rstat + (size_t)row * 2 + 1, skv); }
                }
            }
    }
};
struct EpiUp {
    static constexpr bool PERM = true;
    bf16_t* O; const float* rstat; const f32x2* rope;
    __device__ __forceinline__ void operator()(const f32x4 (&acc)[2][2][4][2], const Unit& u, int wr, int wc, int fr, int fq) const {
        const int row0 = u.pm * BM + wr * 64 + fr; const int colw0 = u.pn * BM + wc * 32;
#pragma unroll
        for (int ai = 0; ai < 2; ++ai)
#pragma unroll
            for (int m = 0; m < 4; ++m) {
                const int row = row0 + ai * HALF + m * 16;
                const f32x2 ss = *(const f32x2*)(rstat + (size_t)row * 2);
                const float rq = rsqrtf(ss.x * (1.0f / 384.0f) + EPS), rkv = rsqrtf(ss.y * (1.0f / 128.0f) + EPS);
                bf16_t* rowp = O + (size_t)row * NUP + colw0 + 8 * fq;
#pragma unroll
                for (int bj = 0; bj < 2; ++bj) {
                    const int colw = colw0 + bj * HALF;
                    const float sc = colw < 768 ? rq : rkv;
                    f32x4 v0 = acc[ai][bj][m][0] * sc, v1 = acc[ai][bj][m][1] * sc;
                    if (colw < 768 && u.pm < 32) {
                        const int within = colw % 192;
                        if (within >= 128) { const int axis = (within - 128) >> 5, t = row & (SEQ - 1), pos = axis ? (t & 63) : (t >> 6); rope8(v0, v1, rope + pos * 16 + 4 * fq); }
                    }
                    u32x4 w; w.x = cvt_pk_bf16(v0[0], v0[1]); w.y = cvt_pk_bf16(v0[2], v0[3]); w.z = cvt_pk_bf16(v1[0], v1[1]); w.w = cvt_pk_bf16(v1[2], v1[3]);
                    *(u32x4*)(rowp + bj * HALF) = w;
                }
            }
    }
};
struct EpiRes {
    static constexpr bool PERM = false;
    const float* base_lat; const float* base_ctx; float* out; const float* gate;
    __device__ __forceinline__ void operator()(const f32x4 (&acc)[2][2][4][2], const Unit& u, int wr, int wc, int fr, int fq) const {
        const int row0 = u.pm * BM + wr * 64 + fr, col0 = u.pn * BM + wc * 32 + 4 * fq;
        const int r = u.pm < 16 ? 0 : (u.pm < 32 ? 1 : 2);
        const float* gp = gate + (size_t)r * 6 * DM + col0;
        f32x4 gv[2][2];
#pragma unroll
        for (int bj = 0; bj < 2; ++bj)
#pragma unroll
            for (int n = 0; n < 2; ++n) gv[bj][n] = *(const f32x4*)(gp + bj * HALF + n * 16);
#pragma unroll
        for (int ai = 0; ai < 2; ++ai)
#pragma unroll
            for (int m = 0; m < 4; ++m) {
                const int row = row0 + ai * HALF + m * 16;
                const float* bp = (u.pm < 32 ? base_lat + (size_t)row * DM : base_ctx + (size_t)(row - ML) * DM) + col0;
                float* op = out + (size_t)row * DM + col0;
#pragma unroll
                for (int bj = 0; bj < 2; ++bj)
#pragma unroll
                    for (int n = 0; n < 2; ++n) { const f32x4 b = *(const f32x4*)(bp + bj * HALF + n * 16); *(f32x4*)(op + bj * HALF + n * 16) = b + gv[bj][n] * acc[ai][bj][m][n]; }
            }
    }
};
struct EpiSwiglu {
    static constexpr bool PERM = true;
    bf16_t* U;
    __device__ __forceinline__ void operator()(const f32x4 (&acc)[2][2][4][2], const Unit& u, int wr, int wc, int fr, int fq) const {
        const int row0 = u.pm * BM + wr * 64 + fr, oc = u.pn * HALF + wc * 32 + 8 * fq;
#pragma unroll
        for (int ai = 0; ai < 2; ++ai)
#pragma unroll
            for (int m = 0; m < 4; ++m) {
                const int row = row0 + ai * HALF + m * 16;
                float o[8];
#pragma unroll
                for (int n = 0; n < 2; ++n)
#pragma unroll
                    for (int j = 0; j < 4; ++j) { const float a = acc[ai][0][m][n][j], b = acc[ai][1][m][n][j]; o[n * 4 + j] = a * b * __builtin_amdgcn_rcpf(1.0f + __builtin_amdgcn_exp2f(-1.4426950408889634f * a)); }
                u32x4 w; w.x = cvt_pk_bf16(o[0], o[1]); w.y = cvt_pk_bf16(o[2], o[3]); w.z = cvt_pk_bf16(o[4], o[5]); w.w = cvt_pk_bf16(o[6], o[7]);
                *(u32x4*)(U + (size_t)row * DFF + oc) = w;
            }
    }
};
}

#define XB_TMO      128
#define XB_XCNT(j)  (256  + 64 * (j))
#define XB_XSUB(j)  (1280 + 64 * (j))
#define XB_XGEN(j)  (2304 + 64 * (j))
#define XB_TOP      3328
#define XB_TOPGEN   3392
#define XCD_BAR_WORDS 3456
#define XB_SPIN_CAP (1u << 18)
__device__ __forceinline__ unsigned xb_ld(unsigned* p)              { return __hip_atomic_load(p, __ATOMIC_RELAXED, __HIP_MEMORY_SCOPE_AGENT); }
__device__ __forceinline__ unsigned xb_add(unsigned* p, unsigned v) { return __hip_atomic_fetch_add(p, v, __ATOMIC_RELAXED, __HIP_MEMORY_SCOPE_AGENT); }
__device__ __forceinline__ unsigned xb_xcc_id() { return (unsigned)__builtin_amdgcn_s_getreg((3 << 11) | 20) & 0xFu; }
#define XB_SPIN(cond, bar) do { unsigned _sp = 0; while (cond) { __builtin_amdgcn_s_sleep(1); \
    if ((++_sp & 255u) == 0u) { if (xb_ld(&(bar)[XB_TMO])) break; if (_sp > XB_SPIN_CAP) { atomicAdd(&(bar)[XB_TMO], 1u); break; } } } } while (0)
struct XcdBarrier { unsigned* bar; unsigned x; volatile LAS unsigned* st; };
__device__ __forceinline__ XcdBarrier xcd_barrier_post(unsigned* bar, volatile LAS unsigned* st) {
    XcdBarrier b; b.bar = bar; b.x = xb_xcc_id(); b.st = st;
    if (threadIdx.x == 0) (void)xb_add(&bar[XB_XCNT(b.x)], 1u);
    return b;
}
__device__ __forceinline__ void xcd_barrier_complete(unsigned* bar, unsigned x, unsigned& nloc, unsigned& nx) {
    const unsigned G = gridDim.x * gridDim.y * gridDim.z;
    unsigned sum, cnt, mine, sp = 0u;
    for (;;) {
        sum = 0u; cnt = 0u; mine = 0u;
#pragma unroll
        for (unsigned j = 0; j < 16; ++j) { const unsigned c = xb_ld(&bar[XB_XCNT(j)]); sum += c; cnt += (c > 0u) ? 1u : 0u; mine = (j == x) ? c : mine; }
        if (sum == G) break;
        __builtin_amdgcn_s_sleep(1);
        if ((++sp & 255u) == 0u) { if (xb_ld(&bar[XB_TMO])) break; if (sp > XB_SPIN_CAP) { atomicAdd(&bar[XB_TMO], 1u); break; } }
    }
    nloc = mine > 0u ? mine : 1u; nx = cnt > 0u ? cnt : 1u;
}
__device__ __forceinline__ void xcd_barrier(const XcdBarrier& b) {
    asm volatile("s_waitcnt vmcnt(0)" ::: "memory");
    __syncthreads();
    if (threadIdx.x == 0) {
        unsigned* bar = b.bar;
        __builtin_amdgcn_s_waitcnt(0);
        unsigned nloc = b.st[0], nx = b.st[1];
        if (nloc == 0u) { xcd_barrier_complete(bar, b.x, nloc, nx); b.st[0] = nloc; b.st[1] = nx; }
        const unsigned old = xb_add(&bar[XB_XSUB(b.x)], 1u);
        const unsigned gen = old / nloc;
        if (old + 1u == (gen + 1u) * nloc) {
            __builtin_amdgcn_fence(__ATOMIC_RELEASE, "agent");
            asm volatile("s_waitcnt vmcnt(0)" ::: "memory");
            const unsigned og = xb_add(&bar[XB_TOP], 1u);
            const unsigned tg = og / nx;
            if (og + 1u == (tg + 1u) * nx) xb_add(&bar[XB_TOPGEN], 1u);
            else XB_SPIN(xb_ld(&bar[XB_TOPGEN]) == tg, bar);
            __builtin_amdgcn_fence(__ATOMIC_ACQUIRE, "agent");
            xb_add(&bar[XB_XGEN(b.x)], 1u);
            asm volatile("s_waitcnt vmcnt(0)" ::: "memory");
        } else {
            XB_SPIN(xb_ld(&bar[XB_XGEN(b.x)]) == gen, bar);
            __builtin_amdgcn_fence(__ATOMIC_ACQUIRE, "agent");
            asm volatile("s_waitcnt vmcnt(0)" ::: "memory");
        }
    }
    __syncthreads();
}

struct Params {
    const float *x, *c, *ctx, *c_ctx, *norm1_g, *w_mod, *b_mod, *w_in, *fg_up, *fg_b, *onorm_g, *conf_dw, *conf_dw_b, *conf_ln_g, *conf_ln_b, *sc_dw,
                *qn_g, *kvn_g, *w_uq, *w_ukv, *w_out, *norm2_g, *w1, *w3, *w2, *final_g;
    float* out; unsigned char* ws; int ph_lo, ph_hi;
};

template <class RowMap>
__device__ __forceinline__ void transpose_item(const float* W, int N, bf16_t* WT, int ldk, const RowMap& rm, LAS float* scr, int item, int lane) {
    const int nblk = N / 32, kb = item / nblk, nb = item % nblk, k0 = 64 * kb, n0 = 32 * nb;
#pragma unroll 8
    for (int i = 0; i < 32; ++i) { const int kk = 2 * i + (lane >> 5); scr[kk * 33 + (lane & 31)] = W[(size_t)(k0 + kk) * N + n0 + (lane & 31)]; }
    LDS_WAIT(); asm volatile("" ::: "memory");
    const int c = lane & 7;
#pragma unroll
    for (int j = 0; j < 4; ++j) { const int n = (lane >> 3) + 8 * j; const LAS float* s = scr + (8 * c) * 33 + n;
        u32x4 o; o.x = cvt_pk_bf16(s[0 * 33], s[1 * 33]); o.y = cvt_pk_bf16(s[2 * 33], s[3 * 33]); o.z = cvt_pk_bf16(s[4 * 33], s[5 * 33]); o.w = cvt_pk_bf16(s[6 * 33], s[7 * 33]);
        *(u32x4*)(WT + (size_t)rm(n0 + n) * ldk + k0 + 8 * c) = o; }
    LDS_WAIT(); asm volatile("" ::: "memory");
}
struct RmId { __device__ __forceinline__ int operator()(int n) const { return n; } };
struct RmIn { __device__ __forceinline__ int operator()(int n) const { if (n < ZKR) return n; const int rc = n - ZKR, a = rc >> 5, hf = (rc >> 4) & 1, i = rc & 15; return ZKR + a * 32 + 2 * i + hf; } };
struct RmFf { int off; __device__ __forceinline__ int operator()(int n) const { return (n >> 7) * 256 + off + (n & 127); } };

struct Frame {
    LAS unsigned char* lds; int tid, lane, wave, G, bid; unsigned char* ws; const Params* p;
};

__device__ __forceinline__ void phase_p0a(const Params& P, LAS unsigned char* lds, int tid, int lane, int wave, int G, int bid) {
    unsigned char* ws = P.ws;
    const int gw = bid * 8 + wave, NGW = G * 8;
    const int gt = bid * 512 + tid, NGT = G * 512;
    LAS float* act = (LAS float*)(lds + 8 * 8448);
    for (int i = tid; i < 3 * DM; i += 512) { const int r = i / DM, k = i % DM; const float v = r < 2 ? P.c[r * DM + k] : P.c_ctx[k]; act[i] = v / (1.0f + expf(-v)); }
    __syncthreads();
    {
        float* modp = (float*)(ws + WS_MODP);
        for (int it = gw; it < 4 * 48 * 8; it += NGW) {
            const int layer = it / 384, rem = it % 384, cb = rem / 8, ks = rem % 8;
            const int col0 = cb * 256 + lane * 4;
            const float* Wp = P.w_mod + ((size_t)layer * DM + (size_t)ks * 256) * 12288 + col0;
            const LAS float* a0 = act + ks * 256;
            f32x4 s0 = {0.f, 0.f, 0.f, 0.f}, s1 = s0, s2 = s0;
#pragma unroll 8
            for (int k = 0; k < 256; ++k) { const f32x4 w = *(const f32x4*)(Wp + (size_t)k * 12288); s0 += w * a0[k]; s1 += w * a0[DM + k]; s2 += w * a0[2 * DM + k]; }
            float* o = modp + (((size_t)ks * 4 + layer) * 3) * 12288 + col0;
            *(f32x4*)(o) = s0; *(f32x4*)(o + 12288) = s1; *(f32x4*)(o + 2 * 12288) = s2;
        }
    }
    {
        LAS float* scr = (LAS float*)(lds + wave * 8448);
        constexpr int I_IN = (DM / 64) * (INW / 32), I_OUT = (DM / 64) * (DM / 32), I_FF = (DM / 64) * (DFF / 32), I_W2 = (DFF / 64) * (DM / 32);
        constexpr int PER_LAYER = I_IN + I_OUT + 2 * I_FF + I_W2;
        for (int it = gw; it < 4 * PER_LAYER; it += NGW) {
            const int layer = it / PER_LAYER; int r = it % PER_LAYER;
            if (r < I_IN) { transpose_item(P.w_in + (size_t)layer * DM * INW, INW, (bf16_t*)(ws + WS_WIN) + (size_t)layer * INWP * DM, DM, RmIn{}, scr, r, lane); continue; } r -= I_IN;
            if (r < I_OUT) { transpose_item(P.w_out + (size_t)layer * DM * DM, DM, (bf16_t*)(ws + WS_WOUT) + (size_t)layer * DM * DM, DM, RmId{}, scr, r, lane); continue; } r -= I_OUT;
            if (r < I_FF) { transpose_item(P.w1 + (size_t)layer * DM * DFF, DFF, (bf16_t*)(ws + WS_W13) + (size_t)layer * 2 * DFF * DM, DM, RmFf{0}, scr, r, lane); continue; } r -= I_FF;
            if (r < I_FF) { transpose_item(P.w3 + (size_t)layer * DM * DFF, DFF, (bf16_t*)(ws + WS_W13) + (size_t)layer * 2 * DFF * DM, DM, RmFf{128}, scr, r, lane); continue; } r -= I_FF;
            transpose_item(P.w2 + (size_t)layer * DFF * DM, DM, (bf16_t*)(ws + WS_W2) + (size_t)layer * DM * DFF, DFF, RmId{}, scr, r, lane);
        }
    }
    {
        constexpr int PADW = (INWP - INW) * DM / 8;
        for (int i = gt; i < 4 * PADW; i += NGT) { const int layer = i / PADW, j = i % PADW;
            *(u32x4*)((bf16_t*)(ws + WS_WIN) + ((size_t)layer * INWP + INW) * DM + (size_t)j * 8) = (u32x4){0u, 0u, 0u, 0u}; }
    }
    {
        bf16_t* WU = (bf16_t*)(ws + WS_WUP);
        for (int i = gt; i < 4 * NUP * KUP; i += NGT) {
            const int layer = i / (NUP * KUP), rem = i % (NUP * KUP), p = rem / KUP, k = rem % KUP;
            float v = 0.f;
            if (p < 768) {
                if (k < 384) { const int hd = p / 192, within = p % 192; int ow = within;
                    if (within >= 128) { const int rc = within - 128, a = rc >> 5, j = rc & 31, ii = j >> 1, hf = j & 1; ow = 128 + a * 32 + hf * 16 + ii; }
                    v = P.qn_g[layer * 384 + k] * P.w_uq[((size_t)layer * 384 + k) * 768 + hd * 192 + ow]; }
            } else {
                if (k >= 384) { const int kk = k - 384; v = P.kvn_g[layer * 128 + kk] * P.w_ukv[((size_t)layer * 128 + kk) * 1024 + (p - 768)]; }
            }
            WU[i] = f2bf(v);
        }
    }
    {
        f32x2* rope = (f32x2*)(ws + WS_ROPE);
        for (int i = gt; i < 1024; i += NGT) { const int pos = i >> 4, f = i & 15; const float inv = powf(10000.0f, -(float)f * 2.0f / 32.0f); const float ang = (float)pos * inv; rope[i] = (f32x2){cosf(ang), sinf(ang)}; }
        float* rs = (float*)(ws + WS_RSTAT);
        for (int i = gt; i < 4 * MT * 2; i += NGT) rs[i] = 0.f;
    }
}
__device__ __forceinline__ void phase_p0b(const Params& P, int tid, int G, int bid) {
    const float* modp = (const float*)(P.ws + WS_MODP); float* modv = (float*)(P.ws + WS_MODV);
    for (int i = bid * 512 + tid; i < 4 * 3 * 12288; i += G * 512) {
        const int layer = i / (3 * 12288), rem = i % (3 * 12288), r = rem / 12288, c12 = rem % 12288, j = c12 / DM, col = c12 % DM;
        float s = P.b_mod[layer * 12288 + c12];
#pragma unroll
        for (int ks = 0; ks < 8; ++ks) s += modp[(((size_t)ks * 4 + layer) * 3 + r) * 12288 + c12];
        if (j == 1) s = P.norm1_g[layer * DM + col] * (1.0f + s);
        if (j == 4) s = P.norm2_g[layer * DM + col] * (1.0f + s);
        modv[(((size_t)layer * 3 + r) * 6 + j) * DM + col] = s;
    }
}

__device__ __forceinline__ void phase_norm(const float* xlat, const float* xctx, const float* modl  , int jg, int jsh, bf16_t* H, int nrows, int lane, int wave, int G, int bid) {
    const int rpw = (nrows + G - 1) / G;
    int cur = -1; f32x4 gsv[8], shv[8];
    for (int k = wave; k < rpw; k += 8) {
        const int row = bid * rpw + k; if (row >= nrows) break;
        const int r = row < SEQ ? 0 : (row < ML ? 1 : 2);
        if (r != cur) { cur = r; const float* gp = modl + ((size_t)r * 6 + jg) * DM; const float* sp = modl + ((size_t)r * 6 + jsh) * DM;
#pragma unroll
            for (int j = 0; j < 8; ++j) { gsv[j] = *(const f32x4*)(gp + (lane + 64 * j) * 4); shv[j] = *(const f32x4*)(sp + (lane + 64 * j) * 4); } }
        const float* xr = row < ML ? xlat + (size_t)row * DM : xctx + (size_t)(row - ML) * DM;
        f32x4 v[8]; float ss = 0.f;
#pragma unroll
        for (int j = 0; j < 8; ++j) { v[j] = *(const f32x4*)(xr + (lane + 64 * j) * 4); ss += dot4(v[j]); }
        const float rstd = rsqrtf(wave_sum(ss) * (1.0f / DM) + EPS);
        bf16_t* hr = H + (size_t)row * DM;
#pragma unroll
        for (int j = 0; j < 8; ++j) { const f32x4 o = v[j] * rstd * gsv[j] + shv[j]; u32x2 w; w.x = cvt_pk_bf16(o[0], o[1]); w.y = cvt_pk_bf16(o[2], o[3]); *(u32x2*)(hr + (lane + 64 * j) * 4) = w; }
    }
}
__device__ __forceinline__ void phase_final(const float* X, const float* g, float* out, int lane, int wave, int G, int bid) {
    for (int row = bid * 8 + wave; row < ML; row += G * 8) {
        const float* xr = X + (size_t)row * DM; f32x4 v[8]; float ss = 0.f;
#pragma unroll
        for (int j = 0; j < 8; ++j) { v[j] = *(const f32x4*)(xr + (lane + 64 * j) * 4); ss += dot4(v[j]); }
        const float rstd = rsqrtf(wave_sum(ss) * (1.0f / DM) + EPS);
#pragma unroll
        for (int j = 0; j < 8; ++j) { const f32x4 gg = *(const f32x4*)(g + (lane + 64 * j) * 4); *(f32x4*)(out + (size_t)row * DM + (lane + 64 * j) * 4) = v[j] * rstd * gg; }
    }
}

constexpr int GL_L = 0;
constexpr int GL_QT = 33792;
constexpr int GL_KT = 51200;
constexpr int GL_PP = 68608;
constexpr int GL_VT = 77824;
constexpr int GL_FG = 96256;
constexpr int GL_LR = 104960;
__device__ __forceinline__ int gla_row0(int b, int id) { return id < 4 ? ML + b * CTX + id * 64 : b * SEQ + (id - 4) * 64; }
__device__ __forceinline__ void gla_load_vT(LAS unsigned char* lds, const bf16_t* Z, int row0, int h, int tid) {
    const int t = tid >> 3, eg = (tid & 7) * 16;
    const u32x4* src = (const u32x4*)(Z + (size_t)(row0 + t) * INWP + ZV + h * 128 + eg);
    const u32x4 a = src[0], b = src[1];
    LAS bf16_t* VT = (LAS bf16_t*)(lds + GL_VT);
    const unsigned w[8] = {a.x, a.y, a.z, a.w, b.x, b.y, b.z, b.w};
#pragma unroll
    for (int i = 0; i < 8; ++i) { VT[(eg + 2 * i) * 72 + t] = (bf16_t)(w[i] & 0xffffu); VT[(eg + 2 * i + 1) * 72 + t] = (bf16_t)(w[i] >> 16); }
}
__device__ __forceinline__ void gla_decay(LAS unsigned char* lds, const bf16_t* Z, const float* fgup  , const float* fgb  , int row0, int h, int dir, int tid) {
    LAS float* FG = (LAS float*)(lds + GL_FG); LAS float* FB = FG + 2048; LAS float* LR = (LAS float*)(lds + GL_LR); LAS float* L = (LAS float*)(lds + GL_L);
    { const int r = tid >> 5, d4 = (tid & 31) * 4; *(LAS f32x4*)(FG + r * 128 + d4) = *(const f32x4*)(fgup + r * 512 + h * 128 + d4); }
    if (tid < 32) *(LAS f32x4*)(FB + tid * 4) = *(const f32x4*)(fgb + h * 128 + tid * 4);
    if (tid < 128) { const int t = tid >> 1, hf = tid & 1; const u32x4 w = *(const u32x4*)(Z + (size_t)(row0 + t) * INWP + ZLR + dir * 16 + hf * 8);
        LAS float* o = LR + t * 16 + hf * 8; o[0] = bflo(w.x); o[1] = bfhi(w.x); o[2] = bflo(w.y); o[3] = bfhi(w.y); o[4] = bflo(w.z); o[5] = bfhi(w.z); o[6] = bflo(w.w); o[7] = bfhi(w.w); }
    __syncthreads();
    {
        const int t = tid >> 3, dg = (tid & 7) * 16;
        f32x4 a[4];
#pragma unroll
        for (int q = 0; q < 4; ++q) a[q] = *(const LAS f32x4*)(FB + dg + 4 * q);
#pragma unroll
        for (int r = 0; r < 16; ++r) { const float lr = LR[t * 16 + r];
#pragma unroll
            for (int q = 0; q < 4; ++q) a[q] += *(const LAS f32x4*)(FG + r * 128 + dg + 4 * q) * lr; }
#pragma unroll
        for (int q = 0; q < 4; ++q) { f32x4 o;
#pragma unroll
            for (int j = 0; j < 4; ++j) { const float x = a[q][j]; o[j] = (fminf(x, 0.f) - log1pf(expf(-fabsf(x)))) * (1.0f / 16.0f); }
            *(LAS f32x4*)(L + t * 132 + dg + 4 * q) = o; }
    }
    __syncthreads();
    if (tid < 128) { float run = 0.f;
        if (dir == 0) { for (int t = 0; t < 64; ++t) { run += L[t * 132 + tid]; L[t * 132 + tid] = run; } }
        else { for (int t = 63; t >= 0; --t) { run += L[t * 132 + tid]; L[t * 132 + tid] = run; } } }
    __syncthreads();
}
__device__ __forceinline__ void gla_g1_item(LAS unsigned char* lds, const Params& P, int layer, int item, int tid, int lane, int wave) {
    const bf16_t* Z = (const bf16_t*)(P.ws + WS_Z);
    const int id = item % NCH, dir = (item / NCH) & 1, h = (item / (2 * NCH)) & 3, b = item / (8 * NCH);
    const int seq = (b * 4 + h) * 2 + dir, row0 = gla_row0(b, id);
    gla_load_vT(lds, Z, row0, h, tid);
    gla_decay(lds, Z, P.fg_up + ((size_t)layer * 2 + dir) * 16 * 512, P.fg_b + ((size_t)layer * 2 + dir) * 512, row0, h, dir, tid);
    LAS float* L = (LAS float*)(lds + GL_L); LAS bf16_t* KH = (LAS bf16_t*)(lds + GL_QT);
    const int tl = dir == 0 ? 63 : 0;
    {
        const int t = tid >> 3, dg = (tid & 7) * 16;
        const u32x4* src = (const u32x4*)(Z + (size_t)(row0 + t) * INWP + ZK + h * 128 + dg);
        const u32x4 a = src[0], bq = src[1]; const unsigned w[8] = {a.x, a.y, a.z, a.w, bq.x, bq.y, bq.z, bq.w};
#pragma unroll
        for (int i = 0; i < 8; ++i) { const int d = dg + 2 * i;
            const float e0 = __expf(L[tl * 132 + d] - L[t * 132 + d]), e1 = __expf(L[tl * 132 + d + 1] - L[t * 132 + d + 1]);
            KH[d * 72 + t] = f2bf(bflo(w[i]) * e0); KH[(d + 1) * 72 + t] = f2bf(bfhi(w[i]) * e1); }
        if (tid < 128) ((float*)(P.ws + WS_GD))[((size_t)seq * NCH + id) * 128 + tid] = __expf(L[tl * 132 + tid]);
    }
    __syncthreads();
    {
        const LAS bf16_t* VT = (const LAS bf16_t*)(lds + GL_VT);
        const int eb = wave >> 1, r32 = lane & 31, hi = lane >> 5;
        float* U = (float*)(P.ws + WS_GU) + ((size_t)seq * NCH + id) * 16384;
#pragma unroll
        for (int q = 0; q < 2; ++q) { const int db = 2 * (wave & 1) + q; f32x16 acc = {};
#pragma unroll
            for (int kk = 0; kk < 4; ++kk) { const bf16x8 av = *(const LAS bf16x8*)(VT + (32 * eb + r32) * 72 + 16 * kk + 8 * hi), bv = *(const LAS bf16x8*)(KH + (32 * db + r32) * 72 + 16 * kk + 8 * hi);
                acc = __builtin_amdgcn_mfma_f32_32x32x16_bf16(av, bv, acc, 0, 0, 0); }
#pragma unroll
            for (int r = 0; r < 16; ++r) { const int e = 32 * eb + (r & 3) + 8 * (r >> 2) + 4 * hi; U[e * 128 + 32 * db + r32] = acc[r]; } }
    }
    __syncthreads();
}
__device__ __forceinline__ void gla_g2(const Params& P, int tid, int G, int bid) {
    const float* U = (const float*)(P.ws + WS_GU); const float* Dv = (const float*)(P.ws + WS_GD); bf16_t* S = (bf16_t*)(P.ws + WS_GS);
    for (int slot = bid * 512 + tid; slot < 16 * 8192; slot += G * 512) {
        const int seq = slot >> 13, el = (slot & 8191) * 2, d = el & 127, dir = seq & 1;
        float s0 = 0.f, s1 = 0.f;
#pragma unroll 4
        for (int p = 0; p < NCH; ++p) {
            const int id = dir == 0 ? p : (p < 4 ? 3 - p : 71 - p);
            const size_t base = ((size_t)seq * NCH + id);
            *(unsigned*)(S + base * 16384 + el) = cvt_pk_bf16(s0, s1);
            const f32x2 u = *(const f32x2*)(U + base * 16384 + el), dd = *(const f32x2*)(Dv + base * 128 + d);
            s0 = dd.x * s0 + u.x; s1 = dd.y * s1 + u.y;
        }
    }
}
__device__ __forceinline__ void gla_g3_item(LAS unsigned char* lds, const Params& P, int layer, int item, int tid, int lane, int wave) {
    const bf16_t* Z = (const bf16_t*)(P.ws + WS_Z);
    const int id = item % NCH, h = (item / NCH) & 3, b = item / (4 * NCH);
    const int row0 = gla_row0(b, id);
    gla_load_vT(lds, Z, row0, h, tid);
    LAS float* L = (LAS float*)(lds + GL_L); LAS bf16_t* QT = (LAS bf16_t*)(lds + GL_QT); LAS bf16_t* KT = (LAS bf16_t*)(lds + GL_KT); LAS bf16_t* PP = (LAS bf16_t*)(lds + GL_PP);
    const LAS bf16_t* VT = (const LAS bf16_t*)(lds + GL_VT);
    const int r32 = lane & 31, hi = lane >> 5, rb = wave >> 2, cb = wave & 3;
    f32x16 o = {};
    for (int dir = 0; dir < 2; ++dir) {
        const int seq = (b * 4 + h) * 2 + dir;
        const bf16_t* Sg = (const bf16_t*)(P.ws + WS_GS) + ((size_t)seq * NCH + id) * 16384 + (size_t)(32 * cb + r32) * 128 + 8 * hi;
        bf16x8 sf[8];
#pragma unroll
        for (int kk = 0; kk < 8; ++kk) sf[kk] = *(const bf16x8*)(Sg + 16 * kk);
        gla_decay(lds, Z, P.fg_up + ((size_t)layer * 2 + dir) * 16 * 512, P.fg_b + ((size_t)layer * 2 + dir) * 512, row0, h, dir, tid);
        {
            const int t = tid >> 3, dg = (tid & 7) * 16;
            const u32x4* qs = (const u32x4*)(Z + (size_t)(row0 + t) * INWP + ZQ + h * 128 + dg); const u32x4* ks = (const u32x4*)(Z + (size_t)(row0 + t) * INWP + ZK + h * 128 + dg);
            const u32x4 qa = qs[0], qb = qs[1], ka = ks[0], kb = ks[1];
            const unsigned qw[8] = {qa.x, qa.y, qa.z, qa.w, qb.x, qb.y, qb.z, qb.w}, kw[8] = {ka.x, ka.y, ka.z, ka.w, kb.x, kb.y, kb.z, kb.w};
            unsigned qo[8], ko[8];
#pragma unroll
            for (int i = 0; i < 8; ++i) { const float b0 = L[t * 132 + dg + 2 * i], b1 = L[t * 132 + dg + 2 * i + 1];
                const float eq0 = __expf(b0) * 0.08838834764831845f, eq1 = __expf(b1) * 0.08838834764831845f, ek0 = __expf(fminf(-b0, 80.f)), ek1 = __expf(fminf(-b1, 80.f));
                qo[i] = cvt_pk_bf16(bflo(qw[i]) * eq0, bfhi(qw[i]) * eq1); ko[i] = cvt_pk_bf16(bflo(kw[i]) * ek0, bfhi(kw[i]) * ek1); }
            *(LAS u32x4*)(QT + t * 136 + dg) = (u32x4){qo[0], qo[1], qo[2], qo[3]}; *(LAS u32x4*)(QT + t * 136 + dg + 8) = (u32x4){qo[4], qo[5], qo[6], qo[7]};
            *(LAS u32x4*)(KT + t * 136 + dg) = (u32x4){ko[0], ko[1], ko[2], ko[3]}; *(LAS u32x4*)(KT + t * 136 + dg + 8) = (u32x4){ko[4], ko[5], ko[6], ko[7]};
        }
        __syncthreads();
        {
            const int bi = wave >> 1, fr = lane & 15, fq = lane >> 4;
#pragma unroll
            for (int q = 0; q < 2; ++q) { const int bj = 2 * (wave & 1) + q; f32x4 acc = {0.f, 0.f, 0.f, 0.f};
#pragma unroll
                for (int kk = 0; kk < 4; ++kk) { const bf16x8 av = *(const LAS bf16x8*)(QT + (16 * bi + fr) * 136 + 32 * kk + 8 * fq), bv = *(const LAS bf16x8*)(KT + (16 * bj + fr) * 136 + 32 * kk + 8 * fq);
                    acc = __builtin_amdgcn_mfma_f32_16x16x32_bf16(av, bv, acc, 0, 0, 0); }
                const int jt = 16 * bj + fr;
#pragma unroll
                for (int r = 0; r < 4; ++r) { const int it = 16 * bi + 4 * fq + r; const bool keep = dir == 0 ? (jt <= it) : (jt >= it); PP[it * 72 + jt] = f2bf(keep ? acc[r] : 0.f); } }
        }
        __syncthreads();
        {
#pragma unroll
            for (int kk = 0; kk < 4; ++kk) { const bf16x8 av = *(const LAS bf16x8*)(PP + (32 * rb + r32) * 72 + 16 * kk + 8 * hi), bv = *(const LAS bf16x8*)(VT + (32 * cb + r32) * 72 + 16 * kk + 8 * hi);
                o = __builtin_amdgcn_mfma_f32_32x32x16_bf16(av, bv, o, 0, 0, 0); }
#pragma unroll
            for (int kk = 0; kk < 8; ++kk) { const bf16x8 av = *(const LAS bf16x8*)(QT + (32 * rb + r32) * 136 + 16 * kk + 8 * hi);
                o = __builtin_amdgcn_mfma_f32_32x32x16_bf16(av, sf[kk], o, 0, 0, 0); }
        }
        __syncthreads();
    }
#pragma unroll
    for (int r = 0; r < 16; ++r) { const int t = 32 * rb + (r & 3) + 8 * (r >> 2) + 4 * hi; L[t * 132 + 32 * cb + r32] = o[r]; }
    __syncthreads();
    {
        const int t = tid >> 3, eg = (tid & 7) * 16;
        f32x4 v[4]; float ss = 0.f;
#pragma unroll
        for (int q = 0; q < 4; ++q) { v[q] = *(const LAS f32x4*)(L + t * 132 + eg + 4 * q); ss += dot4(v[q]); }
        ss += __shfl_xor(ss, 1); ss += __shfl_xor(ss, 2); ss += __shfl_xor(ss, 4);
        const float rstd = rsqrtf(ss * (1.0f / 128.0f) + EPS);
        const u32x4* gs = (const u32x4*)(Z + (size_t)(row0 + t) * INWP + ZG + h * 128 + eg); const u32x4 ga = gs[0], gb = gs[1];
        const unsigned gw[8] = {ga.x, ga.y, ga.z, ga.w, gb.x, gb.y, gb.z, gb.w};
        const float* og = P.onorm_g + layer * 128 + eg;
        unsigned ow[8];
#pragma unroll
        for (int i = 0; i < 8; ++i) { const float g0 = bflo(gw[i]), g1 = bfhi(gw[i]);
            const float o0 = v[i >> 1][(i & 1) * 2] * rstd * og[2 * i] * siluf_(g0), o1 = v[i >> 1][(i & 1) * 2 + 1] * rstd * og[2 * i + 1] * siluf_(g1);
            ow[i] = cvt_pk_bf16(o0, o1); }
        bf16_t* mp = (bf16_t*)(P.ws + WS_MIX) + (size_t)(row0 + t) * DM + h * 128 + eg;
        *(u32x4*)(mp) = (u32x4){ow[0], ow[1], ow[2], ow[3]}; *(u32x4*)(mp + 8) = (u32x4){ow[4], ow[5], ow[6], ow[7]};
    }
    __syncthreads();
}

__device__ __forceinline__ void conf_item(LAS unsigned char* lds, const Params& P, int layer, int item, int tid, int lane, int wave) {
    const bf16_t* Z = (const bf16_t*)(P.ws + WS_Z);
    const int r0 = item * 16;
    const int s0 = r0 < ML ? (r0 & ~(SEQ - 1)) : ML + ((r0 - ML) & ~(CTX - 1)), s1 = s0 + (r0 < ML ? SEQ : CTX);
    LAS float* UB = (LAS float*)lds;
    LAS float* YB = (LAS float*)(lds + 46 * 512 * 4);
    const int c = tid;
    for (int i = 0; i < 46; ++i) { const int row = r0 - 15 + i; float u = 0.f;
        if (row >= s0 && row < s1) { const float a = bf2f(Z[(size_t)row * INWP + ZCA + c]), g = bf2f(Z[(size_t)row * INWP + ZCG + c]); u = a * sigmoidf_(g); }
        UB[i * 512 + c] = u; }
    float w[31];
#pragma unroll
    for (int j = 0; j < 31; ++j) w[j] = P.conf_dw[((size_t)layer * 31 + j) * 512 + c];
    const float bias = P.conf_dw_b[layer * 512 + c];
    LDS_WAIT();
#pragma unroll
    for (int g8 = 0; g8 < 2; ++g8) {
        float win[38];
#pragma unroll
        for (int i = 0; i < 38; ++i) win[i] = UB[(g8 * 8 + i) * 512 + c];
#pragma unroll
        for (int r = 0; r < 8; ++r) { float y = bias;
#pragma unroll
            for (int j = 0; j < 31; ++j) y += w[j] * win[r + j];
            YB[(g8 * 8 + r) * 512 + c] = y; }
    }
    __syncthreads();
    {
        const float* lg = P.conf_ln_g + layer * 512 + 8 * lane; const float* lb = P.conf_ln_b + layer * 512 + 8 * lane;
        const f32x4 g0 = *(const f32x4*)lg, g1 = *(const f32x4*)(lg + 4), b0 = *(const f32x4*)lb, b1 = *(const f32x4*)(lb + 4);
#pragma unroll
        for (int q = 0; q < 2; ++q) { const int t = 2 * wave + q;
            f32x4 y0 = *(const LAS f32x4*)(YB + t * 512 + 8 * lane), y1 = *(const LAS f32x4*)(YB + t * 512 + 8 * lane + 4);
            const float mean = wave_sum((y0[0] + y0[1]) + (y0[2] + y0[3]) + (y1[0] + y1[1]) + (y1[2] + y1[3])) * (1.0f / 512.0f);
            y0 = y0 - mean; y1 = y1 - mean;
            const float rstd = rsqrtf(wave_sum(dot4(y0) + dot4(y1)) * (1.0f / 512.0f) + EPS);
            y0 = y0 * rstd * g0 + b0; y1 = y1 * rstd * g1 + b1;
            u32x4 o; o.x = cvt_pk_bf16(siluf_(y0[0]), siluf_(y0[1])); o.y = cvt_pk_bf16(siluf_(y0[2]), siluf_(y0[3])); o.z = cvt_pk_bf16(siluf_(y1[0]), siluf_(y1[1])); o.w = cvt_pk_bf16(siluf_(y1[2]), siluf_(y1[3]));
            *(u32x4*)((bf16_t*)(P.ws + WS_MIX) + (size_t)(r0 + t) * DM + 512 + 8 * lane) = o; }
    }
    __syncthreads();
}
__device__ __forceinline__ void sconv_item(const Params& P, int layer, int item, int tid) {
    const bf16_t* Z = (const bf16_t*)(P.ws + WS_Z);
    const int row = item * 16 + (tid >> 5);
    const int s0 = row < ML ? (row & ~(SEQ - 1)) : ML + ((row - ML) & ~(CTX - 1)), s1 = s0 + (row < ML ? SEQ : CTX);
#pragma unroll
    for (int q = 0; q < 2; ++q) {
        const int c0 = ((tid & 31) + 32 * q) * 8;
        float acc[8];
#pragma unroll
        for (int i = 0; i < 8; ++i) acc[i] = 0.f;
#pragma unroll
        for (int j = 0; j < 3; ++j) { const int rr = row + j - 1;
            if (rr >= s0 && rr < s1) { const u32x4 cg = *(const u32x4*)(Z + (size_t)rr * INWP + ZSC + c0), hh = *(const u32x4*)(Z + (size_t)rr * INWP + ZSH + c0);
                const float* wp = P.sc_dw + ((size_t)layer * 3 + j) * 512 + c0; const f32x4 w0 = *(const f32x4*)wp, w1 = *(const f32x4*)(wp + 4);
                const unsigned cw[4] = {cg.x, cg.y, cg.z, cg.w}, hw[4] = {hh.x, hh.y, hh.z, hh.w};
#pragma unroll
                for (int i = 0; i < 4; ++i) { const float wa = i < 2 ? w0[2 * i] : w1[2 * i - 4], wb = i < 2 ? w0[2 * i + 1] : w1[2 * i - 3];
                    acc[2 * i] += wa * bflo(cw[i]) * bflo(hw[i]); acc[2 * i + 1] += wb * bfhi(cw[i]) * bfhi(hw[i]); } } }
        const u32x4 bg = *(const u32x4*)(Z + (size_t)row * INWP + ZSB + c0); const unsigned bw[4] = {bg.x, bg.y, bg.z, bg.w};
        u32x4 o; unsigned ow[4];
#pragma unroll
        for (int i = 0; i < 4; ++i) ow[i] = cvt_pk_bf16(bflo(bw[i]) * acc[2 * i], bfhi(bw[i]) * acc[2 * i + 1]);
        o.x = ow[0]; o.y = ow[1]; o.z = ow[2]; o.w = ow[3];
        *(u32x4*)((bf16_t*)(P.ws + WS_MIX) + (size_t)row * DM + 1024 + c0) = o;
    }
}

namespace att {
constexpr int NW = 8, QBLK = 32, KVBLK = 64;
constexpr float SCALE = 0.07216878364870322f;
constexpr float THR = 8.f;
constexpr int SHM_V = KVBLK * 128 * 2, SHM_K = KVBLK * 192 * 2;
constexpr int OFF_K = 2 * SHM_V, OFF_WS = OFF_K + 2 * SHM_K, OFF_QR = OFF_WS + 2048;
#define KSWZ(row, colB) ((row) * 384 + ((colB) ^ ((((row) >> 1) & 7) << 4)))
#define SBAR() __builtin_amdgcn_sched_barrier(0)
__device__ __forceinline__ int crow(int r, int hi) { return (r & 3) + 8 * (r >> 2) + 4 * hi; }
__device__ __forceinline__ void partialSM(f32x16& p0, f32x16& p1, float& m_reg, float& mn, float& alpha) {
    constexpr float C = SCALE * 1.4426950408889634f;
    float pmax = p0[0];
#pragma unroll
    for (int r = 1; r < 16; ++r) pmax = fmaxf(pmax, p0[r]);
#pragma unroll
    for (int r = 0; r < 16; ++r) pmax = fmaxf(pmax, p1[r]);
    { auto rr = __builtin_amdgcn_permlane32_swap(__float_as_uint(pmax), __float_as_uint(pmax), false, false);
      pmax = fmaxf(__uint_as_float(rr[0]), __uint_as_float(rr[1])); }
    if (__builtin_expect(__all(pmax - m_reg <= THR / SCALE), 1)) { mn = m_reg; alpha = 1.f; }
    else { mn = fmaxf(m_reg, pmax); alpha = __builtin_amdgcn_exp2f((m_reg - mn) * C); m_reg = mn; }
    const float mnC = -mn * C;
#pragma unroll
    for (int r = 0; r < 16; ++r) p0[r] = fmaf(p0[r], C, mnC);
#pragma unroll
    for (int r = 0; r < 16; ++r) p1[r] = fmaf(p1[r], C, mnC);
#pragma unroll
    for (int r = 0; r < 16; ++r) p0[r] = __builtin_amdgcn_exp2f(p0[r]);
}
__device__ __forceinline__ void finishSM(f32x16& p0, f32x16& p1, float alpha, float& l_reg, bf16x8& pa0, bf16x8& pa1, bf16x8& pa2, bf16x8& pa3) {
#pragma unroll
    for (int r = 0; r < 16; ++r) p1[r] = __builtin_amdgcn_exp2f(p1[r]);
    float ps = 0;
#pragma unroll
    for (int r = 0; r < 16; ++r) ps += p0[r];
#pragma unroll
    for (int r = 0; r < 16; ++r) ps += p1[r];
    { auto rr = __builtin_amdgcn_permlane32_swap(__float_as_uint(ps), __float_as_uint(ps), false, false);
      ps = __uint_as_float(rr[0]) + __uint_as_float(rr[1]); }
    l_reg = l_reg * alpha + ps;
#define PK4(Pv, BASE, OUT) do { unsigned a0 = cvt_pk_bf16(Pv[BASE + 0], Pv[BASE + 1]), a1 = cvt_pk_bf16(Pv[BASE + 2], Pv[BASE + 3]);   \
    unsigned b0 = cvt_pk_bf16(Pv[BASE + 4], Pv[BASE + 5]), b1 = cvt_pk_bf16(Pv[BASE + 6], Pv[BASE + 7]);                              \
    auto r0 = __builtin_amdgcn_permlane32_swap(a0, b0, false, false); auto r1 = __builtin_amdgcn_permlane32_swap(a1, b1, false, false); \
    u32x4 w = {r0[0], r1[0], r0[1], r1[1]}; OUT = *reinterpret_cast<bf16x8*>(&w); } while (0)
    PK4(p0, 0, pa0); PK4(p0, 8, pa1); PK4(p1, 0, pa2); PK4(p1, 8, pa3);
#undef PK4
}
__device__ __forceinline__ void qkt(f32x16& p0, f32x16& p1, const LAS unsigned char* Ks, const bf16x8* qr, const LAS unsigned char* qrp, int qsw, const int (&kq)[4], int hi) {
    p0 = f32x16{}; p1 = f32x16{};
#pragma unroll
    for (int d0 = 0; d0 < 12; ++d0) {
        const bf16x8 b0 = *(const LAS bf16x8*)(Ks + kq[d0 & 3] + 128 * (d0 >> 2));
        const bf16x8 b1 = *(const LAS bf16x8*)(Ks + kq[d0 & 3] + 128 * (d0 >> 2) + 32 * 384);
        bf16x8 qv; if (d0 < 8) qv = qr[d0]; else qv = *(const LAS bf16x8*)(qrp + (((2 * (d0 - 8) + hi) ^ qsw) << 4));
        p0 = __builtin_amdgcn_mfma_f32_32x32x16_bf16(b0, qv, p0, 0, 0, 0);
        p1 = __builtin_amdgcn_mfma_f32_32x32x16_bf16(b1, qv, p1, 0, 0, 0); }
}
__device__ __forceinline__ int v_st(int k, int c) { const int kk = (k & ~0xC) | ((k & 4) << 1) | ((k & 8) >> 1); return ((kk >> 3) * 4 + (c >> 5)) * 512 + ((kk & 7) * 32 + (c & 31)) * 2; }
__device__ __forceinline__ int v_rd_base(int lane) { return ((lane & 3) << 3) | (((lane >> 2) & 3) << 6) | (((lane >> 4) & 1) << 5) | (((lane >> 5) & 1) << 8); }
constexpr int v_rd_off(int d0, int ks, int half) { return d0 * 512 + ks * 4096 + half * 2048; }
template <int OFF> __device__ __forceinline__ s16x4 tr_read(int vb) {
    s16x4 r; asm volatile("ds_read_b64_tr_b16 %0, %1 offset:%2" : "=&v"(r) : "v"(vb), "i"(OFF) : "memory"); return r;
}
template <int D0> __device__ __forceinline__ void pv_one(f32x16& od, int vb, bf16x8 pa0, bf16x8 pa1, bf16x8 pa2, bf16x8 pa3) {
    const s16x4 l0 = tr_read<v_rd_off(D0, 0, 0)>(vb), h0 = tr_read<v_rd_off(D0, 0, 1)>(vb), l1 = tr_read<v_rd_off(D0, 1, 0)>(vb), h1 = tr_read<v_rd_off(D0, 1, 1)>(vb);
    const s16x4 l2 = tr_read<v_rd_off(D0, 2, 0)>(vb), h2 = tr_read<v_rd_off(D0, 2, 1)>(vb), l3 = tr_read<v_rd_off(D0, 3, 0)>(vb), h3 = tr_read<v_rd_off(D0, 3, 1)>(vb);
    asm volatile("s_waitcnt lgkmcnt(0)" ::: "memory"); SBAR();
#define PK(Lo, Hi) (bf16x8){Lo[0], Lo[1], Lo[2], Lo[3], Hi[0], Hi[1], Hi[2], Hi[3]}
    od = __builtin_amdgcn_mfma_f32_32x32x16_bf16(pa0, PK(l0, h0), od, 0, 0, 0);
    od = __builtin_amdgcn_mfma_f32_32x32x16_bf16(pa1, PK(l1, h1), od, 0, 0, 0);
    od = __builtin_amdgcn_mfma_f32_32x32x16_bf16(pa2, PK(l2, h2), od, 0, 0, 0);
    od = __builtin_amdgcn_mfma_f32_32x32x16_bf16(pa3, PK(l3, h3), od, 0, 0, 0);
#undef PK
}
__device__ __forceinline__ void pv_d0(f32x16* o, int vb, bf16x8 pa0, bf16x8 pa1, bf16x8 pa2, bf16x8 pa3) {
    pv_one<0>(o[0], vb, pa0, pa1, pa2, pa3); pv_one<1>(o[1], vb, pa0, pa1, pa2, pa3); pv_one<2>(o[2], vb, pa0, pa1, pa2, pa3); pv_one<3>(o[3], vb, pa0, pa1, pa2, pa3);
}
template <bool DIRECT>
__device__ __forceinline__ void attn_unit(LAS unsigned char* lds, const bf16_t* QKV, const bf16_t* Z, int qrow0, int h, int crow0, int lrow0, int t0, int NT,
                                          float* Opart, float* Lse, bf16_t* MIX, const int tid) {
    const int wid = tid >> 6, lane = tid & 63, r32 = lane & 31, hi = lane >> 5;
    LAS unsigned char* V_lds = lds; LAS unsigned char* K_lds = lds + OFF_K;
    LAS float* ws = (LAS float*)(lds + OFF_WS) + wid * 64; LAS float* li_l = ws; LAS float* al_l = ws + 32;
    float m_reg = -1e30f, l_reg = 0; f32x16 o[4] = {}; bf16x8 qr[8];
    const bf16_t* Qw = QKV + (size_t)(qrow0 + wid * QBLK + r32) * NUP + h * 192 + hi * 8;
#pragma unroll
    for (int d0 = 0; d0 < 8; ++d0) qr[d0] = *(const bf16x8*)(Qw + d0 * 16);
    LAS unsigned char* qrp = lds + OFF_QR + wid * 4096 + r32 * 128; const int qsw = (r32 >> 1) & 7;
    int kq[4];
#pragma unroll
    for (int q = 0; q < 4; ++q) kq[q] = 384 * r32 + (((2 * q + hi) ^ qsw) << 4);
#pragma unroll
    for (int d0 = 8; d0 < 12; ++d0) *(LAS bf16x8*)(qrp + (((2 * (d0 - 8) + hi) ^ qsw) << 4)) = *(const bf16x8*)(Qw + d0 * 16);
    const int sr = tid >> 4, sc = (tid & 15) * 8;
    const int vst0 = v_st(sr, sc);
    const int kst0 = KSWZ(sr, sc * 2);
    const int krst = KSWZ(tid >> 3, 256 + (tid & 7) * 16);
    const unsigned voffV = (unsigned)(sr * NUP + sc) * 2u, voffR = (unsigned)((tid >> 3) * INWP + (tid & 7) * 8) * 2u;
    const char* Vb = (const char*)(QKV + 768 + h * 256 + 128); const char* Kb = (const char*)(QKV + 768 + h * 256); const char* Rb = (const char*)(Z + ZKR);
    const int vb0 = (int)(uintptr_t)V_lds + v_rd_base(lane);
    bf16x8 vs0, vs1, ks0, ks1, ks2;
#define ROW0(kt) (((t0) + (kt)) < 4 ? crow0 + 64 * ((t0) + (kt)) : lrow0 + 64 * ((t0) + (kt) - 4))
#define SLOADV(kt) do { const size_t _r0 = (size_t)__builtin_amdgcn_readfirstlane(ROW0(kt)); const char* _v = Vb + _r0 * (NUP * 2) + voffV; \
    vs0 = *(const bf16x8*)(_v); vs1 = *(const bf16x8*)(_v + 32 * NUP * 2); } while (0)
#define SLOADK(kt) do { const size_t _r0 = (size_t)__builtin_amdgcn_readfirstlane(ROW0(kt)); const char* _k = Kb + _r0 * (NUP * 2) + voffV; \
    ks0 = *(const bf16x8*)(_k); ks1 = *(const bf16x8*)(_k + 32 * NUP * 2); ks2 = *(const bf16x8*)(Rb + _r0 * (INWP * 2) + voffR); } while (0)
#define SLOAD(kt) do { SLOADV(kt); SLOADK(kt); } while (0)
#define SWRITE(b) do { *(LAS bf16x8*)(V_lds + (b) * SHM_V + vst0) = vs0; *(LAS bf16x8*)(V_lds + (b) * SHM_V + vst0 + 8192) = vs1; \
    *(LAS bf16x8*)(K_lds + (b) * SHM_K + kst0) = ks0; *(LAS bf16x8*)(K_lds + (b) * SHM_K + kst0 + 32 * 384) = ks1; *(LAS bf16x8*)(K_lds + (b) * SHM_K + krst) = ks2; } while (0)
#define SWAIT() asm volatile("s_waitcnt vmcnt(0)" ::: "memory")
#define RESC(a) do { if (__any((a) < 1.f)) { if (hi == 0) al_l[r32] = (a); asm volatile("s_waitcnt lgkmcnt(0)" ::: "memory"); \
    _Pragma("unroll") for (int d = 0; d < 4; ++d) _Pragma("unroll") for (int r = 0; r < 16; ++r) o[d][r] *= al_l[crow(r, hi)]; } } while (0)
    f32x16 pA0, pA1, pB0, pB1; float mnA, mnB, alA, alB; bf16x8 pa0, pa1, pa2, pa3;
    SLOAD(0); SWAIT(); SWRITE(0); __syncthreads();
    qkt(pA0, pA1, K_lds, qr, qrp, qsw, kq, hi); partialSM(pA0, pA1, m_reg, mnA, alA);
    SLOAD(1);
    SWAIT(); SWRITE(1); __syncthreads();
    for (int j = 1; j + 1 < NT; j += 2) {
        SBAR(); qkt(pB0, pB1, K_lds + SHM_K, qr, qrp, qsw, kq, hi);
        finishSM(pA0, pA1, alA, l_reg, pa0, pa1, pa2, pa3); SBAR();
        SLOADV(j + 1); SBAR();
        pv_d0(o, vb0, pa0, pa1, pa2, pa3); SBAR(); SLOADK(j + 1); SBAR(); partialSM(pB0, pB1, m_reg, mnB, alB);
        __syncthreads(); SWAIT(); SWRITE(0);
        RESC(alB); __syncthreads();
        SBAR(); qkt(pA0, pA1, K_lds, qr, qrp, qsw, kq, hi);
        finishSM(pB0, pB1, alB, l_reg, pa0, pa1, pa2, pa3); SBAR();
        SLOADV(j + 2); SBAR();
        pv_d0(o, vb0 + SHM_V, pa0, pa1, pa2, pa3); SBAR(); SLOADK(j + 2); SBAR(); partialSM(pA0, pA1, m_reg, mnA, alA);
        __syncthreads(); SWAIT(); SWRITE(1);
        RESC(alA); __syncthreads();
    }
    SBAR(); qkt(pB0, pB1, K_lds + SHM_K, qr, qrp, qsw, kq, hi);
    finishSM(pA0, pA1, alA, l_reg, pa0, pa1, pa2, pa3); SBAR();
    pv_d0(o, vb0, pa0, pa1, pa2, pa3); partialSM(pB0, pB1, m_reg, mnB, alB);
    __syncthreads(); RESC(alB);
    finishSM(pB0, pB1, alB, l_reg, pa0, pa1, pa2, pa3); SBAR();
    pv_d0(o, vb0 + SHM_V, pa0, pa1, pa2, pa3);
    if (hi == 0) li_l[r32] = l_reg; asm volatile("s_waitcnt lgkmcnt(0)" ::: "memory");
    float rli[16];
#pragma unroll
    for (int r = 0; r < 16; ++r) rli[r] = __builtin_amdgcn_rcpf(li_l[crow(r, hi)]);
    const int qw0 = qrow0 + wid * QBLK;
    if constexpr (DIRECT) {
#pragma unroll
        for (int r = 0; r < 16; ++r) { const int orow = crow(r, hi);
#pragma unroll
            for (int d0 = 0; d0 < 4; ++d0) MIX[(size_t)(qw0 + orow) * DM + 1536 + h * 128 + d0 * 32 + r32] = f2bf(o[d0][r] * rli[r]); }
    } else {
#pragma unroll
        for (int r = 0; r < 16; ++r) { const int orow = crow(r, hi);
#pragma unroll
            for (int d0 = 0; d0 < 4; ++d0) Opart[(size_t)(qw0 + orow) * 512 + h * 128 + d0 * 32 + r32] = o[d0][r] * rli[r]; }
        if (hi == 0) Lse[(size_t)(qw0 + r32) * 4 + h] = m_reg * (SCALE * 1.4426950408889634f) + __builtin_amdgcn_logf(l_reg);
    }
    __syncthreads();
#undef ROW0
#undef SLOAD
#undef SWRITE
#undef SWAIT
#undef RESC
}
#undef KSWZ
#undef SBAR
}

__device__ __forceinline__ void attn_combine(const Params& P, int tid, int G, int bid) {
    const float* OP = (const float*)(P.ws + WS_OP); const float* LS = (const float*)(P.ws + WS_LSE); bf16_t* MIX = (bf16_t*)(P.ws + WS_MIX);
    for (int i = bid * 512 + tid; i < ML * 64; i += G * 512) {
        const int row = i >> 6, rem = i & 63, h = rem >> 4, cg = (rem & 15) * 8;
        const float l1 = LS[(size_t)row * 4 + h], l2 = LS[((size_t)ML + row) * 4 + h], m = fmaxf(l1, l2);
        float w1 = __builtin_amdgcn_exp2f(l1 - m), w2 = __builtin_amdgcn_exp2f(l2 - m); const float inv = 1.0f / (w1 + w2); w1 *= inv; w2 *= inv;
        const float* a = OP + (size_t)row * 512 + h * 128 + cg; const float* b = OP + ((size_t)ML + row) * 512 + h * 128 + cg;
        const f32x4 a0 = *(const f32x4*)a, a1 = *(const f32x4*)(a + 4), b0 = *(const f32x4*)b, b1 = *(const f32x4*)(b + 4);
        const f32x4 o0 = a0 * w1 + b0 * w2, o1 = a1 * w1 + b1 * w2;
        u32x4 w; w.x = cvt_pk_bf16(o0[0], o0[1]); w.y = cvt_pk_bf16(o0[2], o0[3]); w.z = cvt_pk_bf16(o1[0], o1[1]); w.w = cvt_pk_bf16(o1[2], o1[3]);
        *(u32x4*)(MIX + (size_t)row * DM + 1536 + h * 128 + cg) = w;
    }
}

constexpr int PH_PER_LAYER = 9, N_PHASES = 2 + DEPTH * PH_PER_LAYER + 1;
typedef const __attribute__((address_space(4))) Params* KParams;
__global__ void __launch_bounds__(512, 2) mk_fwd(Params Pk) {
    extern __shared__ __attribute__((aligned(16))) unsigned char lds_raw[];
    LAS unsigned char* lds = (LAS unsigned char*)lds_raw;
    const int G = gridDim.x, bid = blockIdx.x;
    KParams kp0 = (KParams)__builtin_amdgcn_kernarg_segment_ptr();
    const int wave0 = __builtin_amdgcn_readfirstlane(threadIdx.x >> 6);
#define OPQ int tid; asm volatile("v_mbcnt_lo_u32_b32 %0, -1, 0\n\tv_mbcnt_hi_u32_b32 %0, -1, %0" : "=v"(tid)); tid |= wave0 << 6; const int lane = tid & 63, wave = __builtin_amdgcn_readfirstlane(tid >> 6); (void)lane; (void)wave; \
    KParams kp = kp0; asm volatile("" : "+s"(kp)); Params P; { const __attribute__((address_space(4))) unsigned long long* _q = (const __attribute__((address_space(4))) unsigned long long*)kp; unsigned long long* _d = (unsigned long long*)&P; \
      _Pragma("unroll") for (int _i = 0; _i < (int)(sizeof(Params) / 8); ++_i) _d[_i] = _q[_i]; } unsigned char* const ws = P.ws; (void)ws;
    volatile LAS unsigned* MISC = (volatile LAS unsigned*)(lds + LDS_MISC);
    for (int u = threadIdx.x; u < 256; u += 512) ((LAS unsigned*)(lds + LDS_MISC))[u] = 0u;
    __syncthreads();
    const int lo = kp0->ph_lo, hi = kp0->ph_hi;
    XcdBarrier bar; bar.bar = (unsigned*)(kp0->ws + WS_CTL) + 1024; bar.x = 0; bar.st = nullptr;
    if (hi - lo > 1) bar = xcd_barrier_post((unsigned*)(kp0->ws + WS_CTL) + 1024, MISC + 8);
#define IN(k) (lo <= (k) && (k) < hi)
#define SEAM(k) do { if (IN(k) && IN((k) + 1)) xcd_barrier(bar); } while (0)
#define XRES ((float*)(ws + WS_XRES))
#define MODL ((const float*)(ws + WS_MODV) + (size_t)layer * 3 * 6 * DM)
#define RSTAT ((float*)(ws + WS_RSTAT) + (size_t)layer * MT * 2)
#define ROPE ((const f32x2*)(ws + WS_ROPE))
#define HB ((bf16_t*)(ws + WS_H))
#define ZB ((bf16_t*)(ws + WS_Z))
#define QKVB ((bf16_t*)(ws + WS_QKV))
#define MIXB ((bf16_t*)(ws + WS_MIX))
#define UB_ ((bf16_t*)(ws + WS_U))

    if (PHM(0) && IN(0)) { OPQ phase_p0a(P, lds, tid, lane, wave, G, bid); } SEAM(0);
    if (PHM(1) && IN(1)) { OPQ phase_p0b(P, tid, G, bid); } SEAM(1);

    for (int layer = 0; layer < DEPTH; ++layer) {
        const int pb = 2 + layer * PH_PER_LAYER;
        const bool need_ctx = layer < DEPTH - 1;
        const int mrows = need_ctx ? MT : ML;

        if (PHM(2) && IN(pb + 0)) { OPQ
            const float* xl = layer == 0 ? P.x : XRES; const float* xc = layer == 0 ? P.ctx : XRES + (size_t)ML * DM;
            phase_norm(xl, xc, MODL, 1, 0, HB, MT, lane, wave, G, bid); } SEAM(pb + 0);
        if (PHM(3) && IN(pb + 1)) { OPQ
            pg8::Gemm g{HB, (const bf16_t*)(ws + WS_WIN) + (size_t)layer * INWP * DM, MT, INWP, DM, DM, DM}; pg8::StaticOrder S; S.init(MT, INWP, G, bid);
            pg8::EpiIn E{ZB, RSTAT, ROPE};
            pg8::gemm_phase<pg8::EpiIn, pg8::StaticOrder>(lds, g, S, E, tid);
        } SEAM(pb + 1);
        if (IN(pb + 2)) { OPQ
            if (PHM(4)) {
                pg8::Gemm g{ZB + ZCQ, (const bf16_t*)(ws + WS_WUP) + (size_t)layer * NUP * KUP, MT, NUP, KUP, INWP, KUP}; pg8::StaticOrder S; S.init(MT, NUP, G, bid);
                pg8::EpiUp E{QKVB, RSTAT, ROPE};
                pg8::gemm_phase<pg8::EpiUp, pg8::StaticOrder>(lds, g, S, E, tid);
            }
            constexpr int N_G1 = 2 * 4 * 2 * NCH, N_CF = MT / 16, N_SC = MT / 16;
            const int nup_units = (MT / 256) * (NUP / 256);
            int start = bid - (nup_units % G); if (start < 0) start += G;
            for (int it = start; it < N_G1 + N_CF + N_SC; it += G) {
                if (it < N_G1) { if (PHM(5)) gla_g1_item(lds, P, layer, it, tid, lane, wave); }
                else if (it < N_G1 + N_CF) { if (PHM(6)) conf_item(lds, P, layer, it - N_G1, tid, lane, wave); }
                else { if (PHM(7)) sconv_item(P, layer, it - N_G1 - N_CF, tid); }
            }
        } SEAM(pb + 2);
        if (IN(pb + 3)) { OPQ
            if (PHM(8)) gla_g2(P, tid, G, bid);
            if (PHM(9)) for (int u = bid; u < 256; u += G) {
                const int bh = u & 7, sub = u >> 3, b = bh >> 2, h = bh & 3, qb = sub >> 1, half = sub & 1;
                att::attn_unit<false>(lds, QKVB, ZB, b * SEQ + qb * 256, h, ML + b * CTX, b * SEQ, half * 34, 34,
                                      (float*)(ws + WS_OP) + (size_t)half * ML * 512, (float*)(ws + WS_LSE) + (size_t)half * ML * 4, MIXB, tid);
            }
        } SEAM(pb + 3);
        if (IN(pb + 4)) { OPQ
            if (PHM(10)) for (int it = bid; it < 2 * 4 * NCH; it += G) gla_g3_item(lds, P, layer, it, tid, lane, wave);
            if (PHM(11)) attn_combine(P, tid, G, bid);
            if (PHM(12) && need_ctx) {
                int start = bid - ((2 * 4 * NCH) % G); if (start < 0) start += G;
                for (int u = start; u < 8; u += G) { const int b = u >> 2, h = u & 3;
                    att::attn_unit<true>(lds, QKVB, ZB, ML + b * CTX, h, ML + b * CTX, 0, 0, 4, nullptr, nullptr, MIXB, tid); }
            }
        } SEAM(pb + 4);
        if (PHM(13) && IN(pb + 5)) { OPQ
            const float* xl = layer == 0 ? P.x : XRES; const float* xc = layer == 0 ? P.ctx : XRES + (size_t)ML * DM;
            pg8::Gemm g{MIXB, (const bf16_t*)(ws + WS_WOUT) + (size_t)layer * DM * DM, mrows, DM, DM, DM, DM}; pg8::StaticOrder S; S.init(mrows, DM, G, bid);
            pg8::EpiRes E{xl, xc, XRES, MODL + 2 * DM};
            pg8::gemm_phase<pg8::EpiRes, pg8::StaticOrder>(lds, g, S, E, tid);
        } SEAM(pb + 5);
        if (PHM(2) && IN(pb + 6)) { OPQ phase_norm(XRES, XRES + (size_t)ML * DM, MODL, 4, 3, HB, mrows, lane, wave, G, bid); } SEAM(pb + 6);
        if (PHM(14) && IN(pb + 7)) { OPQ
            pg8::Gemm g{HB, (const bf16_t*)(ws + WS_W13) + (size_t)layer * 2 * DFF * DM, mrows, 2 * DFF, DM, DM, DM}; pg8::StaticOrder S; S.init(mrows, 2 * DFF, G, bid);
            pg8::EpiSwiglu E{UB_};
            pg8::gemm_phase<pg8::EpiSwiglu, pg8::StaticOrder>(lds, g, S, E, tid);
        } SEAM(pb + 7);
        if (PHM(15) && IN(pb + 8)) { OPQ
            pg8::Gemm g{UB_, (const bf16_t*)(ws + WS_W2) + (size_t)layer * DM * DFF, mrows, DM, DFF, DFF, DFF}; pg8::StaticOrder S; S.init(mrows, DM, G, bid);
            pg8::EpiRes E{XRES, XRES + (size_t)ML * DM, XRES, MODL + 5 * DM};
            pg8::gemm_phase<pg8::EpiRes, pg8::StaticOrder>(lds, g, S, E, tid);
        } SEAM(pb + 8);
    }
    if (PHM(16) && IN(N_PHASES - 1)) { OPQ phase_final(XRES, P.final_g, P.out, lane, wave, G, bid); }
#undef IN
#undef SEAM
}

extern "C" void kernel_launch(void* const* d_in, const int* in_sizes, int n_in, void* d_out, int out_size, void* d_ws, size_t ws_size, hipStream_t stream) {
    static int grid = 0;
    if (grid == 0) {
        if (n_in != 26 || in_sizes[0] != ML * DM || out_size != ML * DM || ws_size < WS_END) {
            fprintf(stderr, "kernel_launch: shape mismatch: n_in %d in0 %d out %d ws %zu (need %zu); nothing launched\n", n_in, n_in > 0 ? in_sizes[0] : -1, out_size, ws_size, (size_t)WS_END); grid = -1; return; }
        int dev = 0, cus = 0, per_cu = 0;
        if (hipGetDevice(&dev) != hipSuccess || hipDeviceGetAttribute(&cus, hipDeviceAttributeMultiprocessorCount, dev) != hipSuccess) { fprintf(stderr, "kernel_launch: device query failed\n"); grid = -1; return; }
        if (hipFuncSetAttribute((const void*)mk_fwd, hipFuncAttributeMaxDynamicSharedMemorySize, LDS_BYTES) != hipSuccess) { fprintf(stderr, "kernel_launch: hipFuncSetAttribute failed\n"); grid = -1; return; }
        if (hipOccupancyMaxActiveBlocksPerMultiprocessor(&per_cu, (const void*)mk_fwd, 512, LDS_BYTES) != hipSuccess || per_cu < 1)
            fprintf(stderr, "kernel_launch: note: occupancy query reports %d workgroups per CU\n", per_cu);
        (void)hipGetLastError();
        grid = cus;
    }
    if (grid < 0) return;
    if (hipMemsetAsync((char*)d_ws + WS_CTL, 0, CTL_BYTES, stream) != hipSuccess) { fprintf(stderr, "kernel_launch: memset failed\n"); return; }
    Params p{};
    const float** pp = (const float**)&p;
    for (int i = 0; i < 26; ++i) pp[i] = (const float*)d_in[i];
    p.out = (float*)d_out; p.ws = (unsigned char*)d_ws;
#if MK_MULTI
    for (int ph = 0; ph < N_PHASES; ++ph) { p.ph_lo = ph; p.ph_hi = ph + 1; hipLaunchKernelGGL(mk_fwd, dim3(grid), dim3(512), LDS_BYTES, stream, p); }
#else
    p.ph_lo = 0; p.ph_hi = N_PHASES;
    hipLaunchKernelGGL(mk_fwd, dim3(grid), dim3(512), LDS_BYTES, stream, p);
#endif
    const hipError_t le = hipPeekAtLastError();
    if (le != hipSuccess) fprintf(stderr, "kernel_launch: launch failed: %s\n", hipGetErrorName(le));
}
```

```cpp
#include <hip/hip_runtime.h>
#include <cstdio>
#include <cstdint>

#ifndef MK_MULTI
#define MK_MULTI 0
#endif

#ifndef PH_MASK
#define PH_MASK 0xFFFFFFFFu
#endif
#define PHM(b) ((PH_MASK >> (b)) & 1u)
#define LAS __attribute__((address_space(3)))
#define GAS __attribute__((address_space(1)))
typedef unsigned short bf16_t;
typedef short bf16x8 __attribute__((ext_vector_type(8)));
typedef short s16x4 __attribute__((ext_vector_type(4)));
typedef float f32x4 __attribute__((ext_vector_type(4)));
typedef float f32x2 __attribute__((ext_vector_type(2)));
typedef float f32x16 __attribute__((ext_vector_type(16)));
typedef unsigned u32x4 __attribute__((ext_vector_type(4)));
typedef unsigned u32x2 __attribute__((ext_vector_type(2)));

constexpr int DM = 2048, NB = 2, SEQ = 4096, CTX = 256, DEPTH = 4, DFF = 5632;
constexpr int ML = NB * SEQ, MC = NB * CTX, MT = ML + MC;
constexpr int INW = 5216, INWP = 5376;
constexpr int ZQ = 0, ZK = 512, ZV = 1024, ZG = 1536, ZLR = 2048, ZCA = 2080, ZCG = 2592, ZSB = 3104, ZSC = 3616, ZSH = 4128, ZCQ = 4640, ZCKV = 5024, ZKR = 5152;
constexpr int NUP = 1792, KUP = 512;
constexpr int NCH = 68;
constexpr float EPS = 1e-6f;

constexpr size_t al256(size_t x) { return (x + 255) / 256 * 256; }
constexpr size_t WS_CTL = 0, CTL_BYTES = 1u << 20;
constexpr size_t WS_ROPE = WS_CTL + CTL_BYTES;
constexpr size_t WS_MODP = WS_ROPE + 8192;
constexpr size_t WS_MODV = WS_MODP + al256((size_t)8 * 4 * 3 * 12288 * 4);
constexpr size_t WS_RSTAT = WS_MODV + al256((size_t)4 * 3 * 6 * 2048 * 4);
constexpr size_t WS_WIN = WS_RSTAT + al256((size_t)4 * MT * 2 * 4);
constexpr size_t WS_WOUT = WS_WIN + (size_t)4 * INWP * DM * 2;
constexpr size_t WS_W13 = WS_WOUT + (size_t)4 * DM * DM * 2;
constexpr size_t WS_W2 = WS_W13 + (size_t)4 * 2 * DFF * DM * 2;
constexpr size_t WS_WUP = WS_W2 + (size_t)4 * DM * DFF * 2;
constexpr size_t WS_XRES = WS_WUP + (size_t)4 * NUP * KUP * 2;
constexpr size_t WS_H = WS_XRES + (size_t)MT * DM * 4;
constexpr size_t WS_Z = WS_H + (size_t)MT * DM * 2;
constexpr size_t WS_QKV = WS_Z + (size_t)MT * INWP * 2;
constexpr size_t WS_MIX = WS_QKV + (size_t)MT * NUP * 2;
constexpr size_t WS_U = WS_MIX + (size_t)MT * DM * 2;
constexpr size_t WS_GU = WS_U + (size_t)MT * DFF * 2;
constexpr size_t WS_GD = WS_GU + (size_t)16 * NCH * 16384 * 4;
constexpr size_t WS_GS = WS_GD + (size_t)16 * NCH * 128 * 4;
constexpr size_t WS_OP = WS_GS + (size_t)16 * NCH * 16384 * 2;
constexpr size_t WS_LSE = WS_OP + (size_t)2 * ML * 512 * 4;
constexpr size_t WS_END = WS_LSE + (size_t)2 * ML * 4 * 4;

constexpr int LDS_MAIN = 131072, LDS_MISC = LDS_MAIN, LDS_BYTES = LDS_MAIN + 1024;

__device__ __forceinline__ unsigned cvt_pk_bf16(float lo, float hi) { unsigned r; asm volatile("v_cvt_pk_bf16_f32 %0, %1, %2" : "=v"(r) : "v"(lo), "v"(hi)); return r; }
__device__ __forceinline__ float bf2f(unsigned short b) { return __uint_as_float(((unsigned)b) << 16); }
__device__ __forceinline__ float bflo(unsigned w) { return __uint_as_float(w << 16); }
__device__ __forceinline__ float bfhi(unsigned w) { return __uint_as_float(w & 0xffff0000u); }
__device__ __forceinline__ unsigned short f2bf(float f) { return (unsigned short)(cvt_pk_bf16(f, 0.f) & 0xffffu); }
__device__ __forceinline__ float wave_sum(float v) {
#pragma unroll
    for (int o = 1; o < 64; o <<= 1) v += __shfl_xor(v, o);
    return v;
}
__device__ __forceinline__ float sigmoidf_(float x) { return 1.0f / (1.0f + __expf(-x)); }
__device__ __forceinline__ float siluf_(float x) { return x / (1.0f + __expf(-x)); }
__device__ __forceinline__ float dot4(const f32x4& v) { return (v[0] * v[0] + v[1] * v[1]) + (v[2] * v[2] + v[3] * v[3]); }
#define LDS_WAIT() asm volatile("s_waitcnt lgkmcnt(0)" ::: "memory")
#define VM_WAIT() asm volatile("s_waitcnt vmcnt(0)" ::: "memory")

namespace pg8 {
#define PG8_LAS __attribute__((address_space(3)))
constexpr int BM = 256, BK = 64, HALF = 128, HTB = HALF * BK * 2, STAGE_BYTES = 8 * HTB, NXCD = 8, WGM = 8;
__host__ __device__ __forceinline__ int lds_byte(int r, int c) { const int st = (r >> 4) * 2 + (c >> 5), rr = r & 15, cc = c & 31, ob = rr * 64 + cc * 2; return st * 1024 + (ob ^ (((ob >> 9) & 1) << 5)); }
__host__ __device__ __forceinline__ void stage_rc(int b, int& R, int& C) { const int st = b / 1024, sb = b % 1024, swz = sb ^ (((sb >> 9) & 1) << 5); R = (st >> 1) * 16 + swz / 64; C = (st & 1) * 32 + (swz % 64) / 2; }
__host__ __device__ __forceinline__ int perm32(int rho) { const int n = rho >> 4, i = rho & 15; return 8 * (i >> 2) + 4 * n + (i & 3); }
struct Unit { int pm, pn; };
struct Gemm { const bf16_t* A; const bf16_t* Bt; int M, N, K, lda, ldb; };
struct StaticOrder {
    int nM, nN, nwg, G, c;
    __host__ __device__ void init(int M, int N, int G_, int c_) { nM = M / BM; nN = N / BM; nwg = nM * nN; G = G_; c = c_; }
    __host__ __device__ bool next(int i, Unit& u) const {
        const long L = (long)i * G + c; if (L >= nwg) return false;
        int wgid = (int)L; { const int q = nwg / NXCD, r = nwg % NXCD, xcd = wgid % NXCD, off = wgid / NXCD; wgid = (xcd < r ? xcd * (q + 1) : r * (q + 1) + (xcd - r) * q) + off; }
        const int nig = WGM * nN, gid = wgid / nig, fm = gid * WGM, gsz = (nM - fm) < WGM ? (nM - fm) : WGM;
        u.pm = fm + ((wgid % nig) % gsz); u.pn = (wgid % nig) / gsz; return true;
    }
    __device__ __forceinline__ void a_ready(const Unit&) const {}
    __device__ __forceinline__ void done(const Unit&) const {}
};
template <class Epi, class Sched, bool ALIGN_EPI = true, bool SP2 = true>
__device__ __forceinline__ void gemm_phase(PG8_LAS unsigned char* lds, const Gemm g, const Sched& S, const Epi& E, const int tid) {
    const int wid = __builtin_amdgcn_readfirstlane(tid >> 6), lane = tid & 63, wr = wid >> 2, wc = wid & 3, fr = lane & 15, fq = lane >> 4;
    const int K = g.K, nt = K / BK;
    unsigned voffA[2], voffB[2];
#pragma unroll
    for (int i = 0; i < 2; ++i) { int R, C; stage_rc(tid * 16 + i * 8192, R, C); const int Rb = Epi::PERM ? ((R & ~31) + perm32(R & 31)) : R;
        voffA[i] = (unsigned)(R * g.lda + C) * 2u; voffB[i] = (unsigned)(Rb * g.ldb + C) * 2u; }
    const size_t kstep = (size_t)(BK * 2);
    const size_t hstepA = (size_t)HALF * g.lda * 2, hstepB = (size_t)HALF * g.ldb * 2;
    const size_t tstepA = 2 * hstepA, tstepB = 2 * hstepB;
    const unsigned ldsw = (unsigned)wid * 1024u;
    const int aoff = lds_byte(wr * 64 + fr, fq * 8), boff = lds_byte(wc * 32 + fr, fq * 8);
#define PG8_SA(b, h) (((b) * 2 + (h)) * HTB)
#define PG8_SB(b, h) ((4 + (b) * 2 + (h)) * HTB)
#define PG8_STAGE(bufoff, gbase, voff) do { _Pragma("unroll") for (int _i = 0; _i < 2; ++_i) \
        __builtin_amdgcn_global_load_lds((const unsigned*)((const char*)(gbase) + (voff)[_i]), (PG8_LAS unsigned*)(lds + (bufoff) + ldsw + _i * 8192), 16, 0, 0); } while (0)
#define PG8_LDA(dst, b, h) do { _Pragma("unroll") for (int m = 0; m < 4; ++m) _Pragma("unroll") for (int k = 0; k < 2; ++k) dst[m][k] = *(const PG8_LAS bf16x8*)(lds + PG8_SA(b, h) + aoff + m * 2048 + k * 1024); } while (0)
#define PG8_LDB(dst, b, h) do { _Pragma("unroll") for (int n = 0; n < 2; ++n) _Pragma("unroll") for (int k = 0; k < 2; ++k) dst[n][k] = *(const PG8_LAS bf16x8*)(lds + PG8_SB(b, h) + boff + n * 2048 + k * 1024); } while (0)
#define PG8_MMA(ai, bj, At, Bt) do { __builtin_amdgcn_s_setprio(1); _Pragma("unroll") for (int m = 0; m < 4; ++m) _Pragma("unroll") for (int n = 0; n < 2; ++n) _Pragma("unroll") for (int k = 0; k < 2; ++k) \
        acc[ai][bj][m][n] = __builtin_amdgcn_mfma_f32_16x16x32_bf16(Bt[n][k], At[m][k], acc[ai][bj][m][n], 0, 0, 0); __builtin_amdgcn_s_setprio(0); } while (0)
#define PG8_WAIT_V(n) asm volatile("s_waitcnt vmcnt(" #n ")" ::: "memory")
#define PG8_WAIT_L(n) asm volatile("s_waitcnt lgkmcnt(" #n ")" ::: "memory")
#define PG8_BAR __builtin_amdgcn_s_barrier()
#define PG8_SCHED __builtin_amdgcn_sched_barrier(0)
    Unit cur, nxt; int ui = 0;
    if (!S.next(0, cur)) return;
    f32x4 acc[2][2][4][2];
#pragma unroll
    for (int a = 0; a < 2; ++a)
#pragma unroll
        for (int b = 0; b < 2; ++b)
#pragma unroll
            for (int m = 0; m < 4; ++m)
#pragma unroll
                for (int n = 0; n < 2; ++n) acc[a][b][m][n] = (f32x4){0.f, 0.f, 0.f, 0.f};
    bf16x8 At[4][2], B0[2][2], B1[2][2];
    const char* cA = (const char*)g.A + (size_t)cur.pm * tstepA; const char* cB = (const char*)g.Bt + (size_t)cur.pn * tstepB;
    S.a_ready(cur);
    if constexpr (SP2) {
        PG8_STAGE(PG8_SB(0, 0), cB, voffB); PG8_STAGE(PG8_SB(0, 1), cB + hstepB, voffB); PG8_STAGE(PG8_SA(0, 0), cA, voffA); PG8_STAGE(PG8_SA(0, 1), cA + hstepA, voffA);
        if (wr == 1) PG8_BAR;
        PG8_WAIT_V(2); PG8_BAR;
        PG8_STAGE(PG8_SB(1, 0), cB + kstep, voffB); PG8_STAGE(PG8_SA(1, 0), cA + kstep, voffA); PG8_STAGE(PG8_SB(1, 1), cB + hstepB + kstep, voffB);
        PG8_WAIT_V(6); PG8_BAR;
    } else {
        PG8_STAGE(PG8_SB(0, 0), cB, voffB); PG8_STAGE(PG8_SA(0, 0), cA, voffA); PG8_STAGE(PG8_SB(0, 1), cB + hstepB, voffB); PG8_STAGE(PG8_SA(0, 1), cA + hstepA, voffA);
        if (wr == 1) PG8_BAR;
        PG8_WAIT_V(4); PG8_BAR;
        PG8_STAGE(PG8_SB(1, 0), cB + kstep, voffB); PG8_STAGE(PG8_SA(1, 0), cA + kstep, voffA); PG8_STAGE(PG8_SB(1, 1), cB + hstepB + kstep, voffB);
        PG8_WAIT_V(6); PG8_BAR;
    }
    for (;;) {
        const bool has_next = S.next(ui + 1, nxt);
        const char* nA = has_next ? (const char*)g.A + (size_t)nxt.pm * tstepA : cA; const char* nB = has_next ? (const char*)g.Bt + (size_t)nxt.pn * tstepB : cB;
        for (int t = 0; t < nt; t += 2) {
            const bool last = (t == nt - 2);
            const char* a1 = cA + (size_t)(t + 1) * kstep;
            const char* a2 = last ? nA : cA + (size_t)(t + 2) * kstep; const char* b2 = last ? nB : cB + (size_t)(t + 2) * kstep;
            const char* a3 = a2 + kstep; const char* b3 = b2 + kstep;
            if (last && has_next) S.a_ready(nxt);
            if constexpr (SP2) {
            PG8_LDB(B0, 0, 0); PG8_LDB(B1, 0, 1); PG8_SCHED; PG8_LDA(At, 0, 0); PG8_STAGE(PG8_SA(1, 1), a1 + hstepA, voffA);
            PG8_WAIT_V(8); PG8_WAIT_L(0); PG8_BAR; PG8_MMA(0, 0, At, B0); PG8_MMA(0, 1, At, B1); PG8_BAR; PG8_SCHED;
            PG8_LDA(At, 0, 1); PG8_STAGE(PG8_SB(0, 0), b2, voffB); PG8_STAGE(PG8_SB(0, 1), b2 + hstepB, voffB); PG8_STAGE(PG8_SA(0, 0), a2, voffA);
            PG8_WAIT_V(8); PG8_WAIT_L(0); PG8_BAR; PG8_MMA(1, 0, At, B0); PG8_MMA(1, 1, At, B1); PG8_BAR; PG8_SCHED;
            PG8_LDB(B0, 1, 0); PG8_LDB(B1, 1, 1); PG8_SCHED; PG8_LDA(At, 1, 0); PG8_STAGE(PG8_SA(0, 1), a2 + hstepA, voffA);
            PG8_WAIT_V(8); PG8_WAIT_L(0); PG8_BAR; PG8_MMA(0, 0, At, B0); PG8_MMA(0, 1, At, B1); PG8_BAR; PG8_SCHED;
            PG8_LDA(At, 1, 1); PG8_STAGE(PG8_SB(1, 0), b3, voffB); PG8_STAGE(PG8_SB(1, 1), b3 + hstepB, voffB); PG8_STAGE(PG8_SA(1, 0), a3, voffA);
            PG8_WAIT_V(8); PG8_WAIT_L(0); PG8_BAR; PG8_MMA(1, 0, At, B0); PG8_MMA(1, 1, At, B1); PG8_BAR; PG8_SCHED;
            } else {
            PG8_LDB(B0, 0, 0); PG8_SCHED; PG8_LDA(At, 0, 0); PG8_STAGE(PG8_SA(1, 1), a1 + hstepA, voffA);
            PG8_WAIT_L(8); PG8_BAR; PG8_WAIT_L(0); PG8_MMA(0, 0, At, B0); PG8_BAR; PG8_SCHED;
            PG8_LDB(B1, 0, 1); PG8_STAGE(PG8_SB(0, 0), b2, voffB);
            PG8_BAR; PG8_WAIT_L(0); PG8_MMA(0, 1, At, B1); PG8_BAR;
            PG8_LDA(At, 0, 1); PG8_STAGE(PG8_SA(0, 0), a2, voffA);
            PG8_BAR; PG8_WAIT_L(0); PG8_MMA(1, 0, At, B0); PG8_BAR; PG8_SCHED;
            PG8_STAGE(PG8_SB(0, 1), b2 + hstepB, voffB);
            PG8_WAIT_V(6); PG8_BAR; PG8_MMA(1, 1, At, B1); PG8_BAR;
            PG8_LDB(B0, 1, 0); PG8_SCHED; PG8_LDA(At, 1, 0); PG8_STAGE(PG8_SA(0, 1), a2 + hstepA, voffA);
            PG8_WAIT_L(8); PG8_BAR; PG8_WAIT_L(0); PG8_MMA(0, 0, At, B0); PG8_BAR; PG8_SCHED;
            PG8_LDB(B1, 1, 1); PG8_STAGE(PG8_SB(1, 0), b3, voffB);
            PG8_BAR; PG8_WAIT_L(0); PG8_MMA(0, 1, At, B1); PG8_BAR;
            PG8_LDA(At, 1, 1); PG8_STAGE(PG8_SA(1, 0), a3, voffA);
            PG8_BAR; PG8_WAIT_L(0); PG8_MMA(1, 0, At, B0); PG8_BAR; PG8_SCHED;
            PG8_STAGE(PG8_SB(1, 1), b3 + hstepB, voffB);
            PG8_WAIT_V(6); PG8_BAR; PG8_MMA(1, 1, At, B1); PG8_BAR;
            }
        }
        if constexpr (ALIGN_EPI) { if (wr == 0) PG8_BAR; }
        E(acc, cur, wr, wc, fr, fq);
        if (!has_next) break;
#pragma unroll
        for (int a = 0; a < 2; ++a)
#pragma unroll
            for (int b = 0; b < 2; ++b)
#pragma unroll
                for (int m = 0; m < 4; ++m)
#pragma unroll
                    for (int n = 0; n < 2; ++n) acc[a][b][m][n] = (f32x4){0.f, 0.f, 0.f, 0.f};
        cur = nxt; cA = nA; cB = nB; ++ui;
        if constexpr (ALIGN_EPI) { if (wr == 1) PG8_BAR; }
    }
    PG8_WAIT_V(0);
    if constexpr (!ALIGN_EPI) { if (wr == 0) PG8_BAR; }
    PG8_BAR;
#undef PG8_SA
#undef PG8_SB
#undef PG8_STAGE
#undef PG8_LDA
#undef PG8_LDB
#undef PG8_MMA
#undef PG8_WAIT_V
#undef PG8_WAIT_L
#undef PG8_BAR
#undef PG8_SCHED
}

__device__ __forceinline__ void rope8(f32x4& v0, f32x4& v1, const f32x2* cs) {
    const f32x2 c0 = cs[0], c1 = cs[1], c2 = cs[2], c3 = cs[3];
    float a, b;
    a = v0[0]; b = v0[1]; v0[0] = a * c0.x - b * c0.y; v0[1] = b * c0.x + a * c0.y;
    a = v0[2]; b = v0[3]; v0[2] = a * c1.x - b * c1.y; v0[3] = b * c1.x + a * c1.y;
    a = v1[0]; b = v1[1]; v1[0] = a * c2.x - b * c2.y; v1[1] = b * c2.x + a * c2.y;
    a = v1[2]; b = v1[3]; v1[2] = a * c3.x - b * c3.y; v1[3] = b * c3.x + a * c3.y;
}

struct EpiIn {
    static constexpr bool PERM = true;
    bf16_t* Z; float* rstat; const f32x2* rope;
    __device__ __forceinline__ void operator()(const f32x4 (&acc)[2][2][4][2], const Unit& u, int wr, int wc, int fr, int fq) const {
        const int row0 = u.pm * BM + wr * 64 + fr; const int colw0 = u.pn * BM + wc * 32;
        const bool special = (u.pn >= 18);
#pragma unroll
        for (int ai = 0; ai < 2; ++ai)
#pragma unroll
            for (int m = 0; m < 4; ++m) {
                const int row = row0 + ai * HALF + m * 16;
                bf16_t* rowp = Z + (size_t)row * INWP + colw0 + 8 * fq;
                float sq = 0.f, skv = 0.f;
#pragma unroll
                for (int bj = 0; bj < 2; ++bj) {
                    f32x4 v0 = acc[ai][bj][m][0], v1 = acc[ai][bj][m][1];
                    if (special) {
                        const int colw = colw0 + bj * HALF;
                        if (colw >= ZCQ && colw < ZCKV) sq += dot4(v0) + dot4(v1);
                        else if (colw >= ZCKV && colw < ZKR) skv += dot4(v0) + dot4(v1);
                        else if (colw >= ZKR && colw < INW && u.pm < 32) {
                            const int axis = (colw - ZKR) >> 5, t = row & (SEQ - 1), pos = axis ? (t & 63) : (t >> 6);
                            rope8(v0, v1, rope + pos * 16 + 4 * fq);
                        }
                    }
                    u32x4 w; w.x = cvt_pk_bf16(v0[0], v0[1]); w.y = cvt_pk_bf16(v0[2], v0[3]); w.z = cvt_pk_bf16(v1[0], v1[1]); w.w = cvt_pk_bf16(v1[2], v1[3]);
                    *(u32x4*)(rowp + bj * HALF) = w;
                }
                if (special) {
                    sq += __shfl_xor(sq, 16); sq += __shfl_xor(sq, 32); skv += __shfl_xor(skv, 16); skv += __shfl_xor(skv, 32);
                    if (fq == 0) { if (sq != 0.f) atomicAdd(rstat + (size_t)row * 2, sq); if (skv != 0.f) atomicAdd(rstat + (size_t)row * 2 + 1, skv); }
                }
            }
    }
};
struct EpiUp {
    static constexpr bool PERM = true;
    bf16_t* O; const float* rstat; const f32x2* rope;
    __device__ __forceinline__ void operator()(const f32x4 (&acc)[2][2][4][2], const Unit& u, int wr, int wc, int fr, int fq) const {
        const int row0 = u.pm * BM + wr * 64 + fr; const int colw0 = u.pn * BM + wc * 32;
#pragma unroll
        for (int ai = 0; ai < 2; ++ai)
#pragma unroll
            for (int m = 0; m < 4; ++m) {
                const int row = row0 + ai * HALF + m * 16;
                const f32x2 ss = *(const f32x2*)(rstat + (size_t)row * 2);
                const float rq = rsqrtf(ss.x * (1.0f / 384.0f) + EPS), rkv = rsqrtf(ss.y * (1.0f / 128.0f) + EPS);
                bf16_t* rowp = O + (size_t)row * NUP + colw0 + 8 * fq;
#pragma unroll
                for (int bj = 0; bj < 2; ++bj) {
                    const int colw = colw0 + bj * HALF;
                    const float sc = colw < 768 ? rq : rkv;
                    f32x4 v0 = acc[ai][bj][m][0] * sc, v1 = acc[ai][bj][m][1] * sc;
                    if (colw < 768 && u.pm < 32) {
                        const int within = colw % 192;
                        if (within >= 128) { const int axis = (within - 128) >> 5, t = row & (SEQ - 1), pos = axis ? (t & 63) : (t >> 6); rope8(v0, v1, rope + pos * 16 + 4 * fq); }
                    }
                    u32x4 w; w.x = cvt_pk_bf16(v0[0], v0[1]); w.y = cvt_pk_bf16(v0[2], v0[3]); w.z = cvt_pk_bf16(v1[0], v1[1]); w.w = cvt_pk_bf16(v1[2], v1[3]);
                    *(u32x4*)(rowp + bj * HALF) = w;
                }
            }
    }
};
struct EpiRes {
    static constexpr bool PERM = false;
    const float* base_lat; const float* base_ctx; float* out; const float* gate;
    __device__ __forceinline__ void operator()(const f32x4 (&acc)[2][2][4][2], const Unit& u, int wr, int wc, int fr, int fq) const {
        const int row0 = u.pm * BM + wr * 64 + fr, col0 = u.pn * BM + wc * 32 + 4 * fq;
        const int r = u.pm < 16 ? 0 : (u.pm < 32 ? 1 : 2);
        const float* gp = gate + (size_t)r * 6 * DM + col0;
        f32x4 gv[2][2];
#pragma unroll
        for (int bj = 0; bj < 2; ++bj)
#pragma unroll
            for (int n = 0; n < 2; ++n) gv[bj][n] = *(const f32x4*)(gp + bj * HALF + n * 16);
#pragma unroll
        for (int ai = 0; ai < 2; ++ai)
#pragma unroll
            for (int m = 0; m < 4; ++m) {
                const int row = row0 + ai * HALF + m * 16;
                const float* bp = (u.pm < 32 ? base_lat + (size_t)row * DM : base_ctx + (size_t)(row - ML) * DM) + col0;
                float* op = out + (size_t)row * DM + col0;
#pragma unroll
                for (int bj = 0; bj < 2; ++bj)
#pragma unroll
                    for (int n = 0; n < 2; ++n) { const f32x4 b = *(const f32x4*)(bp + bj * HALF + n * 16); *(f32x4*)(op + bj * HALF + n * 16) = b + gv[bj][n] * acc[ai][bj][m][n]; }
            }
    }
};
struct EpiSwiglu {
    static constexpr bool PERM = true;
    bf16_t* U;
    __device__ __forceinline__ void operator()(const f32x4 (&acc)[2][2][4][2], const Unit& u, int wr, int wc, int fr, int fq) const {
        const int row0 = u.pm * BM + wr * 64 + fr, oc = u.pn * HALF + wc * 32 + 8 * fq;
#pragma unroll
        for (int ai = 0; ai < 2; ++ai)
#pragma unroll
            for (int m = 0; m < 4; ++m) {
                const int row = row0 + ai * HALF + m * 16;
                float o[8];
#pragma unroll
                for (int n = 0; n < 2; ++n)
#pragma unroll
                    for (int j = 0; j < 4; ++j) { const float a = acc[ai][0][m][n][j], b = acc[ai][1][m][n][j]; o[n * 4 + j] = a * b * __builtin_amdgcn_rcpf(1.0f + __builtin_amdgcn_exp2f(-1.4426950408889634f * a)); }
                u32x4 w; w.x = cvt_pk_bf16(o[0], o[1]); w.y = cvt_pk_bf16(o[2], o[3]); w.z = cvt_pk_bf16(o[4], o[5]); w.w = cvt_pk_bf16(o[6], o[7]);
                *(u32x4*)(U + (size_t)row * DFF + oc) = w;
            }
    }
};
}

#define XB_TMO      128
#define XB_XCNT(j)  (256  + 64 * (j))
#define XB_XSUB(j)  (1280 + 64 * (j))
#define XB_XGEN(j)  (2304 + 64 * (j))
#define XB_TOP      3328
#define XB_TOPGEN   3392
#define XCD_BAR_WORDS 3456
#define XB_SPIN_CAP (1u << 18)
__device__ __forceinline__ unsigned xb_ld(unsigned* p)              { return __hip_atomic_load(p, __ATOMIC_RELAXED, __HIP_MEMORY_SCOPE_AGENT); }
__device__ __forceinline__ unsigned xb_add(unsigned* p, unsigned v) { return __hip_atomic_fetch_add(p, v, __ATOMIC_RELAXED, __HIP_MEMORY_SCOPE_AGENT); }
__device__ __forceinline__ unsigned xb_xcc_id() { return (unsigned)__builtin_amdgcn_s_getreg((3 << 11) | 20) & 0xFu; }
#define XB_SPIN(cond, bar) do { unsigned _sp = 0; while (cond) { __builtin_amdgcn_s_sleep(1); \
    if ((++_sp & 255u) == 0u) { if (xb_ld(&(bar)[XB_TMO])) break; if (_sp > XB_SPIN_CAP) { atomicAdd(&(bar)[XB_TMO], 1u); break; } } } } while (0)
struct XcdBarrier { unsigned* bar; unsigned x; volatile LAS unsigned* st; };
__device__ __forceinline__ XcdBarrier xcd_barrier_post(unsigned* bar, volatile LAS unsigned* st) {
    XcdBarrier b; b.bar = bar; b.x = xb_xcc_id(); b.st = st;
    if (threadIdx.x == 0) (void)xb_add(&bar[XB_XCNT(b.x)], 1u);
    return b;
}
__device__ __forceinline__ void xcd_barrier_complete(unsigned* bar, unsigned x, unsigned& nloc, unsigned& nx) {
    const unsigned G = gridDim.x * gridDim.y * gridDim.z;
    unsigned sum, cnt, mine, sp = 0u;
    for (;;) {
        sum = 0u; cnt = 0u; mine = 0u;
#pragma unroll
        for (unsigned j = 0; j < 16; ++j) { const unsigned c = xb_ld(&bar[XB_XCNT(j)]); sum += c; cnt += (c > 0u) ? 1u : 0u; mine = (j == x) ? c : mine; }
        if (sum == G) break;
        __builtin_amdgcn_s_sleep(1);
        if ((++sp & 255u) == 0u) { if (xb_ld(&bar[XB_TMO])) break; if (sp > XB_SPIN_CAP) { atomicAdd(&bar[XB_TMO], 1u); break; } }
    }
    nloc = mine > 0u ? mine : 1u; nx = cnt > 0u ? cnt : 1u;
}
__device__ __forceinline__ void xcd_barrier(const XcdBarrier& b) {
    asm volatile("s_waitcnt vmcnt(0)" ::: "memory");
    __syncthreads();
    if (threadIdx.x == 0) {
        unsigned* bar = b.bar;
        __builtin_amdgcn_s_waitcnt(0);
        unsigned nloc = b.st[0], nx = b.st[1];
        if (nloc == 0u) { xcd_barrier_complete(bar, b.x, nloc, nx); b.st[0] = nloc; b.st[1] = nx; }
        const unsigned old = xb_add(&bar[XB_XSUB(b.x)], 1u);
        const unsigned gen = old / nloc;
        if (old + 1u == (gen + 1u) * nloc) {
            __builtin_amdgcn_fence(__ATOMIC_RELEASE, "agent");
            asm volatile("s_waitcnt vmcnt(0)" ::: "memory");
            const unsigned og = xb_add(&bar[XB_TOP], 1u);
            const unsigned tg = og / nx;
            if (og + 1u == (tg + 1u) * nx) xb_add(&bar[XB_TOPGEN], 1u);
            else XB_SPIN(xb_ld(&bar[XB_TOPGEN]) == tg, bar);
            __builtin_amdgcn_fence(__ATOMIC_ACQUIRE, "agent");
            xb_add(&bar[XB_XGEN(b.x)], 1u);
            asm volatile("s_waitcnt vmcnt(0)" ::: "memory");
        } else {
            XB_SPIN(xb_ld(&bar[XB_XGEN(b.x)]) == gen, bar);
            __builtin_amdgcn_fence(__ATOMIC_ACQUIRE, "agent");
            asm volatile("s_waitcnt vmcnt(0)" ::: "memory");
        }
    }
    __syncthreads();
}

struct Params {
    const float *x, *c, *ctx, *c_ctx, *norm1_g, *w_mod, *b_mod, *w_in, *fg_up, *fg_b, *onorm_g, *conf_dw, *conf_dw_b, *conf_ln_g, *conf_ln_b, *sc_dw,
                *qn_g, *kvn_g, *w_uq, *w_ukv, *w_out, *norm2_g, *w1, *w3, *w2, *final_g;
    float* out; unsigned char* ws; int ph_lo, ph_hi;
};

template <class RowMap>
__device__ __forceinline__ void transpose_item(const float* W, int N, bf16_t* WT, int ldk, const RowMap& rm, LAS float* scr, int item, int lane) {
    const int nblk = N / 32, kb = item / nblk, nb = item % nblk, k0 = 64 * kb, n0 = 32 * nb;
#pragma unroll 8
    for (int i = 0; i < 32; ++i) { const int kk = 2 * i + (lane >> 5); scr[kk * 33 + (lane & 31)] = W[(size_t)(k0 + kk) * N + n0 + (lane & 31)]; }
    LDS_WAIT(); asm volatile("" ::: "memory");
    const int c = lane & 7;
#pragma unroll
    for (int j = 0; j < 4; ++j) { const int n = (lane >> 3) + 8 * j; const LAS float* s = scr + (8 * c) * 33 + n;
        u32x4 o; o.x = cvt_pk_bf16(s[0 * 33], s[1 * 33]); o.y = cvt_pk_bf16(s[2 * 33], s[3 * 33]); o.z = cvt_pk_bf16(s[4 * 33], s[5 * 33]); o.w = cvt_pk_bf16(s[6 * 33], s[7 * 33]);
        *(u32x4*)(WT + (size_t)rm(n0 + n) * ldk + k0 + 8 * c) = o; }
    LDS_WAIT(); asm volatile("" ::: "memory");
}
struct RmId { __device__ __forceinline__ int operator()(int n) const { return n; } };
struct RmIn { __device__ __forceinline__ int operator()(int n) const { if (n < ZKR) return n; const int rc = n - ZKR, a = rc >> 5, hf = (rc >> 4) & 1, i = rc & 15; return ZKR + a * 32 + 2 * i + hf; } };
struct RmFf { int off; __device__ __forceinline__ int operator()(int n) const { return (n >> 7) * 256 + off + (n & 127); } };

struct Frame {
    LAS unsigned char* lds; int tid, lane, wave, G, bid; unsigned char* ws; const Params* p;
};

__device__ __forceinline__ void phase_p0a(const Params& P, LAS unsigned char* lds, int tid, int lane, int wave, int G, int bid) {
    unsigned char* ws = P.ws;
    const int gw = bid * 8 + wave, NGW = G * 8;
    const int gt = bid * 512 + tid, NGT = G * 512;
    LAS float* act = (LAS float*)(lds + 8 * 8448);
    for (int i = tid; i < 3 * DM; i += 512) { const int r = i / DM, k = i % DM; const float v = r < 2 ? P.c[r * DM + k] : P.c_ctx[k]; act[i] = v / (1.0f + expf(-v)); }
    __syncthreads();
    {
        float* modp = (float*)(ws + WS_MODP);
        for (int it = gw; it < 4 * 48 * 8; it += NGW) {
            const int layer = it / 384, rem = it % 384, cb = rem / 8, ks = rem % 8;
            const int col0 = cb * 256 + lane * 4;
            const float* Wp = P.w_mod + ((size_t)layer * DM + (size_t)ks * 256) * 12288 + col0;
            const LAS float* a0 = act + ks * 256;
            f32x4 s0 = {0.f, 0.f, 0.f, 0.f}, s1 = s0, s2 = s0;
#pragma unroll 8
            for (int k = 0; k < 256; ++k) { const f32x4 w = *(const f32x4*)(Wp + (size_t)k * 12288); s0 += w * a0[k]; s1 += w * a0[DM + k]; s2 += w * a0[2 * DM + k]; }
            float* o = modp + (((size_t)ks * 4 + layer) * 3) * 12288 + col0;
            *(f32x4*)(o) = s0; *(f32x4*)(o + 12288) = s1; *(f32x4*)(o + 2 * 12288) = s2;
        }
    }
    {
        LAS float* scr = (LAS float*)(lds + wave * 8448);
        constexpr int I_IN = (DM / 64) * (INW / 32), I_OUT = (DM / 64) * (DM / 32), I_FF = (DM / 64) * (DFF / 32), I_W2 = (DFF / 64) * (DM / 32);
        constexpr int PER_LAYER = I_IN + I_OUT + 2 * I_FF + I_W2;
        for (int it = gw; it < 4 * PER_LAYER; it += NGW) {
            const int layer = it / PER_LAYER; int r = it % PER_LAYER;
            if (r < I_IN) { transpose_item(P.w_in + (size_t)layer * DM * INW, INW, (bf16_t*)(ws + WS_WIN) + (size_t)layer * INWP * DM, DM, RmIn{}, scr, r, lane); continue; } r -= I_IN;
            if (r < I_OUT) { transpose_item(P.w_out + (size_t)layer * DM * DM, DM, (bf16_t*)(ws + WS_WOUT) + (size_t)layer * DM * DM, DM, RmId{}, scr, r, lane); continue; } r -= I_OUT;
            if (r < I_FF) { transpose_item(P.w1 + (size_t)layer * DM * DFF, DFF, (bf16_t*)(ws + WS_W13) + (size_t)layer * 2 * DFF * DM, DM, RmFf{0}, scr, r, lane); continue; } r -= I_FF;
            if (r < I_FF) { transpose_item(P.w3 + (size_t)layer * DM * DFF, DFF, (bf16_t*)(ws + WS_W13) + (size_t)layer * 2 * DFF * DM, DM, RmFf{128}, scr, r, lane); continue; } r -= I_FF;
            transpose_item(P.w2 + (size_t)layer * DFF * DM, DM, (bf16_t*)(ws + WS_W2) + (size_t)layer * DM * DFF, DFF, RmId{}, scr, r, lane);
        }
    }
    {
        constexpr int PADW = (INWP - INW) * DM / 8;
        for (int i = gt; i < 4 * PADW; i += NGT) { const int layer = i / PADW, j = i % PADW;
            *(u32x4*)((bf16_t*)(ws + WS_WIN) + ((size_t)layer * INWP + INW) * DM + (size_t)j * 8) = (u32x4){0u, 0u, 0u, 0u}; }
    }
    {
        bf16_t* WU = (bf16_t*)(ws + WS_WUP);
        for (int i = gt; i < 4 * NUP * KUP; i += NGT) {
            const int layer = i / (NUP * KUP), rem = i % (NUP * KUP), p = rem / KUP, k = rem % KUP;
            float v = 0.f;
            if (p < 768) {
                if (k < 384) { const int hd = p / 192, within = p % 192; int ow = within;
                    if (within >= 128) { const int rc = within - 128, a = rc >> 5, j = rc & 31, ii = j >> 1, hf = j & 1; ow = 128 + a * 32 + hf * 16 + ii; }
                    v = P.qn_g[layer * 384 + k] * P.w_uq[((size_t)layer * 384 + k) * 768 + hd * 192 + ow]; }
            } else {
                if (k >= 384) { const int kk = k - 384; v = P.kvn_g[layer * 128 + kk] * P.w_ukv[((size_t)layer * 128 + kk) * 1024 + (p - 768)]; }
            }
            WU[i] = f2bf(v);
        }
    }
    {
        f32x2* rope = (f32x2*)(ws + WS_ROPE);
        for (int i = gt; i < 1024; i += NGT) { const int pos = i >> 4, f = i & 15; const float inv = powf(10000.0f, -(float)f * 2.0f / 32.0f); const float ang = (float)pos * inv; rope[i] = (f32x2){cosf(ang), sinf(ang)}; }
        float* rs = (float*)(ws + WS_RSTAT);
        for (int i = gt; i < 4 * MT * 2; i += NGT) rs[i] = 0.f;
    }
}
__device__ __forceinline__ void phase_p0b(const Params& P, int tid, int G, int bid) {
    const float* modp = (const float*)(P.ws + WS_MODP); float* modv = (float*)(P.ws + WS_MODV);
    for (int i = bid * 512 + tid; i < 4 * 3 * 12288; i += G * 512) {
        const int layer = i / (3 * 12288), rem = i % (3 * 12288), r = rem / 12288, c12 = rem % 12288, j = c12 / DM, col = c12 % DM;
        float s = P.b_mod[layer * 12288 + c12];
#pragma unroll
        for (int ks = 0; ks < 8; ++ks) s += modp[(((size_t)ks * 4 + layer) * 3 + r) * 12288 + c12];
        if (j == 1) s = P.norm1_g[layer * DM + col] * (1.0f + s);
        if (j == 4) s = P.norm2_g[layer * DM + col] * (1.0f + s);
        modv[(((size_t)layer * 3 + r) * 6 + j) * DM + col] = s;
    }
}

__device__ __forceinline__ void phase_norm(const float* xlat, const float* xctx, const float* modl  , int jg, int jsh, bf16_t* H, int nrows, int lane, int wave, int G, int bid) {
    const int rpw = (nrows + G - 1) / G;
    int cur = -1; f32x4 gsv[8], shv[8];
    for (int k = wave; k < rpw; k += 8) {
        const int row = bid * rpw + k; if (row >= nrows) break;
        const int r = row < SEQ ? 0 : (row < ML ? 1 : 2);
        if (r != cur) { cur = r; const float* gp = modl + ((size_t)r * 6 + jg) * DM; const float* sp = modl + ((size_t)r * 6 + jsh) * DM;
#pragma unroll
            for (int j = 0; j < 8; ++j) { gsv[j] = *(const f32x4*)(gp + (lane + 64 * j) * 4); shv[j] = *(const f32x4*)(sp + (lane + 64 * j) * 4); } }
        const float* xr = row < ML ? xlat + (size_t)row * DM : xctx + (size_t)(row - ML) * DM;
        f32x4 v[8]; float ss = 0.f;
#pragma unroll
        for (int j = 0; j < 8; ++j) { v[j] = *(const f32x4*)(xr + (lane + 64 * j) * 4); ss += dot4(v[j]); }
        const float rstd = rsqrtf(wave_sum(ss) * (1.0f / DM) + EPS);
        bf16_t* hr = H + (size_t)row * DM;
#pragma unroll
        for (int j = 0; j < 8; ++j) { const f32x4 o = v[j] * rstd * gsv[j] + shv[j]; u32x2 w; w.x = cvt_pk_bf16(o[0], o[1]); w.y = cvt_pk_bf16(o[2], o[3]); *(u32x2*)(hr + (lane + 64 * j) * 4) = w; }
    }
}
__device__ __forceinline__ void phase_final(const float* X, const float* g, float* out, int lane, int wave, int G, int bid) {
    for (int row = bid * 8 + wave; row < ML; row += G * 8) {
        const float* xr = X + (size_t)row * DM; f32x4 v[8]; float ss = 0.f;
#pragma unroll
        for (int j = 0; j < 8; ++j) { v[j] = *(const f32x4*)(xr + (lane + 64 * j) * 4); ss += dot4(v[j]); }
        const float rstd = rsqrtf(wave_sum(ss) * (1.0f / DM) + EPS);
#pragma unroll
        for (int j = 0; j < 8; ++j) { const f32x4 gg = *(const f32x4*)(g + (lane + 64 * j) * 4); *(f32x4*)(out + (size_t)row * DM + (lane + 64 * j) * 4) = v[j] * rstd * gg; }
    }
}

constexpr int GL_L = 0;
constexpr int GL_QT = 33792;
constexpr int GL_KT = 51200;
constexpr int GL_PP = 68608;
constexpr int GL_VT = 77824;
constexpr int GL_FG = 96256;
constexpr int GL_LR = 104960;
__device__ __forceinline__ int gla_row0(int b, int id) { return id < 4 ? ML + b * CTX + id * 64 : b * SEQ + (id - 4) * 64; }
__device__ __forceinline__ void gla_load_vT(LAS unsigned char* lds, const bf16_t* Z, int row0, int h, int tid) {
    const int t = tid >> 3, eg = (tid & 7) * 16;
    const u32x4* src = (const u32x4*)(Z + (size_t)(row0 + t) * INWP + ZV + h * 128 + eg);
    const u32x4 a = src[0], b = src[1];
    LAS bf16_t* VT = (LAS bf16_t*)(lds + GL_VT);
    const unsigned w[8] = {a.x, a.y, a.z, a.w, b.x, b.y, b.z, b.w};
#pragma unroll
    for (int i = 0; i < 8; ++i) { VT[(eg + 2 * i) * 72 + t] = (bf16_t)(w[i] & 0xffffu); VT[(eg + 2 * i + 1) * 72 + t] = (bf16_t)(w[i] >> 16); }
}
__device__ __forceinline__ void gla_decay(LAS unsigned char* lds, const bf16_t* Z, const float* fgup  , const float* fgb  , int row0, int h, int dir, int tid) {
    LAS float* FG = (LAS float*)(lds + GL_FG); LAS float* FB = FG + 2048; LAS float* LR = (LAS float*)(lds + GL_LR); LAS float* L = (LAS float*)(lds + GL_L);
    { const int r = tid >> 5, d4 = (tid & 31) * 4; *(LAS f32x4*)(FG + r * 128 + d4) = *(const f32x4*)(fgup + r * 512 + h * 128 + d4); }
    if (tid < 32) *(LAS f32x4*)(FB + tid * 4) = *(const f32x4*)(fgb + h * 128 + tid * 4);
    if (tid < 128) { const int t = tid >> 1, hf = tid & 1; const u32x4 w = *(const u32x4*)(Z + (size_t)(row0 + t) * INWP + ZLR + dir * 16 + hf * 8);
        LAS float* o = LR + t * 16 + hf * 8; o[0] = bflo(w.x); o[1] = bfhi(w.x); o[2] = bflo(w.y); o[3] = bfhi(w.y); o[4] = bflo(w.z); o[5] = bfhi(w.z); o[6] = bflo(w.w); o[7] = bfhi(w.w); }
    __syncthreads();
    {
        const int t = tid >> 3, dg = (tid & 7) * 16;
        f32x4 a[4];
#pragma unroll
        for (int q = 0; q < 4; ++q) a[q] = *(const LAS f32x4*)(FB + dg + 4 * q);
#pragma unroll
        for (int r = 0; r < 16; ++r) { const float lr = LR[t * 16 + r];
#pragma unroll
            for (int q = 0; q < 4; ++q) a[q] += *(const LAS f32x4*)(FG + r * 128 + dg + 4 * q) * lr; }
#pragma unroll
        for (int q = 0; q < 4; ++q) { f32x4 o;
#pragma unroll
            for (int j = 0; j < 4; ++j) { const float x = a[q][j]; o[j] = (fminf(x, 0.f) - log1pf(expf(-fabsf(x)))) * (1.0f / 16.0f); }
            *(LAS f32x4*)(L + t * 132 + dg + 4 * q) = o; }
    }
    __syncthreads();
    if (tid < 128) { float run = 0.f;
        if (dir == 0) { for (int t = 0; t < 64; ++t) { run += L[t * 132 + tid]; L[t * 132 + tid] = run; } }
        else { for (int t = 63; t >= 0; --t) { run += L[t * 132 + tid]; L[t * 132 + tid] = run; } } }
    __syncthreads();
}
__device__ __forceinline__ void gla_g1_item(LAS unsigned char* lds, const Params& P, int layer, int item, int tid, int lane, int wave) {
    const bf16_t* Z = (const bf16_t*)(P.ws + WS_Z);
    const int id = item % NCH, dir = (item / NCH) & 1, h = (item / (2 * NCH)) & 3, b = item / (8 * NCH);
    const int seq = (b * 4 + h) * 2 + dir, row0 = gla_row0(b, id);
    gla_load_vT(lds, Z, row0, h, tid);
    gla_decay(lds, Z, P.fg_up + ((size_t)layer * 2 + dir) * 16 * 512, P.fg_b + ((size_t)layer * 2 + dir) * 512, row0, h, dir, tid);
    LAS float* L = (LAS float*)(lds + GL_L); LAS bf16_t* KH = (LAS bf16_t*)(lds + GL_QT);
    const int tl = dir == 0 ? 63 : 0;
    {
        const int t = tid >> 3, dg = (tid & 7) * 16;
        const u32x4* src = (const u32x4*)(Z + (size_t)(row0 + t) * INWP + ZK + h * 128 + dg);
        const u32x4 a = src[0], bq = src[1]; const unsigned w[8] = {a.x, a.y, a.z, a.w, bq.x, bq.y, bq.z, bq.w};
#pragma unroll
        for (int i = 0; i < 8; ++i) { const int d = dg + 2 * i;
            const float e0 = __expf(L[tl * 132 + d] - L[t * 132 + d]), e1 = __expf(L[tl * 132 + d + 1] - L[t * 132 + d + 1]);
            KH[d * 72 + t] = f2bf(bflo(w[i]) * e0); KH[(d + 1) * 72 + t] = f2bf(bfhi(w[i]) * e1); }
        if (tid < 128) ((float*)(P.ws + WS_GD))[((size_t)seq * NCH + id) * 128 + tid] = __expf(L[tl * 132 + tid]);
    }
    __syncthreads();
    {
        const LAS bf16_t* VT = (const LAS bf16_t*)(lds + GL_VT);
        const int eb = wave >> 1, r32 = lane & 31, hi = lane >> 5;
        float* U = (float*)(P.ws + WS_GU) + ((size_t)seq * NCH + id) * 16384;
#pragma unroll
        for (int q = 0; q < 2; ++q) { const int db = 2 * (wave & 1) + q; f32x16 acc = {};
#pragma unroll
            for (int kk = 0; kk < 4; ++kk) { const bf16x8 av = *(const LAS bf16x8*)(VT + (32 * eb + r32) * 72 + 16 * kk + 8 * hi), bv = *(const LAS bf16x8*)(KH + (32 * db + r32) * 72 + 16 * kk + 8 * hi);
                acc = __builtin_amdgcn_mfma_f32_32x32x16_bf16(av, bv, acc, 0, 0, 0); }
#pragma unroll
            for (int r = 0; r < 16; ++r) { const int e = 32 * eb + (r & 3) + 8 * (r >> 2) + 4 * hi; U[e * 128 + 32 * db + r32] = acc[r]; } }
    }
    __syncthreads();
}
__device__ __forceinline__ void gla_g2(const Params& P, int tid, int G, int bid) {
    const float* U = (const float*)(P.ws + WS_GU); const float* Dv = (const float*)(P.ws + WS_GD); bf16_t* S = (bf16_t*)(P.ws + WS_GS);
    for (int slot = bid * 512 + tid; slot < 16 * 8192; slot += G * 512) {
        const int seq = slot >> 13, el = (slot & 8191) * 2, d = el & 127, dir = seq & 1;
        float s0 = 0.f, s1 = 0.f;
#pragma unroll 4
        for (int p = 0; p < NCH; ++p) {
            const int id = dir == 0 ? p : (p < 4 ? 3 - p : 71 - p);
            const size_t base = ((size_t)seq * NCH + id);
            *(unsigned*)(S + base * 16384 + el) = cvt_pk_bf16(s0, s1);
            const f32x2 u = *(const f32x2*)(U + base * 16384 + el), dd = *(const f32x2*)(Dv + base * 128 + d);
            s0 = dd.x * s0 + u.x; s1 = dd.y * s1 + u.y;
        }
    }
}
__device__ __forceinline__ void gla_g3_item(LAS unsigned char* lds, const Params& P, int layer, int item, int tid, int lane, int wave) {
    const bf16_t* Z = (const bf16_t*)(P.ws + WS_Z);
    const int id = item % NCH, h = (item / NCH) & 3, b = item / (4 * NCH);
    const int row0 = gla_row0(b, id);
    gla_load_vT(lds, Z, row0, h, tid);
    LAS float* L = (LAS float*)(lds + GL_L); LAS bf16_t* QT = (LAS bf16_t*)(lds + GL_QT); LAS bf16_t* KT = (LAS bf16_t*)(lds + GL_KT); LAS bf16_t* PP = (LAS bf16_t*)(lds + GL_PP);
    const LAS bf16_t* VT = (const LAS bf16_t*)(lds + GL_VT);
    const int r32 = lane & 31, hi = lane >> 5, rb = wave >> 2, cb = wave & 3;
    f32x16 o = {};
    for (int dir = 0; dir < 2; ++dir) {
        const int seq = (b * 4 + h) * 2 + dir;
        const bf16_t* Sg = (const bf16_t*)(P.ws + WS_GS) + ((size_t)seq * NCH + id) * 16384 + (size_t)(32 * cb + r32) * 128 + 8 * hi;
        bf16x8 sf[8];
#pragma unroll
        for (int kk = 0; kk < 8; ++kk) sf[kk] = *(const bf16x8*)(Sg + 16 * kk);
        gla_decay(lds, Z, P.fg_up + ((size_t)layer * 2 + dir) * 16 * 512, P.fg_b + ((size_t)layer * 2 + dir) * 512, row0, h, dir, tid);
        {
            const int t = tid >> 3, dg = (tid & 7) * 16;
            const u32x4* qs = (const u32x4*)(Z + (size_t)(row0 + t) * INWP + ZQ + h * 128 + dg); const u32x4* ks = (const u32x4*)(Z + (size_t)(row0 + t) * INWP + ZK + h * 128 + dg);
            const u32x4 qa = qs[0], qb = qs[1], ka = ks[0], kb = ks[1];
            const unsigned qw[8] = {qa.x, qa.y, qa.z, qa.w, qb.x, qb.y, qb.z, qb.w}, kw[8] = {ka.x, ka.y, ka.z, ka.w, kb.x, kb.y, kb.z, kb.w};
            unsigned qo[8], ko[8];
#pragma unroll
            for (int i = 0; i < 8; ++i) { const float b0 = L[t * 132 + dg + 2 * i], b1 = L[t * 132 + dg + 2 * i + 1];
                const float eq0 = __expf(b0) * 0.08838834764831845f, eq1 = __expf(b1) * 0.08838834764831845f, ek0 = __expf(fminf(-b0, 80.f)), ek1 = __expf(fminf(-b1, 80.f));
                qo[i] = cvt_pk_bf16(bflo(qw[i]) * eq0, bfhi(qw[i]) * eq1); ko[i] = cvt_pk_bf16(bflo(kw[i]) * ek0, bfhi(kw[i]) * ek1); }
            *(LAS u32x4*)(QT + t * 136 + dg) = (u32x4){qo[0], qo[1], qo[2], qo[3]}; *(LAS u32x4*)(QT + t * 136 + dg + 8) = (u32x4){qo[4], qo[5], qo[6], qo[7]};
            *(LAS u32x4*)(KT + t * 136 + dg) = (u32x4){ko[0], ko[1], ko[2], ko[3]}; *(LAS u32x4*)(KT + t * 136 + dg + 8) = (u32x4){ko[4], ko[5], ko[6], ko[7]};
        }
        __syncthreads();
        {
            const int bi = wave >> 1, fr = lane & 15, fq = lane >> 4;
#pragma unroll
            for (int q = 0; q < 2; ++q) { const int bj = 2 * (wave & 1) + q; f32x4 acc = {0.f, 0.f, 0.f, 0.f};
#pragma unroll
                for (int kk = 0; kk < 4; ++kk) { const bf16x8 av = *(const LAS bf16x8*)(QT + (16 * bi + fr) * 136 + 32 * kk + 8 * fq), bv = *(const LAS bf16x8*)(KT + (16 * bj + fr) * 136 + 32 * kk + 8 * fq);
                    acc = __builtin_amdgcn_mfma_f32_16x16x32_bf16(av, bv, acc, 0, 0, 0); }
                const int jt = 16 * bj + fr;
#pragma unroll
                for (int r = 0; r < 4; ++r) { const int it = 16 * bi + 4 * fq + r; const bool keep = dir == 0 ? (jt <= it) : (jt >= it); PP[it * 72 + jt] = f2bf(keep ? acc[r] : 0.f); } }
        }
        __syncthreads();
        {
#pragma unroll
            for (int kk = 0; kk < 4; ++kk) { const bf16x8 av = *(const LAS bf16x8*)(PP + (32 * rb + r32) * 72 + 16 * kk + 8 * hi), bv = *(const LAS bf16x8*)(VT + (32 * cb + r32) * 72 + 16 * kk + 8 * hi);
                o = __builtin_amdgcn_mfma_f32_32x32x16_bf16(av, bv, o, 0, 0, 0); }
#pragma unroll
            for (int kk = 0; kk < 8; ++kk) { const bf16x8 av = *(const LAS bf16x8*)(QT + (32 * rb + r32) * 136 + 16 * kk + 8 * hi);
                o = __builtin_amdgcn_mfma_f32_32x32x16_bf16(av, sf[kk], o, 0, 0, 0); }
        }
        __syncthreads();
    }
#pragma unroll
    for (int r = 0; r < 16; ++r) { const int t = 32 * rb + (r & 3) + 8 * (r >> 2) + 4 * hi; L[t * 132 + 32 * cb + r32] = o[r]; }
    __syncthreads();
    {
        const int t = tid >> 3, eg = (tid & 7) * 16;
        f32x4 v[4]; float ss = 0.f;
#pragma unroll
        for (int q = 0; q < 4; ++q) { v[q] = *(const LAS f32x4*)(L + t * 132 + eg + 4 * q); ss += dot4(v[q]); }
        ss += __shfl_xor(ss, 1); ss += __shfl_xor(ss, 2); ss += __shfl_xor(ss, 4);
        const float rstd = rsqrtf(ss * (1.0f / 128.0f) + EPS);
        const u32x4* gs = (const u32x4*)(Z + (size_t)(row0 + t) * INWP + ZG + h * 128 + eg); const u32x4 ga = gs[0], gb = gs[1];
        const unsigned gw[8] = {ga.x, ga.y, ga.z, ga.w, gb.x, gb.y, gb.z, gb.w};
        const float* og = P.onorm_g + layer * 128 + eg;
        unsigned ow[8];
#pragma unroll
        for (int i = 0; i < 8; ++i) { const float g0 = bflo(gw[i]), g1 = bfhi(gw[i]);
            const float o0 = v[i >> 1][(i & 1) * 2] * rstd * og[2 * i] * siluf_(g0), o1 = v[i >> 1][(i & 1) * 2 + 1] * rstd * og[2 * i + 1] * siluf_(g1);
            ow[i] = cvt_pk_bf16(o0, o1); }
        bf16_t* mp = (bf16_t*)(P.ws + WS_MIX) + (size_t)(row0 + t) * DM + h * 128 + eg;
        *(u32x4*)(mp) = (u32x4){ow[0], ow[1], ow[2], ow[3]}; *(u32x4*)(mp + 8) = (u32x4){ow[4], ow[5], ow[6], ow[7]};
    }
    __syncthreads();
}

__device__ __forceinline__ void conf_item(LAS unsigned char* lds, const Params& P, int layer, int item, int tid, int lane, int wave) {
    const bf16_t* Z = (const bf16_t*)(P.ws + WS_Z);
    const int r0 = item * 16;
    const int s0 = r0 < ML ? (r0 & ~(SEQ - 1)) : ML + ((r0 - ML) & ~(CTX - 1)), s1 = s0 + (r0 < ML ? SEQ : CTX);
    LAS float* UB = (LAS float*)lds;
    LAS float* YB = (LAS float*)(lds + 46 * 512 * 4);
    const int c = tid;
    for (int i = 0; i < 46; ++i) { const int row = r0 - 15 + i; float u = 0.f;
        if (row >= s0 && row < s1) { const float a = bf2f(Z[(size_t)row * INWP + ZCA + c]), g = bf2f(Z[(size_t)row * INWP + ZCG + c]); u = a * sigmoidf_(g); }
        UB[i * 512 + c] = u; }
    float w[31];
#pragma unroll
    for (int j = 0; j < 31; ++j) w[j] = P.conf_dw[((size_t)layer * 31 + j) * 512 + c];
    const float bias = P.conf_dw_b[layer * 512 + c];
    LDS_WAIT();
#pragma unroll
    for (int g8 = 0; g8 < 2; ++g8) {
        float win[38];
#pragma unroll
        for (int i = 0; i < 38; ++i) win[i] = UB[(g8 * 8 + i) * 512 + c];
#pragma unroll
        for (int r = 0; r < 8; ++r) { float y = bias;
#pragma unroll
            for (int j = 0; j < 31; ++j) y += w[j] * win[r + j];
            YB[(g8 * 8 + r) * 512 + c] = y; }
    }
    __syncthreads();
    {
        const float* lg = P.conf_ln_g + layer * 512 + 8 * lane; const float* lb = P.conf_ln_b + layer * 512 + 8 * lane;
        const f32x4 g0 = *(const f32x4*)lg, g1 = *(const f32x4*)(lg + 4), b0 = *(const f32x4*)lb, b1 = *(const f32x4*)(lb + 4);
#pragma unroll
        for (int q = 0; q < 2; ++q) { const int t = 2 * wave + q;
            f32x4 y0 = *(const LAS f32x4*)(YB + t * 512 + 8 * lane), y1 = *(const LAS f32x4*)(YB + t * 512 + 8 * lane + 4);
            const float mean = wave_sum((y0[0] + y0[1]) + (y0[2] + y0[3]) + (y1[0] + y1[1]) + (y1[2] + y1[3])) * (1.0f / 512.0f);
            y0 = y0 - mean; y1 = y1 - mean;
            const float rstd = rsqrtf(wave_sum(dot4(y0) + dot4(y1)) * (1.0f / 512.0f) + EPS);
            y0 = y0 * rstd * g0 + b0; y1 = y1 * rstd * g1 + b1;
            u32x4 o; o.x = cvt_pk_bf16(siluf_(y0[0]), siluf_(y0[1])); o.y = cvt_pk_bf16(siluf_(y0[2]), siluf_(y0[3])); o.z = cvt_pk_bf16(siluf_(y1[0]), siluf_(y1[1])); o.w = cvt_pk_bf16(siluf_(y1[2]), siluf_(y1[3]));
            *(u32x4*)((bf16_t*)(P.ws + WS_MIX) + (size_t)(r0 + t) * DM + 512 + 8 * lane) = o; }
    }
    __syncthreads();
}
__device__ __forceinline__ void sconv_item(const Params& P, int layer, int item, int tid) {
    const bf16_t* Z = (const bf16_t*)(P.ws + WS_Z);
    const int row = item * 16 + (tid >> 5);
    const int s0 = row < ML ? (row & ~(SEQ - 1)) : ML + ((row - ML) & ~(CTX - 1)), s1 = s0 + (row < ML ? SEQ : CTX);
#pragma unroll
    for (int q = 0; q < 2; ++q) {
        const int c0 = ((tid & 31) + 32 * q) * 8;
        float acc[8];
#pragma unroll
        for (int i = 0; i < 8; ++i) acc[i] = 0.f;
#pragma unroll
        for (int j = 0; j < 3; ++j) { const int rr = row + j - 1;
            if (rr >= s0 && rr < s1) { const u32x4 cg = *(const u32x4*)(Z + (size_t)rr * INWP + ZSC + c0), hh = *(const u32x4*)(Z + (size_t)rr * INWP + ZSH + c0);
                const float* wp = P.sc_dw + ((size_t)layer * 3 + j) * 512 + c0; const f32x4 w0 = *(const f32x4*)wp, w1 = *(const f32x4*)(wp + 4);
                const unsigned cw[4] = {cg.x, cg.y, cg.z, cg.w}, hw[4] = {hh.x, hh.y, hh.z, hh.w};
#pragma unroll
                for (int i = 0; i < 4; ++i) { const float wa = i < 2 ? w0[2 * i] : w1[2 * i - 4], wb = i < 2 ? w0[2 * i + 1] : w1[2 * i - 3];
                    acc[2 * i] += wa * bflo(cw[i]) * bflo(hw[i]); acc[2 * i + 1] += wb * bfhi(cw[i]) * bfhi(hw[i]); } } }
        const u32x4 bg = *(const u32x4*)(Z + (size_t)row * INWP + ZSB + c0); const unsigned bw[4] = {bg.x, bg.y, bg.z, bg.w};
        u32x4 o; unsigned ow[4];
#pragma unroll
        for (int i = 0; i < 4; ++i) ow[i] = cvt_pk_bf16(bflo(bw[i]) * acc[2 * i], bfhi(bw[i]) * acc[2 * i + 1]);
        o.x = ow[0]; o.y = ow[1]; o.z = ow[2]; o.w = ow[3];
        *(u32x4*)((bf16_t*)(P.ws + WS_MIX) + (size_t)row * DM + 1024 + c0) = o;
    }
}

namespace att {
constexpr int NW = 8, QBLK = 32, KVBLK = 64;
constexpr float SCALE = 0.07216878364870322f;
constexpr float THR = 8.f;
constexpr int SHM_V = KVBLK * 128 * 2, SHM_K = KVBLK * 192 * 2;
constexpr int OFF_K = 2 * SHM_V, OFF_WS = OFF_K + 2 * SHM_K, OFF_QR = OFF_WS + 2048;
#define KSWZ(row, colB) ((row) * 384 + ((colB) ^ ((((row) >> 1) & 7) << 4)))
#define SBAR() __builtin_amdgcn_sched_barrier(0)
__device__ __forceinline__ int crow(int r, int hi) { return (r & 3) + 8 * (r >> 2) + 4 * hi; }
__device__ __forceinline__ void partialSM(f32x16& p0, f32x16& p1, float& m_reg, float& mn, float& alpha) {
    constexpr float C = SCALE * 1.4426950408889634f;
    float pmax = p0[0];
#pragma unroll
    for (int r = 1; r < 16; ++r) pmax = fmaxf(pmax, p0[r]);
#pragma unroll
    for (int r = 0; r < 16; ++r) pmax = fmaxf(pmax, p1[r]);
    { auto rr = __builtin_amdgcn_permlane32_swap(__float_as_uint(pmax), __float_as_uint(pmax), false, false);
      pmax = fmaxf(__uint_as_float(rr[0]), __uint_as_float(rr[1])); }
    if (__builtin_expect(__all(pmax - m_reg <= THR / SCALE), 1)) { mn = m_reg; alpha = 1.f; }
    else { mn = fmaxf(m_reg, pmax); alpha = __builtin_amdgcn_exp2f((m_reg - mn) * C); m_reg = mn; }
    const float mnC = -mn * C;
#pragma unroll
    for (int r = 0; r < 16; ++r) p0[r] = fmaf(p0[r], C, mnC);
#pragma unroll
    for (int r = 0; r < 16; ++r) p1[r] = fmaf(p1[r], C, mnC);
#pragma unroll
    for (int r = 0; r < 16; ++r) p0[r] = __builtin_amdgcn_exp2f(p0[r]);
}
__device__ __forceinline__ void finishSM(f32x16& p0, f32x16& p1, float alpha, float& l_reg, bf16x8& pa0, bf16x8& pa1, bf16x8& pa2, bf16x8& pa3) {
#pragma unroll
    for (int r = 0; r < 16; ++r) p1[r] = __builtin_amdgcn_exp2f(p1[r]);
    float ps = 0;
#pragma unroll
    for (int r = 0; r < 16; ++r) ps += p0[r];
#pragma unroll
    for (int r = 0; r < 16; ++r) ps += p1[r];
    { auto rr = __builtin_amdgcn_permlane32_swap(__float_as_uint(ps), __float_as_uint(ps), false, false);
      ps = __uint_as_float(rr[0]) + __uint_as_float(rr[1]); }
    l_reg = l_reg * alpha + ps;
#define PK4(Pv, BASE, OUT) do { unsigned a0 = cvt_pk_bf16(Pv[BASE + 0], Pv[BASE + 1]), a1 = cvt_pk_bf16(Pv[BASE + 2], Pv[BASE + 3]);   \
    unsigned b0 = cvt_pk_bf16(Pv[BASE + 4], Pv[BASE + 5]), b1 = cvt_pk_bf16(Pv[BASE + 6], Pv[BASE + 7]);                              \
    auto r0 = __builtin_amdgcn_permlane32_swap(a0, b0, false, false); auto r1 = __builtin_amdgcn_permlane32_swap(a1, b1, false, false); \
    u32x4 w = {r0[0], r1[0], r0[1], r1[1]}; OUT = *reinterpret_cast<bf16x8*>(&w); } while (0)
    PK4(p0, 0, pa0); PK4(p0, 8, pa1); PK4(p1, 0, pa2); PK4(p1, 8, pa3);
#undef PK4
}
__device__ __forceinline__ void qkt(f32x16& p0, f32x16& p1, const LAS unsigned char* Ks, const bf16x8* qr, const LAS unsigned char* qrp, int qsw, const int (&kq)[4], int hi) {
    p0 = f32x16{}; p1 = f32x16{};
#pragma unroll
    for (int d0 = 0; d0 < 12; ++d0) {
        const bf16x8 b0 = *(const LAS bf16x8*)(Ks + kq[d0 & 3] + 128 * (d0 >> 2));
        const bf16x8 b1 = *(const LAS bf16x8*)(Ks + kq[d0 & 3] + 128 * (d0 >> 2) + 32 * 384);
        bf16x8 qv; if (d0 < 8) qv = qr[d0]; else qv = *(const LAS bf16x8*)(qrp + (((2 * (d0 - 8) + hi) ^ qsw) << 4));
        p0 = __builtin_amdgcn_mfma_f32_32x32x16_bf16(b0, qv, p0, 0, 0, 0);
        p1 = __builtin_amdgcn_mfma_f32_32x32x16_bf16(b1, qv, p1, 0, 0, 0); }
}
__device__ __forceinline__ int v_st(int k, int c) { const int kk = (k & ~0xC) | ((k & 4) << 1) | ((k & 8) >> 1); return ((kk >> 3) * 4 + (c >> 5)) * 512 + ((kk & 7) * 32 + (c & 31)) * 2; }
__device__ __forceinline__ int v_rd_base(int lane) { return ((lane & 3) << 3) | (((lane >> 2) & 3) << 6) | (((lane >> 4) & 1) << 5) | (((lane >> 5) & 1) << 8); }
constexpr int v_rd_off(int d0, int ks, int half) { return d0 * 512 + ks * 4096 + half * 2048; }
template <int OFF> __device__ __forceinline__ s16x4 tr_read(int vb) {
    s16x4 r; asm volatile("ds_read_b64_tr_b16 %0, %1 offset:%2" : "=&v"(r) : "v"(vb), "i"(OFF) : "memory"); return r;
}
template <int D0> __device__ __forceinline__ void pv_one(f32x16& od, int vb, bf16x8 pa0, bf16x8 pa1, bf16x8 pa2, bf16x8 pa3) {
    const s16x4 l0 = tr_read<v_rd_off(D0, 0, 0)>(vb), h0 = tr_read<v_rd_off(D0, 0, 1)>(vb), l1 = tr_read<v_rd_off(D0, 1, 0)>(vb), h1 = tr_read<v_rd_off(D0, 1, 1)>(vb);
    const s16x4 l2 = tr_read<v_rd_off(D0, 2, 0)>(vb), h2 = tr_read<v_rd_off(D0, 2, 1)>(vb), l3 = tr_read<v_rd_off(D0, 3, 0)>(vb), h3 = tr_read<v_rd_off(D0, 3, 1)>(vb);
    asm volatile("s_waitcnt lgkmcnt(0)" ::: "memory"); SBAR();
#define PK(Lo, Hi) (bf16x8){Lo[0], Lo[1], Lo[2], Lo[3], Hi[0], Hi[1], Hi[2], Hi[3]}
    od = __builtin_amdgcn_mfma_f32_32x32x16_bf16(pa0, PK(l0, h0), od, 0, 0, 0);
    od = __builtin_amdgcn_mfma_f32_32x32x16_bf16(pa1, PK(l1, h1), od, 0, 0, 0);
    od = __builtin_amdgcn_mfma_f32_32x32x16_bf16(pa2, PK(l2, h2), od, 0, 0, 0);
    od = __builtin_amdgcn_mfma_f32_32x32x16_bf16(pa3, PK(l3, h3), od, 0, 0, 0);
#undef PK
}
__device__ __forceinline__ void pv_d0(f32x16* o, int vb, bf16x8 pa0, bf16x8 pa1, bf16x8 pa2, bf16x8 pa3) {
    pv_one<0>(o[0], vb, pa0, pa1, pa2, pa3); pv_one<1>(o[1], vb, pa0, pa1, pa2, pa3); pv_one<2>(o[2], vb, pa0, pa1, pa2, pa3); pv_one<3>(o[3], vb, pa0, pa1, pa2, pa3);
}
template <bool DIRECT>
__device__ __forceinline__ void attn_unit(LAS unsigned char* lds, const bf16_t* QKV, const bf16_t* Z, int qrow0, int h, int crow0, int lrow0, int t0, int NT,
                                          float* Opart, float* Lse, bf16_t* MIX, const int tid) {
    const int wid = tid >> 6, lane = tid & 63, r32 = lane & 31, hi = lane >> 5;
    LAS unsigned char* V_lds = lds; LAS unsigned char* K_lds = lds + OFF_K;
    LAS float* ws = (LAS float*)(lds + OFF_WS) + wid * 64; LAS float* li_l = ws; LAS float* al_l = ws + 32;
    float m_reg = -1e30f, l_reg = 0; f32x16 o[4] = {}; bf16x8 qr[8];
    const bf16_t* Qw = QKV + (size_t)(qrow0 + wid * QBLK + r32) * NUP + h * 192 + hi * 8;
#pragma unroll
    for (int d0 = 0; d0 < 8; ++d0) qr[d0] = *(const bf16x8*)(Qw + d0 * 16);
    LAS unsigned char* qrp = lds + OFF_QR + wid * 4096 + r32 * 128; const int qsw = (r32 >> 1) & 7;
    int kq[4];
#pragma unroll
    for (int q = 0; q < 4; ++q) kq[q] = 384 * r32 + (((2 * q + hi) ^ qsw) << 4);
#pragma unroll
    for (int d0 = 8; d0 < 12; ++d0) *(LAS bf16x8*)(qrp + (((2 * (d0 - 8) + hi) ^ qsw) << 4)) = *(const bf16x8*)(Qw + d0 * 16);
    const int sr = tid >> 4, sc = (tid & 15) * 8;
    const int vst0 = v_st(sr, sc);
    const int kst0 = KSWZ(sr, sc * 2);
    const int krst = KSWZ(tid >> 3, 256 + (tid & 7) * 16);
    const unsigned voffV = (unsigned)(sr * NUP + sc) * 2u, voffR = (unsigned)((tid >> 3) * INWP + (tid & 7) * 8) * 2u;
    const char* Vb = (const char*)(QKV + 768 + h * 256 + 128); const char* Kb = (const char*)(QKV + 768 + h * 256); const char* Rb = (const char*)(Z + ZKR);
    const int vb0 = (int)(uintptr_t)V_lds + v_rd_base(lane);
    bf16x8 vs0, vs1, ks0, ks1, ks2;
#define ROW0(kt) (((t0) + (kt)) < 4 ? crow0 + 64 * ((t0) + (kt)) : lrow0 + 64 * ((t0) + (kt) - 4))
#define SLOADV(kt) do { const size_t _r0 = (size_t)__builtin_amdgcn_readfirstlane(ROW0(kt)); const char* _v = Vb + _r0 * (NUP * 2) + voffV; \
    vs0 = *(const bf16x8*)(_v); vs1 = *(const bf16x8*)(_v + 32 * NUP * 2); } while (0)
#define SLOADK(kt) do { const size_t _r0 = (size_t)__builtin_amdgcn_readfirstlane(ROW0(kt)); const char* _k = Kb + _r0 * (NUP * 2) + voffV; \
    ks0 = *(const bf16x8*)(_k); ks1 = *(const bf16x8*)(_k + 32 * NUP * 2); ks2 = *(const bf16x8*)(Rb + _r0 * (INWP * 2) + voffR); } while (0)
#define SLOAD(kt) do { SLOADV(kt); SLOADK(kt); } while (0)
#define SWRITE(b) do { *(LAS bf16x8*)(V_lds + (b) * SHM_V + vst0) = vs0; *(LAS bf16x8*)(V_lds + (b) * SHM_V + vst0 + 8192) = vs1; \
    *(LAS bf16x8*)(K_lds + (b) * SHM_K + kst0) = ks0; *(LAS bf16x8*)(K_lds + (b) * SHM_K + kst0 + 32 * 384) = ks1; *(LAS bf16x8*)(K_lds + (b) * SHM_K + krst) = ks2; } while (0)
#define SWAIT() asm volatile("s_waitcnt vmcnt(0)" ::: "memory")
#define RESC(a) do { if (__any((a) < 1.f)) { if (hi == 0) al_l[r32] = (a); asm volatile("s_waitcnt lgkmcnt(0)" ::: "memory"); \
    _Pragma("unroll") for (int d = 0; d < 4; ++d) _Pragma("unroll") for (int r = 0; r < 16; ++r) o[d][r] *= al_l[crow(r, hi)]; } } while (0)
    f32x16 pA0, pA1, pB0, pB1; float mnA, mnB, alA, alB; bf16x8 pa0, pa1, pa2, pa3;
    SLOAD(0); SWAIT(); SWRITE(0); __syncthreads();
    qkt(pA0, pA1, K_lds, qr, qrp, qsw, kq, hi); partialSM(pA0, pA1, m_reg, mnA, alA);
    SLOAD(1);
    SWAIT(); SWRITE(1); __syncthreads();
    for (int j = 1; j + 1 < NT; j += 2) {
        SBAR(); qkt(pB0, pB1, K_lds + SHM_K, qr, qrp, qsw, kq, hi);
        finishSM(pA0, pA1, alA, l_reg, pa0, pa1, pa2, pa3); SBAR();
        SLOADV(j + 1); SBAR();
        pv_d0(o, vb0, pa0, pa1, pa2, pa3); SBAR(); SLOADK(j + 1); SBAR(); partialSM(pB0, pB1, m_reg, mnB, alB);
        __syncthreads(); SWAIT(); SWRITE(0);
        RESC(alB); __syncthreads();
        SBAR(); qkt(pA0, pA1, K_lds, qr, qrp, qsw, kq, hi);
        finishSM(pB0, pB1, alB, l_reg, pa0, pa1, pa2, pa3); SBAR();
        SLOADV(j + 2); SBAR();
        pv_d0(o, vb0 + SHM_V, pa0, pa1, pa2, pa3); SBAR(); SLOADK(j + 2); SBAR(); partialSM(pA0, pA1, m_reg, mnA, alA);
        __syncthreads(); SWAIT(); SWRITE(1);
        RESC(alA); __syncthreads();
    }
    SBAR(); qkt(pB0, pB1, K_lds + SHM_K, qr, qrp, qsw, kq, hi);
    finishSM(pA0, pA1, alA, l_reg, pa0, pa1, pa2, pa3); SBAR();
    pv_d0(o, vb0, pa0, pa1, pa2, pa3); partialSM(pB0, pB1, m_reg, mnB, alB);
    __syncthreads(); RESC(alB);
    finishSM(pB0, pB1, alB, l_reg, pa0, pa1, pa2, pa3); SBAR();
    pv_d0(o, vb0 + SHM_V, pa0, pa1, pa2, pa3);
    if (hi == 0) li_l[r32] = l_reg; asm volatile("s_waitcnt lgkmcnt(0)" ::: "memory");
    float rli[16];
#pragma unroll
    for (int r = 0; r < 16; ++r) rli[r] = __builtin_amdgcn_rcpf(li_l[crow(r, hi)]);
    const int qw0 = qrow0 + wid * QBLK;
    if constexpr (DIRECT) {
#pragma unroll
        for (int r = 0; r < 16; ++r) { const int orow = crow(r, hi);
#pragma unroll
            for (int d0 = 0; d0 < 4; ++d0) MIX[(size_t)(qw0 + orow) * DM + 1536 + h * 128 + d0 * 32 + r32] = f2bf(o[d0][r] * rli[r]); }
    } else {
#pragma unroll
        for (int r = 0; r < 16; ++r) { const int orow = crow(r, hi);
#pragma unroll
            for (int d0 = 0; d0 < 4; ++d0) Opart[(size_t)(qw0 + orow) * 512 + h * 128 + d0 * 32 + r32] = o[d0][r] * rli[r]; }
        if (hi == 0) Lse[(size_t)(qw0 + r32) * 4 + h] = m_reg * (SCALE * 1.4426950408889634f) + __builtin_amdgcn_logf(l_reg);
    }
    __syncthreads();
#undef ROW0
#undef SLOAD
#undef SWRITE
#undef SWAIT
#undef RESC
}
#undef KSWZ
#undef SBAR
}

__device__ __forceinline__ void attn_combine(const Params& P, int tid, int G, int bid) {
    const float* OP = (const float*)(P.ws + WS_OP); const float* LS = (const float*)(P.ws + WS_LSE); bf16_t* MIX = (bf16_t*)(P.ws + WS_MIX);
    for (int i = bid * 512 + tid; i < ML * 64; i += G * 512) {
        const int row = i >> 6, rem = i & 63, h = rem >> 4, cg = (rem & 15) * 8;
        const float l1 = LS[(size_t)row * 4 + h], l2 = LS[((size_t)ML + row) * 4 + h], m = fmaxf(l1, l2);
        float w1 = __builtin_amdgcn_exp2f(l1 - m), w2 = __builtin_amdgcn_exp2f(l2 - m); const float inv = 1.0f / (w1 + w2); w1 *= inv; w2 *= inv;
        const float* a = OP + (size_t)row * 512 + h * 128 + cg; const float* b = OP + ((size_t)ML + row) * 512 + h * 128 + cg;
        const f32x4 a0 = *(const f32x4*)a, a1 = *(const f32x4*)(a + 4), b0 = *(const f32x4*)b, b1 = *(const f32x4*)(b + 4);
        const f32x4 o0 = a0 * w1 + b0 * w2, o1 = a1 * w1 + b1 * w2;
        u32x4 w; w.x = cvt_pk_bf16(o0[0], o0[1]); w.y = cvt_pk_bf16(o0[2], o0[3]); w.z = cvt_pk_bf16(o1[0], o1[1]); w.w = cvt_pk_bf16(o1[2], o1[3]);
        *(u32x4*)(MIX + (size_t)row * DM + 1536 + h * 128 + cg) = w;
    }
}

constexpr int PH_PER_LAYER = 9, N_PHASES = 2 + DEPTH * PH_PER_LAYER + 1;
typedef const __attribute__((address_space(4))) Params* KParams;
__global__ void __launch_bounds__(512, 2) mk_fwd(Params Pk) {
    extern __shared__ __attribute__((aligned(16))) unsigned char lds_raw[];
    LAS unsigned char* lds = (LAS unsigned char*)lds_raw;
    const int G = gridDim.x, bid = blockIdx.x;
    KParams kp0 = (KParams)__builtin_amdgcn_kernarg_segment_ptr();
    const int wave0 = __builtin_amdgcn_readfirstlane(threadIdx.x >> 6);
#define OPQ int tid; asm volatile("v_mbcnt_lo_u32_b32 %0, -1, 0\n\tv_mbcnt_hi_u32_b32 %0, -1, %0" : "=v"(tid)); tid |= wave0 << 6; const int lane = tid & 63, wave = __builtin_amdgcn_readfirstlane(tid >> 6); (void)lane; (void)wave; \
    KParams kp = kp0; asm volatile("" : "+s"(kp)); Params P; { const __attribute__((address_space(4))) unsigned long long* _q = (const __attribute__((address_space(4))) unsigned long long*)kp; unsigned long long* _d = (unsigned long long*)&P; \
      _Pragma("unroll") for (int _i = 0; _i < (int)(sizeof(Params) / 8); ++_i) _d[_i] = _q[_i]; } unsigned char* const ws = P.ws; (void)ws;
    volatile LAS unsigned* MISC = (volatile LAS unsigned*)(lds + LDS_MISC);
    for (int u = threadIdx.x; u < 256; u += 512) ((LAS unsigned*)(lds + LDS_MISC))[u] = 0u;
    __syncthreads();
    const int lo = kp0->ph_lo, hi = kp0->ph_hi;
    XcdBarrier bar; bar.bar = (unsigned*)(kp0->ws + WS_CTL) + 1024; bar.x = 0; bar.st = nullptr;
    if (hi - lo > 1) bar = xcd_barrier_post((unsigned*)(kp0->ws + WS_CTL) + 1024, MISC + 8);
#define IN(k) (lo <= (k) && (k) < hi)
#define SEAM(k) do { if (IN(k) && IN((k) + 1)) xcd_barrier(bar); } while (0)
#define XRES ((float*)(ws + WS_XRES))
#define MODL ((const float*)(ws + WS_MODV) + (size_t)layer * 3 * 6 * DM)
#define RSTAT ((float*)(ws + WS_RSTAT) + (size_t)layer * MT * 2)
#define ROPE ((const f32x2*)(ws + WS_ROPE))
#define HB ((bf16_t*)(ws + WS_H))
#define ZB ((bf16_t*)(ws + WS_Z))
#define QKVB ((bf16_t*)(ws + WS_QKV))
#define MIXB ((bf16_t*)(ws + WS_MIX))
#define UB_ ((bf16_t*)(ws + WS_U))

    if (PHM(0) && IN(0)) { OPQ phase_p0a(P, lds, tid, lane, wave, G, bid); } SEAM(0);
    if (PHM(1) && IN(1)) { OPQ phase_p0b(P, tid, G, bid); } SEAM(1);

    for (int layer = 0; layer < DEPTH; ++layer) {
        const int pb = 2 + layer * PH_PER_LAYER;
        const bool need_ctx = layer < DEPTH - 1;
        const int mrows = need_ctx ? MT : ML;

        if (PHM(2) && IN(pb + 0)) { OPQ
            const float* xl = layer == 0 ? P.x : XRES; const float* xc = layer == 0 ? P.ctx : XRES + (size_t)ML * DM;
            phase_norm(xl, xc, MODL, 1, 0, HB, MT, lane, wave, G, bid); } SEAM(pb + 0);
        if (PHM(3) && IN(pb + 1)) { OPQ
            pg8::Gemm g{HB, (const bf16_t*)(ws + WS_WIN) + (size_t)layer * INWP * DM, MT, INWP, DM, DM, DM}; pg8::StaticOrder S; S.init(MT, INWP, G, bid);
            pg8::EpiIn E{ZB, RSTAT, ROPE};
            pg8::gemm_phase<pg8::EpiIn, pg8::StaticOrder>(lds, g, S, E, tid);
        } SEAM(pb + 1);
        if (IN(pb + 2)) { OPQ
            if (PHM(4)) {
                pg8::Gemm g{ZB + ZCQ, (const bf16_t*)(ws + WS_WUP) + (size_t)layer * NUP * KUP, MT, NUP, KUP, INWP, KUP}; pg8::StaticOrder S; S.init(MT, NUP, G, bid);
                pg8::EpiUp E{QKVB, RSTAT, ROPE};
                pg8::gemm_phase<pg8::EpiUp, pg8::StaticOrder>(lds, g, S, E, tid);
            }
            constexpr int N_G1 = 2 * 4 * 2 * NCH, N_CF = MT / 16, N_SC = MT / 16;
            const int nup_units = (MT / 256) * (NUP / 256);
            int start = bid - (nup_units % G); if (start < 0) start += G;
            for (int it = start; it < N_G1 + N_CF + N_SC; it += G) {
                if (it < N_G1) { if (PHM(5)) gla_g1_item(lds, P, layer, it, tid, lane, wave); }
                else if (it < N_G1 + N_CF) { if (PHM(6)) conf_item(lds, P, layer, it - N_G1, tid, lane, wave); }
                else { if (PHM(7)) sconv_item(P, layer, it - N_G1 - N_CF, tid); }
            }
        } SEAM(pb + 2);
        if (IN(pb + 3)) { OPQ
            if (PHM(8)) gla_g2(P, tid, G, bid);
            if (PHM(9)) for (int u = bid; u < 256; u += G) {
                const int bh = u & 7, sub = u >> 3, b = bh >> 2, h = bh & 3, qb = sub >> 1, half = sub & 1;
                att::attn_unit<false>(lds, QKVB, ZB, b * SEQ + qb * 256, h, ML + b * CTX, b * SEQ, half * 34, 34,
                                      (float*)(ws + WS_OP) + (size_t)half * ML * 512, (float*)(ws + WS_LSE) + (size_t)half * ML * 4, MIXB, tid);
            }
        } SEAM(pb + 3);
        if (IN(pb + 4)) { OPQ
            if (PHM(10)) for (int it = bid; it < 2 * 4 * NCH; it += G) gla_g3_item(lds, P, layer, it, tid, lane, wave);
            if (PHM(11)) attn_combine(P, tid, G, bid);
            if (PHM(12) && need_ctx) {
                int start = bid - ((2 * 4 * NCH) % G); if (start < 0) start += G;
                for (int u = start; u < 8; u += G) { const int b = u >> 2, h = u & 3;
                    att::attn_unit<true>(lds, QKVB, ZB, ML + b * CTX, h, ML + b * CTX, 0, 0, 4, nullptr, nullptr, MIXB, tid); }
            }
        } SEAM(pb + 4);
        if (PHM(13) && IN(pb + 5)) { OPQ
            const float* xl = layer == 0 ? P.x : XRES; const float* xc = layer == 0 ? P.ctx : XRES + (size_t)ML * DM;
            pg8::Gemm g{MIXB, (const bf16_t*)(ws + WS_WOUT) + (size_t)layer * DM * DM, mrows, DM, DM, DM, DM}; pg8::StaticOrder S; S.init(mrows, DM, G, bid);
            pg8::EpiRes E{xl, xc, XRES, MODL + 2 * DM};
            pg8::gemm_phase<pg8::EpiRes, pg8::StaticOrder>(lds, g, S, E, tid);
        } SEAM(pb + 5);
        if (PHM(2) && IN(pb + 6)) { OPQ phase_norm(XRES, XRES + (size_t)ML * DM, MODL, 4, 3, HB, mrows, lane, wave, G, bid); } SEAM(pb + 6);
        if (PHM(14) && IN(pb + 7)) { OPQ
            pg8::Gemm g{HB, (const bf16_t*)(ws + WS_W13) + (size_t)layer * 2 * DFF * DM, mrows, 2 * DFF, DM, DM, DM}; pg8::StaticOrder S; S.init(mrows, 2 * DFF, G, bid);
            pg8::EpiSwiglu E{UB_};
            pg8::gemm_phase<pg8::EpiSwiglu, pg8::StaticOrder>(lds, g, S, E, tid);
        } SEAM(pb + 7);
        if (PHM(15) && IN(pb + 8)) { OPQ
            pg8::Gemm g{UB_, (const bf16_t*)(ws + WS_W2) + (size_t)layer * DM * DFF, mrows, DM, DFF, DFF, DFF}; pg8::StaticOrder S; S.init(mrows, DM, G, bid);
            pg8::EpiRes E{XRES, XRES + (size_t)ML * DM, XRES, MODL + 5 * DM};
            pg8::gemm_phase<pg8::EpiRes, pg8::StaticOrder>(lds, g, S, E, tid);
        } SEAM(pb + 8);
    }
    if (PHM(16) && IN(N_PHASES - 1)) { OPQ phase_final(XRES, P.final_g, P.out, lane, wave, G, bid); }
#undef IN
#undef SEAM
}

extern "C" void kernel_launch(void* const* d_in, const int* in_sizes, int n_in, void* d_out, int out_size, void* d_ws, size_t ws_size, hipStream_t stream) {
    static int grid = 0;
    if (grid == 0) {
        if (n_in != 26 || in_sizes[0] != ML * DM || out_size != ML * DM || ws_size < WS_END) {
            fprintf(stderr, "kernel_launch: shape mismatch: n_in %d in0 %d out %d ws %zu (need %zu); nothing launched\n", n_in, n_in > 0 ? in_sizes[0] : -1, out_size, ws_size, (size_t)WS_END); grid = -1; return; }
        int dev = 0, cus = 0, per_cu = 0;
        if (hipGetDevice(&dev) != hipSuccess || hipDeviceGetAttribute(&cus, hipDeviceAttributeMultiprocessorCount, dev) != hipSuccess) { fprintf(stderr, "kernel_launch: device query failed\n"); grid = -1; return; }
        if (hipFuncSetAttribute((const void*)mk_fwd, hipFuncAttributeMaxDynamicSharedMemorySize, LDS_BYTES) != hipSuccess) { fprintf(stderr, "kernel_launch: hipFuncSetAttribute failed\n"); grid = -1; return; }
        if (hipOccupancyMaxActiveBlocksPerMultiprocessor(&per_cu, (const void*)mk_fwd, 512, LDS_BYTES) != hipSuccess || per_cu < 1)
            fprintf(stderr, "kernel_launch: note: occupancy query reports %d workgroups per CU\n", per_cu);
        (void)hipGetLastError();
        grid = cus;
    }
    if (grid < 0) return;
    if (hipMemsetAsync((char*)d_ws + WS_CTL, 0, CTL_BYTES, stream) != hipSuccess) { fprintf(stderr, "kernel_launch: memset failed\n"); return; }
    Params p{};
    const float** pp = (const float**)&p;
    for (int i = 0; i < 26; ++i) pp[i] = (const float*)d_in[i];
    p.out = (float*)d_out; p.ws = (unsigned char*)d_ws;
#if MK_MULTI
    for (int ph = 0; ph < N_PHASES; ++ph) { p.ph_lo = ph; p.ph_hi = ph + 1; hipLaunchKernelGGL(mk_fwd, dim3(grid), dim3(512), LDS_BYTES, stream, p); }
#else
    p.ph_lo = 0; p.ph_hi = N_PHASES;
    hipLaunchKernelGGL(mk_fwd, dim3(grid), dim3(512), LDS_BYTES, stream, p);
#endif
    const hipError_t le = hipPeekAtLastError();
    if (le != hipSuccess) fprintf(stderr, "kernel_launch: launch failed: %s\n", hipGetErrorName(le));
}
```

```cpp
#include <hip/hip_runtime.h>
#include <cstdio>
#include <cstdint>

#ifndef MK_MULTI
#define MK_MULTI 0
#endif

#ifndef PH_MASK
#define PH_MASK 0xFFFFFFFFu
#endif
#define PHM(b) ((PH_MASK >> (b)) & 1u)
#ifndef PROBE_ID
#define PROBE_ID 0
#endif
#define PREP(id) (PROBE_ID == (id) ? 2 : 1)
#define LAS __attribute__((address_space(3)))
#define GAS __attribute__((address_space(1)))
typedef unsigned short bf16_t;
typedef short bf16x8 __attribute__((ext_vector_type(8)));
typedef short s16x4 __attribute__((ext_vector_type(4)));
typedef float f32x4 __attribute__((ext_vector_type(4)));
typedef float f32x2 __attribute__((ext_vector_type(2)));
typedef float f32x16 __attribute__((ext_vector_type(16)));
typedef unsigned u32x4 __attribute__((ext_vector_type(4)));
typedef unsigned u32x2 __attribute__((ext_vector_type(2)));

constexpr int DM = 2048, NB = 2, SEQ = 4096, CTX = 256, DEPTH = 4, DFF = 5632;
constexpr int ML = NB * SEQ, MC = NB * CTX, MT = ML + MC;
constexpr int INW = 5216, INWP = 5376;
constexpr int ZQ = 0, ZK = 512, ZV = 1024, ZG = 1536, ZLR = 2048, ZCA = 2080, ZCG = 2592, ZSB = 3104, ZSC = 3616, ZSH = 4128, ZCQ = 4640, ZCKV = 5024, ZKR = 5152;
constexpr int NUP = 1792, KUP = 512;
constexpr int NCH = 68;
constexpr float EPS = 1e-6f;

constexpr size_t al256(size_t x) { return (x + 255) / 256 * 256; }
constexpr size_t WS_CTL = 0, CTL_BYTES = 1u << 20;
constexpr size_t WS_ROPE = WS_CTL + CTL_BYTES;
constexpr size_t WS_MODP = WS_ROPE + 8192;
constexpr size_t WS_MODV = WS_MODP + al256((size_t)8 * 4 * 3 * 12288 * 4);
constexpr size_t WS_RSTAT = WS_MODV + al256((size_t)4 * 3 * 6 * 2048 * 4);
constexpr size_t WS_WIN = WS_RSTAT + al256((size_t)4 * MT * 2 * 4);
constexpr size_t WS_WOUT = WS_WIN + (size_t)4 * INWP * DM * 2;
constexpr size_t WS_W13 = WS_WOUT + (size_t)4 * DM * DM * 2;
constexpr size_t WS_W2 = WS_W13 + (size_t)4 * 2 * DFF * DM * 2;
constexpr size_t WS_WUP = WS_W2 + (size_t)4 * DM * DFF * 2;
constexpr size_t WS_XRES = WS_WUP + (size_t)4 * NUP * KUP * 2;
constexpr size_t WS_H = WS_XRES + (size_t)MT * DM * 4;
constexpr size_t WS_Z = WS_H + (size_t)MT * DM * 2;
constexpr size_t WS_QKV = WS_Z + (size_t)MT * INWP * 2;
constexpr size_t WS_MIX = WS_QKV + (size_t)MT * NUP * 2;
constexpr size_t WS_U = WS_MIX + (size_t)MT * DM * 2;
constexpr size_t WS_GU = WS_U + (size_t)MT * DFF * 2;
constexpr size_t WS_GD = WS_GU + (size_t)16 * NCH * 16384 * 4;
constexpr size_t WS_GS = WS_GD + (size_t)16 * NCH * 128 * 4;
constexpr size_t WS_OP = WS_GS + (size_t)16 * NCH * 16384 * 2;
constexpr size_t WS_LSE = WS_OP + (size_t)2 * ML * 512 * 4;
constexpr size_t WS_END = WS_LSE + (size_t)2 * ML * 4 * 4;

constexpr int LDS_MAIN = 131072, LDS_MISC = LDS_MAIN, LDS_BYTES = LDS_MAIN + 1024;

__device__ __forceinline__ unsigned cvt_pk_bf16(float lo, float hi) { unsigned r; asm volatile("v_cvt_pk_bf16_f32 %0, %1, %2" : "=v"(r) : "v"(lo), "v"(hi)); return r; }
__device__ __forceinline__ float bf2f(unsigned short b) { return __uint_as_float(((unsigned)b) << 16); }
__device__ __forceinline__ float bflo(unsigned w) { return __uint_as_float(w << 16); }
__device__ __forceinline__ float bfhi(unsigned w) { return __uint_as_float(w & 0xffff0000u); }
__device__ __forceinline__ unsigned short f2bf(float f) { return (unsigned short)(cvt_pk_bf16(f, 0.f) & 0xffffu); }
__device__ __forceinline__ float wave_sum(float v) {
#pragma unroll
    for (int o = 1; o < 64; o <<= 1) v += __shfl_xor(v, o);
    return v;
}
__device__ __forceinline__ float sigmoidf_(float x) { return 1.0f / (1.0f + __expf(-x)); }
__device__ __forceinline__ float siluf_(float x) { return x / (1.0f + __expf(-x)); }
__device__ __forceinline__ float dot4(const f32x4& v) { return (v[0] * v[0] + v[1] * v[1]) + (v[2] * v[2] + v[3] * v[3]); }
#define LDS_WAIT() asm volatile("s_waitcnt lgkmcnt(0)" ::: "memory")
#define VM_WAIT() asm volatile("s_waitcnt vmcnt(0)" ::: "memory")

namespace pg8 {
#define PG8_LAS __attribute__((address_space(3)))
constexpr int BM = 256, BK = 64, HALF = 128, HTB = HALF * BK * 2, STAGE_BYTES = 8 * HTB, NXCD = 8, WGM = 8;
__host__ __device__ __forceinline__ int lds_byte(int r, int c) { const int st = (r >> 4) * 2 + (c >> 5), rr = r & 15, cc = c & 31, ob = rr * 64 + cc * 2; return st * 1024 + (ob ^ (((ob >> 9) & 1) << 5)); }
__host__ __device__ __forceinline__ void stage_rc(int b, int& R, int& C) { const int st = b / 1024, sb = b % 1024, swz = sb ^ (((sb >> 9) & 1) << 5); R = (st >> 1) * 16 + swz / 64; C = (st & 1) * 32 + (swz % 64) / 2; }
__host__ __device__ __forceinline__ int perm32(int rho) { const int n = rho >> 4, i = rho & 15; return 8 * (i >> 2) + 4 * n + (i & 3); }
struct Unit { int pm, pn; };
struct Gemm { const bf16_t* A; const bf16_t* Bt; int M, N, K, lda, ldb; };
struct StaticOrder {
    int nM, nN, nwg, G, c;
    __host__ __device__ void init(int M, int N, int G_, int c_) { nM = M / BM; nN = N / BM; nwg = nM * nN; G = G_; c = c_; }
    __host__ __device__ bool next(int i, Unit& u) const {
        const long L = (long)i * G + c; if (L >= nwg) return false;
        int wgid = (int)L; { const int q = nwg / NXCD, r = nwg % NXCD, xcd = wgid % NXCD, off = wgid / NXCD; wgid = (xcd < r ? xcd * (q + 1) : r * (q + 1) + (xcd - r) * q) + off; }
        const int nig = WGM * nN, gid = wgid / nig, fm = gid * WGM, gsz = (nM - fm) < WGM ? (nM - fm) : WGM;
        u.pm = fm + ((wgid % nig) % gsz); u.pn = (wgid % nig) / gsz; return true;
    }
    __device__ __forceinline__ void a_ready(const Unit&) const {}
    __device__ __forceinline__ void done(const Unit&) const {}
};
template <class Epi, class Sched, bool ALIGN_EPI = true, bool SP2 = true>
__device__ __forceinline__ void gemm_phase(PG8_LAS unsigned char* lds, const Gemm g, const Sched& S, const Epi& E, const int tid) {
    const int wid = __builtin_amdgcn_readfirstlane(tid >> 6), lane = tid & 63, wr = wid >> 2, wc = wid & 3, fr = lane & 15, fq = lane >> 4;
    const int K = g.K, nt = K / BK;
    unsigned voffA[2], voffB[2];
#pragma unroll
    for (int i = 0; i < 2; ++i) { int R, C; stage_rc(tid * 16 + i * 8192, R, C); const int Rb = Epi::PERM ? ((R & ~31) + perm32(R & 31)) : R;
        voffA[i] = (unsigned)(R * g.lda + C) * 2u; voffB[i] = (unsigned)(Rb * g.ldb + C) * 2u; }
    const size_t kstep = (size_t)(BK * 2);
    const size_t hstepA = (size_t)HALF * g.lda * 2, hstepB = (size_t)HALF * g.ldb * 2;
    const size_t tstepA = 2 * hstepA, tstepB = 2 * hstepB;
    const unsigned ldsw = (unsigned)wid * 1024u;
    const int aoff = lds_byte(wr * 64 + fr, fq * 8), boff = lds_byte(wc * 32 + fr, fq * 8);
#define PG8_SA(b, h) (((b) * 2 + (h)) * HTB)
#define PG8_SB(b, h) ((4 + (b) * 2 + (h)) * HTB)
#define PG8_STAGE(bufoff, gbase, voff) do { _Pragma("unroll") for (int _i = 0; _i < 2; ++_i) \
        __builtin_amdgcn_global_load_lds((const unsigned*)((const char*)(gbase) + (voff)[_i]), (PG8_LAS unsigned*)(lds + (bufoff) + ldsw + _i * 8192), 16, 0, 0); } while (0)
#define PG8_LDA(dst, b, h) do { _Pragma("unroll") for (int m = 0; m < 4; ++m) _Pragma("unroll") for (int k = 0; k < 2; ++k) dst[m][k] = *(const PG8_LAS bf16x8*)(lds + PG8_SA(b, h) + aoff + m * 2048 + k * 1024); } while (0)
#define PG8_LDB(dst, b, h) do { _Pragma("unroll") for (int n = 0; n < 2; ++n) _Pragma("unroll") for (int k = 0; k < 2; ++k) dst[n][k] = *(const PG8_LAS bf16x8*)(lds + PG8_SB(b, h) + boff + n * 2048 + k * 1024); } while (0)
#define PG8_MMA(ai, bj, At, Bt) do { __builtin_amdgcn_s_setprio(1); _Pragma("unroll") for (int m = 0; m < 4; ++m) _Pragma("unroll") for (int n = 0; n < 2; ++n) _Pragma("unroll") for (int k = 0; k < 2; ++k) \
        acc[ai][bj][m][n] = __builtin_amdgcn_mfma_f32_16x16x32_bf16(Bt[n][k], At[m][k], acc[ai][bj][m][n], 0, 0, 0); __builtin_amdgcn_s_setprio(0); } while (0)
#define PG8_WAIT_V(n) asm volatile("s_waitcnt vmcnt(" #n ")" ::: "memory")
#define PG8_WAIT_L(n) asm volatile("s_waitcnt lgkmcnt(" #n ")" ::: "memory")
#define PG8_BAR __builtin_amdgcn_s_barrier()
#define PG8_SCHED __builtin_amdgcn_sched_barrier(0)
    Unit cur, nxt; int ui = 0;
    if (!S.next(0, cur)) return;
    f32x4 acc[2][2][4][2];
#pragma unroll
    for (int a = 0; a < 2; ++a)
#pragma unroll
        for (int b = 0; b < 2; ++b)
#pragma unroll
            for (int m = 0; m < 4; ++m)
#pragma unroll
                for (int n = 0; n < 2; ++n) acc[a][b][m][n] = (f32x4){0.f, 0.f, 0.f, 0.f};
    bf16x8 At[4][2], B0[2][2], B1[2][2];
    const char* cA = (const char*)g.A + (size_t)cur.pm * tstepA; const char* cB = (const char*)g.Bt + (size_t)cur.pn * tstepB;
    S.a_ready(cur);
    if constexpr (SP2) {
        PG8_STAGE(PG8_SB(0, 0), cB, voffB); PG8_STAGE(PG8_SB(0, 1), cB + hstepB, voffB); PG8_STAGE(PG8_SA(0, 0), cA, voffA); PG8_STAGE(PG8_SA(0, 1), cA + hstepA, voffA);
        if (wr == 1) PG8_BAR;
        PG8_WAIT_V(2); PG8_BAR;
        PG8_STAGE(PG8_SB(1, 0), cB + kstep, voffB); PG8_STAGE(PG8_SA(1, 0), cA + kstep, voffA); PG8_STAGE(PG8_SB(1, 1), cB + hstepB + kstep, voffB);
        PG8_WAIT_V(6); PG8_BAR;
    } else {
        PG8_STAGE(PG8_SB(0, 0), cB, voffB); PG8_STAGE(PG8_SA(0, 0), cA, voffA); PG8_STAGE(PG8_SB(0, 1), cB + hstepB, voffB); PG8_STAGE(PG8_SA(0, 1), cA + hstepA, voffA);
        if (wr == 1) PG8_BAR;
        PG8_WAIT_V(4); PG8_BAR;
        PG8_STAGE(PG8_SB(1, 0), cB + kstep, voffB); PG8_STAGE(PG8_SA(1, 0), cA + kstep, voffA); PG8_STAGE(PG8_SB(1, 1), cB + hstepB + kstep, voffB);
        PG8_WAIT_V(6); PG8_BAR;
    }
    for (;;) {
        const bool has_next = S.next(ui + 1, nxt);
        const char* nA = has_next ? (const char*)g.A + (size_t)nxt.pm * tstepA : cA; const char* nB = has_next ? (const char*)g.Bt + (size_t)nxt.pn * tstepB : cB;
        for (int t = 0; t < nt; t += 2) {
            const bool last = (t == nt - 2);
            const char* a1 = cA + (size_t)(t + 1) * kstep;
            const char* a2 = last ? nA : cA + (size_t)(t + 2) * kstep; const char* b2 = last ? nB : cB + (size_t)(t + 2) * kstep;
            const char* a3 = a2 + kstep; const char* b3 = b2 + kstep;
            if (last && has_next) S.a_ready(nxt);
            if constexpr (SP2) {
            PG8_LDB(B0, 0, 0); PG8_LDB(B1, 0, 1); PG8_SCHED; PG8_LDA(At, 0, 0); PG8_STAGE(PG8_SA(1, 1), a1 + hstepA, voffA);
            PG8_WAIT_V(8); PG8_WAIT_L(0); PG8_BAR; PG8_MMA(0, 0, At, B0); PG8_MMA(0, 1, At, B1); PG8_BAR; PG8_SCHED;
            PG8_LDA(At, 0, 1); PG8_STAGE(PG8_SB(0, 0), b2, voffB); PG8_STAGE(PG8_SB(0, 1), b2 + hstepB, voffB); PG8_STAGE(PG8_SA(0, 0), a2, voffA);
            PG8_WAIT_V(8); PG8_WAIT_L(0); PG8_BAR; PG8_MMA(1, 0, At, B0); PG8_MMA(1, 1, At, B1); PG8_BAR; PG8_SCHED;
            PG8_LDB(B0, 1, 0); PG8_LDB(B1, 1, 1); PG8_SCHED; PG8_LDA(At, 1, 0); PG8_STAGE(PG8_SA(0, 1), a2 + hstepA, voffA);
            PG8_WAIT_V(8); PG8_WAIT_L(0); PG8_BAR; PG8_MMA(0, 0, At, B0); PG8_MMA(0, 1, At, B1); PG8_BAR; PG8_SCHED;
            PG8_LDA(At, 1, 1); PG8_STAGE(PG8_SB(1, 0), b3, voffB); PG8_STAGE(PG8_SB(1, 1), b3 + hstepB, voffB); PG8_STAGE(PG8_SA(1, 0), a3, voffA);
            PG8_WAIT_V(8); PG8_WAIT_L(0); PG8_BAR; PG8_MMA(1, 0, At, B0); PG8_MMA(1, 1, At, B1); PG8_BAR; PG8_SCHED;
            } else {
            PG8_LDB(B0, 0, 0); PG8_SCHED; PG8_LDA(At, 0, 0); PG8_STAGE(PG8_SA(1, 1), a1 + hstepA, voffA);
            PG8_WAIT_L(8); PG8_BAR; PG8_WAIT_L(0); PG8_MMA(0, 0, At, B0); PG8_BAR; PG8_SCHED;
            PG8_LDB(B1, 0, 1); PG8_STAGE(PG8_SB(0, 0), b2, voffB);
            PG8_BAR; PG8_WAIT_L(0); PG8_MMA(0, 1, At, B1); PG8_BAR;
            PG8_LDA(At, 0, 1); PG8_STAGE(PG8_SA(0, 0), a2, voffA);
            PG8_BAR; PG8_WAIT_L(0); PG8_MMA(1, 0, At, B0); PG8_BAR; PG8_SCHED;
            PG8_STAGE(PG8_SB(0, 1), b2 + hstepB, voffB);
            PG8_WAIT_V(6); PG8_BAR; PG8_MMA(1, 1, At, B1); PG8_BAR;
            PG8_LDB(B0, 1, 0); PG8_SCHED; PG8_LDA(At, 1, 0); PG8_STAGE(PG8_SA(0, 1), a2 + hstepA, voffA);
            PG8_WAIT_L(8); PG8_BAR; PG8_WAIT_L(0); PG8_MMA(0, 0, At, B0); PG8_BAR; PG8_SCHED;
            PG8_LDB(B1, 1, 1); PG8_STAGE(PG8_SB(1, 0), b3, voffB);
            PG8_BAR; PG8_WAIT_L(0); PG8_MMA(0, 1, At, B1); PG8_BAR;
            PG8_LDA(At, 1, 1); PG8_STAGE(PG8_SA(1, 0), a3, voffA);
            PG8_BAR; PG8_WAIT_L(0); PG8_MMA(1, 0, At, B0); PG8_BAR; PG8_SCHED;
            PG8_STAGE(PG8_SB(1, 1), b3 + hstepB, voffB);
            PG8_WAIT_V(6); PG8_BAR; PG8_MMA(1, 1, At, B1); PG8_BAR;
            }
        }
        if constexpr (ALIGN_EPI) { if (wr == 0) PG8_BAR; }
        E(acc, cur, wr, wc, fr, fq);
        if (!has_next) break;
#pragma unroll
        for (int a = 0; a < 2; ++a)
#pragma unroll
            for (int b = 0; b < 2; ++b)
#pragma unroll
                for (int m = 0; m < 4; ++m)
#pragma unroll
                    for (int n = 0; n < 2; ++n) acc[a][b][m][n] = (f32x4){0.f, 0.f, 0.f, 0.f};
        cur = nxt; cA = nA; cB = nB; ++ui;
        if constexpr (ALIGN_EPI) { if (wr == 1) PG8_BAR; }
    }
    PG8_WAIT_V(0);
    if constexpr (!ALIGN_EPI) { if (wr == 0) PG8_BAR; }
    PG8_BAR;
#undef PG8_SA
#undef PG8_SB
#undef PG8_STAGE
#undef PG8_LDA
#undef PG8_LDB
#undef PG8_MMA
#undef PG8_WAIT_V
#undef PG8_WAIT_L
#undef PG8_BAR
#undef PG8_SCHED
}

__device__ __forceinline__ void rope8(f32x4& v0, f32x4& v1, const f32x2* cs) {
    const f32x2 c0 = cs[0], c1 = cs[1], c2 = cs[2], c3 = cs[3];
    float a, b;
    a = v0[0]; b = v0[1]; v0[0] = a * c0.x - b * c0.y; v0[1] = b * c0.x + a * c0.y;
    a = v0[2]; b = v0[3]; v0[2] = a * c1.x - b * c1.y; v0[3] = b * c1.x + a * c1.y;
    a = v1[0]; b = v1[1]; v1[0] = a * c2.x - b * c2.y; v1[1] = b * c2.x + a * c2.y;
    a = v1[2]; b = v1[3]; v1[2] = a * c3.x - b * c3.y; v1[3] = b * c3.x + a * c3.y;
}

struct EpiIn {
    static constexpr bool PERM = true;
    bf16_t* Z; float* rstat; const f32x2* rope;
    __device__ __forceinline__ void operator()(const f32x4 (&acc)[2][2][4][2], const Unit& u, int wr, int wc, int fr, int fq) const {
        const int row0 = u.pm * BM + wr * 64 + fr; const int colw0 = u.pn * BM + wc * 32;
        const bool special = (u.pn >= 18);
#pragma unroll
        for (int ai = 0; ai < 2; ++ai)
#pragma unroll
            for (int m = 0; m < 4; ++m) {
                const int row = row0 + ai * HALF + m * 16;
                bf16_t* rowp = Z + (size_t)row * INWP + colw0 + 8 * fq;
                float sq = 0.f, skv = 0.f;
#pragma unroll
                for (int bj = 0; bj < 2; ++bj) {
                    f32x4 v0 = acc[ai][bj][m][0], v1 = acc[ai][bj][m][1];
                    if (special) {
                        const int colw = colw0 + bj * HALF;
                        if (colw >= ZCQ && colw < ZCKV) sq += dot4(v0) + dot4(v1);
                        else if (colw >= ZCKV && colw < ZKR) skv += dot4(v0) + dot4(v1);
                        else if (colw >= ZKR && colw < INW && u.pm < 32) {
                            const int axis = (colw - ZKR) >> 5, t = row & (SEQ - 1), pos = axis ? (t & 63) : (t >> 6);
                            rope8(v0, v1, rope + pos * 16 + 4 * fq);
                        }
                    }
                    u32x4 w; w.x = cvt_pk_bf16(v0[0], v0[1]); w.y = cvt_pk_bf16(v0[2], v0[3]); w.z = cvt_pk_bf16(v1[0], v1[1]); w.w = cvt_pk_bf16(v1[2], v1[3]);
                    *(u32x4*)(rowp + bj * HALF) = w;
                }
                if (special) {
                    sq += __shfl_xor(sq, 16); sq += __shfl_xor(sq, 32); skv += __shfl_xor(skv, 16); skv += __shfl_xor(skv, 32);
                    if (fq == 0) { if (sq != 0.f) atomicAdd(rstat + (size_t)row * 2, sq); if (skv != 0.f) atomicAdd(rstat + (size_t)row * 2 + 1, skv); }
                }
            }
    }
};
struct EpiUp {
    static constexpr bool PERM = true;
    bf16_t* O; const float* rstat; const f32x2* rope;
    __device__ __forceinline__ void operator()(const f32x4 (&acc)[2][2][4][2], const Unit& u, int wr, int wc, int fr, int fq) const {
        const int row0 = u.pm * BM + wr * 64 + fr; const int colw0 = u.pn * BM + wc * 32;
#pragma unroll
        for (int ai = 0; ai < 2; ++ai)
#pragma unroll
            for (int m = 0; m < 4; ++m) {
                const int row = row0 + ai * HALF + m * 16;
                const f32x2 ss = *(const f32x2*)(rstat + (size_t)row * 2);
                const float rq = rsqrtf(ss.x * (1.0f / 384.0f) + EPS), rkv = rsqrtf(ss.y * (1.0f / 128.0f) + EPS);
                bf16_t* rowp = O + (size_t)row * NUP + colw0 + 8 * fq;
#pragma unroll
                for (int bj = 0; bj < 2; ++bj) {
                    const int colw = colw0 + bj * HALF;
                    const float sc = colw < 768 ? rq : rkv;
                    f32x4 v0 = acc[ai][bj][m][0] * sc, v1 = acc[ai][bj][m][1] * sc;
                    if (colw < 768 && u.pm < 32) {
                        const int within = colw % 192;
                        if (within >= 128) { const int axis = (within - 128) >> 5, t = row & (SEQ - 1), pos = axis ? (t & 63) : (t >> 6); rope8(v0, v1, rope + pos * 16 + 4 * fq); }
                    }
                    u32x4 w; w.x = cvt_pk_bf16(v0[0], v0[1]); w.y = cvt_pk_bf16(v0[2], v0[3]); w.z = cvt_pk_bf16(v1[0], v1[1]); w.w = cvt_pk_bf16(v1[2], v1[3]);
                    *(u32x4*)(rowp + bj * HALF) = w;
                }
            }
    }
};
struct EpiRes {
    static constexpr bool PERM = false;
    const float* base_lat; const float* base_ctx; float* out; const float* gate;
    __device__ __forceinline__ void operator()(const f32x4 (&acc)[2][2][4][2], const Unit& u, int wr, int wc, int fr, int fq) const {
        const int row0 = u.pm * BM + wr * 64 + fr, col0 = u.pn * BM + wc * 32 + 4 * fq;
        const int r = u.pm < 16 ? 0 : (u.pm < 32 ? 1 : 2);
        const float* gp = gate + (size_t)r * 6 * DM + col0;
        f32x4 gv[2][2];
#pragma unroll
        for (int bj = 0; bj < 2; ++bj)
#pragma unroll
            for (int n = 0; n < 2; ++n) gv[bj][n] = *(const f32x4*)(gp + bj * HALF + n * 16);
#pragma unroll
        for (int ai = 0; ai < 2; ++ai)
#pragma unroll
            for (int m = 0; m < 4; ++m) {
                const int row = row0 + ai * HALF + m * 16;
                const float* bp = (u.pm < 32 ? base_lat + (size_t)row * DM : base_ctx + (size_t)(row - ML) * DM) + col0;
                float* op = out + (size_t)row * DM + col0;
#pragma unroll
                for (int bj = 0; bj < 2; ++bj)
#pragma unroll
                    for (int n = 0; n < 2; ++n) { const f32x4 b = *(const f32x4*)(bp + bj * HALF + n * 16); *(f32x4*)(op + bj * HALF + n * 16) = b + gv[bj][n] * acc[ai][bj][m][n]; }
            }
    }
};
struct EpiSwiglu {
    static constexpr bool PERM = true;
    bf16_t* U;
    __device__ __forceinline__ void operator()(const f32x4 (&acc)[2][2][4][2], const Unit& u, int wr, int wc, int fr, int fq) const {
        const int row0 = u.pm * BM + wr * 64 + fr, oc = u.pn * HALF + wc * 32 + 8 * fq;
#pragma unroll
        for (int ai = 0; ai < 2; ++ai)
#pragma unroll
            for (int m = 0; m < 4; ++m) {
                const int row = row0 + ai * HALF + m * 16;
                float o[8];
#pragma unroll
                for (int n = 0; n < 2; ++n)
#pragma unroll
                    for (int j = 0; j < 4; ++j) { const float a = acc[ai][0][m][n][j], b = acc[ai][1][m][n][j]; o[n * 4 + j] = a * b * __builtin_amdgcn_rcpf(1.0f + __builtin_amdgcn_exp2f(-1.4426950408889634f * a)); }
                u32x4 w; w.x = cvt_pk_bf16(o[0], o[1]); w.y = cvt_pk_bf16(o[2], o[3]); w.z = cvt_pk_bf16(o[4], o[5]); w.w = cvt_pk_bf16(o[6], o[7]);
                *(u32x4*)(U + (size_t)row * DFF + oc) = w;
            }
    }
};
}

#define XB_TMO      128
#define XB_XCNT(j)  (256  + 64 * (j))
#define XB_XSUB(j)  (1280 + 64 * (j))
#define XB_XGEN(j)  (2304 + 64 * (j))
#define XB_TOP      3328
#define XB_TOPGEN   3392
#define XCD_BAR_WORDS 3456
#define XB_SPIN_CAP (1u << 18)
__device__ __forceinline__ unsigned xb_ld(unsigned* p)              { return __hip_atomic_load(p, __ATOMIC_RELAXED, __HIP_MEMORY_SCOPE_AGENT); }
__device__ __forceinline__ unsigned xb_add(unsigned* p, unsigned v) { return __hip_atomic_fetch_add(p, v, __ATOMIC_RELAXED, __HIP_MEMORY_SCOPE_AGENT); }
__device__ __forceinline__ unsigned xb_xcc_id() { return (unsigned)__builtin_amdgcn_s_getreg((3 << 11) | 20) & 0xFu; }
#define XB_SPIN(cond, bar) do { unsigned _sp = 0; while (cond) { __builtin_amdgcn_s_sleep(1); \
    if ((++_sp & 255u) == 0u) { if (xb_ld(&(bar)[XB_TMO])) break; if (_sp > XB_SPIN_CAP) { atomicAdd(&(bar)[XB_TMO], 1u); break; } } } } while (0)
struct XcdBarrier { unsigned* bar; unsigned x; volatile LAS unsigned* st; };
__device__ __forceinline__ XcdBarrier xcd_barrier_post(unsigned* bar, volatile LAS unsigned* st) {
    XcdBarrier b; b.bar = bar; b.x = xb_xcc_id(); b.st = st;
    if (threadIdx.x == 0) (void)xb_add(&bar[XB_XCNT(b.x)], 1u);
    return b;
}
__device__ __forceinline__ void xcd_barrier_complete(unsigned* bar, unsigned x, unsigned& nloc, unsigned& nx) {
    const unsigned G = gridDim.x * gridDim.y * gridDim.z;
    unsigned sum, cnt, mine, sp = 0u;
    for (;;) {
        sum = 0u; cnt = 0u; mine = 0u;
#pragma unroll
        for (unsigned j = 0; j < 16; ++j) { const unsigned c = xb_ld(&bar[XB_XCNT(j)]); sum += c; cnt += (c > 0u) ? 1u : 0u; mine = (j == x) ? c : mine; }
        if (sum == G) break;
        __builtin_amdgcn_s_sleep(1);
        if ((++sp & 255u) == 0u) { if (xb_ld(&bar[XB_TMO])) break; if (sp > XB_SPIN_CAP) { atomicAdd(&bar[XB_TMO], 1u); break; } }
    }
    nloc = mine > 0u ? mine : 1u; nx = cnt > 0u ? cnt : 1u;
}
__device__ __forceinline__ void xcd_barrier(const XcdBarrier& b) {
    asm volatile("s_waitcnt vmcnt(0)" ::: "memory");
    __syncthreads();
    if (threadIdx.x == 0) {
        unsigned* bar = b.bar;
        __builtin_amdgcn_s_waitcnt(0);
        unsigned nloc = b.st[0], nx = b.st[1];
        if (nloc == 0u) { xcd_barrier_complete(bar, b.x, nloc, nx); b.st[0] = nloc; b.st[1] = nx; }
        const unsigned old = xb_add(&bar[XB_XSUB(b.x)], 1u);
        const unsigned gen = old / nloc;
        if (old + 1u == (gen + 1u) * nloc) {
            __builtin_amdgcn_fence(__ATOMIC_RELEASE, "agent");
            asm volatile("s_waitcnt vmcnt(0)" ::: "memory");
            const unsigned og = xb_add(&bar[XB_TOP], 1u);
            const unsigned tg = og / nx;
            if (og + 1u == (tg + 1u) * nx) xb_add(&bar[XB_TOPGEN], 1u);
            else XB_SPIN(xb_ld(&bar[XB_TOPGEN]) == tg, bar);
            __builtin_amdgcn_fence(__ATOMIC_ACQUIRE, "agent");
            xb_add(&bar[XB_XGEN(b.x)], 1u);
            asm volatile("s_waitcnt vmcnt(0)" ::: "memory");
        } else {
            XB_SPIN(xb_ld(&bar[XB_XGEN(b.x)]) == gen, bar);
            __builtin_amdgcn_fence(__ATOMIC_ACQUIRE, "agent");
            asm volatile("s_waitcnt vmcnt(0)" ::: "memory");
        }
    }
    __syncthreads();
}

struct Params {
    const float *x, *c, *ctx, *c_ctx, *norm1_g, *w_mod, *b_mod, *w_in, *fg_up, *fg_b, *onorm_g, *conf_dw, *conf_dw_b, *conf_ln_g, *conf_ln_b, *sc_dw,
                *qn_g, *kvn_g, *w_uq, *w_ukv, *w_out, *norm2_g, *w1, *w3, *w2, *final_g;
    float* out; unsigned char* ws; int ph_lo, ph_hi;
};

template <class RowMap>
__device__ __forceinline__ void transpose_item64(const float* W, int N, bf16_t* WT, int ldk, int kofs, const RowMap& rm, const float* gain, LAS unsigned* scr, int item, int lane) {
    const int nblk = (N + 63) >> 6, kb = item / nblk, nb = item % nblk, k0 = 64 * kb, n0 = 64 * nb;
    const bool nvalid = (n0 + lane) < N;
    const float* src = W + (size_t)k0 * N + n0 + (nvalid ? lane : 0);
    float v[64];
#pragma unroll
    for (int kk = 0; kk < 64; ++kk) v[kk] = src[(size_t)kk * N];
    if (gain) {
#pragma unroll
        for (int kk = 0; kk < 64; ++kk) v[kk] *= gain[k0 + kk];
    }
#pragma unroll
    for (int j = 0; j < 32; ++j) scr[lane * 33 + j] = cvt_pk_bf16(v[2 * j], v[2 * j + 1]);
    LDS_WAIT(); asm volatile("" ::: "memory");
    const int c = lane & 7;
#pragma unroll
    for (int j = 0; j < 8; ++j) { const int n = (lane >> 3) + 8 * j;
        if (n0 + n < N) { const LAS unsigned* q = scr + n * 33 + 4 * c; u32x4 o; o.x = q[0]; o.y = q[1]; o.z = q[2]; o.w = q[3];
            *(u32x4*)(WT + (size_t)rm(n0 + n) * ldk + kofs + k0 + 8 * c) = o; } }
    LDS_WAIT(); asm volatile("" ::: "memory");
}
struct RmId { __device__ __forceinline__ int operator()(int n) const { return n; } };
struct RmIn { __device__ __forceinline__ int operator()(int n) const { if (n < ZKR) return n; const int rc = n - ZKR, a = rc >> 5, hf = (rc >> 4) & 1, i = rc & 15; return ZKR + a * 32 + 2 * i + hf; } };
struct RmUq { __device__ __forceinline__ int operator()(int n) const { const int hd = n / 192, within = n % 192; if (within < 128) return n; const int rc = within - 128, a = rc >> 5, hf = (rc >> 4) & 1, i = rc & 15; return hd * 192 + 128 + a * 32 + 2 * i + hf; } };
struct RmOff { int off; __device__ __forceinline__ int operator()(int n) const { return off + n; } };
struct RmFf { int off; __device__ __forceinline__ int operator()(int n) const { return (n >> 7) * 256 + off + (n & 127); } };

struct Frame {
    LAS unsigned char* lds; int tid, lane, wave, G, bid; unsigned char* ws; const Params* p;
};

__device__ __forceinline__ void phase_p0a(const Params& P, LAS unsigned char* lds, int tid, int lane, int wave, int G, int bid) {
    unsigned char* ws = P.ws;
    const int gw = bid * 8 + wave, NGW = G * 8;
    const int gt = bid * 512 + tid, NGT = G * 512;
    LAS float* act = (LAS float*)(lds + 8 * 8448);
    for (int i = tid; i < 3 * DM; i += 512) { const int r = i / DM, k = i % DM; const float v = r < 2 ? P.c[r * DM + k] : P.c_ctx[k]; act[i] = v / (1.0f + expf(-v)); }
    __syncthreads();
    {
        float* modp = (float*)(ws + WS_MODP);
        for (int it = gw; it < 4 * 48 * 8; it += NGW) {
            const int layer = it / 384, rem = it % 384, cb = rem / 8, ks = rem % 8;
            const int col0 = cb * 256 + lane * 4;
            const float* Wp = P.w_mod + ((size_t)layer * DM + (size_t)ks * 256) * 12288 + col0;
            const LAS float* a0 = act + ks * 256;
            f32x4 s0 = {0.f, 0.f, 0.f, 0.f}, s1 = s0, s2 = s0;
#pragma unroll 16
            for (int k = 0; k < 256; ++k) { const f32x4 w = *(const f32x4*)(Wp + (size_t)k * 12288); s0 += w * a0[k]; s1 += w * a0[DM + k]; s2 += w * a0[2 * DM + k]; }
            float* o = modp + (((size_t)ks * 4 + layer) * 3) * 12288 + col0;
            *(f32x4*)(o) = s0; *(f32x4*)(o + 12288) = s1; *(f32x4*)(o + 2 * 12288) = s2;
        }
    }
    {
        LAS unsigned* scr = (LAS unsigned*)(lds + wave * 8448);
        constexpr int I_IN = (DM / 64) * ((INW + 63) / 64), I_OUT = (DM / 64) * (DM / 64), I_FF = (DM / 64) * (DFF / 64), I_W2 = (DFF / 64) * (DM / 64), I_UQ = (384 / 64) * (768 / 64), I_UKV = (128 / 64) * (1024 / 64);
        constexpr int PER_LAYER = I_IN + I_OUT + 2 * I_FF + I_W2 + I_UQ + I_UKV;
        for (int it = gw; it < 4 * PER_LAYER; it += NGW) {
            const int layer = it / PER_LAYER; int r = it % PER_LAYER;
            if (r < I_IN) { transpose_item64(P.w_in + (size_t)layer * DM * INW, INW, (bf16_t*)(ws + WS_WIN) + (size_t)layer * INWP * DM, DM, 0, RmIn{}, nullptr, scr, r, lane); continue; } r -= I_IN;
            if (r < I_OUT) { transpose_item64(P.w_out + (size_t)layer * DM * DM, DM, (bf16_t*)(ws + WS_WOUT) + (size_t)layer * DM * DM, DM, 0, RmId{}, nullptr, scr, r, lane); continue; } r -= I_OUT;
            if (r < I_FF) { transpose_item64(P.w1 + (size_t)layer * DM * DFF, DFF, (bf16_t*)(ws + WS_W13) + (size_t)layer * 2 * DFF * DM, DM, 0, RmFf{0}, nullptr, scr, r, lane); continue; } r -= I_FF;
            if (r < I_FF) { transpose_item64(P.w3 + (size_t)layer * DM * DFF, DFF, (bf16_t*)(ws + WS_W13) + (size_t)layer * 2 * DFF * DM, DM, 0, RmFf{128}, nullptr, scr, r, lane); continue; } r -= I_FF;
            if (r < I_W2) { transpose_item64(P.w2 + (size_t)layer * DFF * DM, DM, (bf16_t*)(ws + WS_W2) + (size_t)layer * DM * DFF, DFF, 0, RmId{}, nullptr, scr, r, lane); continue; } r -= I_W2;
            if (r < I_UQ) { transpose_item64(P.w_uq + (size_t)layer * 384 * 768, 768, (bf16_t*)(ws + WS_WUP) + (size_t)layer * NUP * KUP, KUP, 0, RmUq{}, P.qn_g + layer * 384, scr, r, lane); continue; } r -= I_UQ;
            transpose_item64(P.w_ukv + (size_t)layer * 128 * 1024, 1024, (bf16_t*)(ws + WS_WUP) + (size_t)layer * NUP * KUP, KUP, 384, RmOff{768}, P.kvn_g + layer * 128, scr, r, lane);
        }
    }
    {
        constexpr int PADW = (INWP - INW) * DM / 8;
        for (int i = gt; i < 4 * PADW; i += NGT) { const int layer = i / PADW, j = i % PADW;
            *(u32x4*)((bf16_t*)(ws + WS_WIN) + ((size_t)layer * INWP + INW) * DM + (size_t)j * 8) = (u32x4){0u, 0u, 0u, 0u}; }
        constexpr int ZQ_ = 768 * 16, ZKV_ = 1024 * 48;
        for (int i = gt; i < 4 * (ZQ_ + ZKV_); i += NGT) { const int layer = i / (ZQ_ + ZKV_), j = i % (ZQ_ + ZKV_);
            bf16_t* WU = (bf16_t*)(ws + WS_WUP) + (size_t)layer * NUP * KUP;
            if (j < ZQ_) *(u32x4*)(WU + (size_t)(j >> 4) * KUP + 384 + (j & 15) * 8) = (u32x4){0u, 0u, 0u, 0u};
            else { const int jj = j - ZQ_; *(u32x4*)(WU + (size_t)(768 + jj / 48) * KUP + (jj % 48) * 8) = (u32x4){0u, 0u, 0u, 0u}; } }
    }
    {
        f32x2* rope = (f32x2*)(ws + WS_ROPE);
        for (int i = gt; i < 1024; i += NGT) { const int pos = i >> 4, f = i & 15; const float inv = powf(10000.0f, -(float)f * 2.0f / 32.0f); const float ang = (float)pos * inv; rope[i] = (f32x2){cosf(ang), sinf(ang)}; }
        float* rs = (float*)(ws + WS_RSTAT);
        for (int i = gt; i < 4 * MT * 2; i += NGT) rs[i] = 0.f;
    }
}
__device__ __forceinline__ void phase_p0b(const Params& P, int tid, int G, int bid) {
    const float* modp = (const float*)(P.ws + WS_MODP); float* modv = (float*)(P.ws + WS_MODV);
    for (int i = bid * 512 + tid; i < 4 * 3 * 12288; i += G * 512) {
        const int layer = i / (3 * 12288), rem = i % (3 * 12288), r = rem / 12288, c12 = rem % 12288, j = c12 / DM, col = c12 % DM;
        float s = P.b_mod[layer * 12288 + c12];
#pragma unroll
        for (int ks = 0; ks < 8; ++ks) s += modp[(((size_t)ks * 4 + layer) * 3 + r) * 12288 + c12];
        if (j == 1) s = P.norm1_g[layer * DM + col] * (1.0f + s);
        if (j == 4) s = P.norm2_g[layer * DM + col] * (1.0f + s);
        modv[(((size_t)layer * 3 + r) * 6 + j) * DM + col] = s;
    }
}

__device__ __forceinline__ void phase_norm(const float* xlat, const float* xctx, const float* modl  , int jg, int jsh, bf16_t* H, int nrows, int lane, int wave, int G, int bid) {
    const int rpw = (nrows + G - 1) / G;
    int cur = -1; f32x4 gsv[8], shv[8];
    for (int k = wave; k < rpw; k += 8) {
        const int row = bid * rpw + k; if (row >= nrows) break;
        const int r = row < SEQ ? 0 : (row < ML ? 1 : 2);
        if (r != cur) { cur = r; const float* gp = modl + ((size_t)r * 6 + jg) * DM; const float* sp = modl + ((size_t)r * 6 + jsh) * DM;
#pragma unroll
            for (int j = 0; j < 8; ++j) { gsv[j] = *(const f32x4*)(gp + (lane + 64 * j) * 4); shv[j] = *(const f32x4*)(sp + (lane + 64 * j) * 4); } }
        const float* xr = row < ML ? xlat + (size_t)row * DM : xctx + (size_t)(row - ML) * DM;
        f32x4 v[8]; float ss = 0.f;
#pragma unroll
        for (int j = 0; j < 8; ++j) { v[j] = *(const f32x4*)(xr + (lane + 64 * j) * 4); ss += dot4(v[j]); }
        const float rstd = rsqrtf(wave_sum(ss) * (1.0f / DM) + EPS);
        bf16_t* hr = H + (size_t)row * DM;
#pragma unroll
        for (int j = 0; j < 8; ++j) { const f32x4 o = v[j] * rstd * gsv[j] + shv[j]; u32x2 w; w.x = cvt_pk_bf16(o[0], o[1]); w.y = cvt_pk_bf16(o[2], o[3]); *(u32x2*)(hr + (lane + 64 * j) * 4) = w; }
    }
}
__device__ __forceinline__ void phase_final(const float* X, const float* g, float* out, int lane, int wave, int G, int bid) {
    for (int row = bid * 8 + wave; row < ML; row += G * 8) {
        const float* xr = X + (size_t)row * DM; f32x4 v[8]; float ss = 0.f;
#pragma unroll
        for (int j = 0; j < 8; ++j) { v[j] = *(const f32x4*)(xr + (lane + 64 * j) * 4); ss += dot4(v[j]); }
        const float rstd = rsqrtf(wave_sum(ss) * (1.0f / DM) + EPS);
#pragma unroll
        for (int j = 0; j < 8; ++j) { const f32x4 gg = *(const f32x4*)(g + (lane + 64 * j) * 4); *(f32x4*)(out + (size_t)row * DM + (lane + 64 * j) * 4) = v[j] * rstd * gg; }
    }
}

constexpr int GL_L = 0;
constexpr int GL_QT = 33792;
constexpr int GL_KT = 51200;
constexpr int GL_PP = 68608;
constexpr int GL_VT = 77824;
constexpr int GL_FG = 96256;
constexpr int GL_LR = 104960;
__device__ __forceinline__ int gla_row0(int b, int id) { return id < 4 ? ML + b * CTX + id * 64 : b * SEQ + (id - 4) * 64; }
__device__ __forceinline__ void gla_load_vT(LAS unsigned char* lds, const bf16_t* Z, int row0, int h, int tid) {
    const int t = tid >> 3, eg = (tid & 7) * 16;
    const u32x4* src = (const u32x4*)(Z + (size_t)(row0 + t) * INWP + ZV + h * 128 + eg);
    const u32x4 a = src[0], b = src[1];
    LAS bf16_t* VT = (LAS bf16_t*)(lds + GL_VT);
    const unsigned w[8] = {a.x, a.y, a.z, a.w, b.x, b.y, b.z, b.w};
#pragma unroll
    for (int i = 0; i < 8; ++i) { VT[(eg + 2 * i) * 72 + t] = (bf16_t)(w[i] & 0xffffu); VT[(eg + 2 * i + 1) * 72 + t] = (bf16_t)(w[i] >> 16); }
}
__device__ __forceinline__ void gla_decay(LAS unsigned char* lds, const bf16_t* Z, const float* fgup  , const float* fgb  , int row0, int h, int dir, int tid) {
    LAS float* FG = (LAS float*)(lds + GL_FG); LAS float* FB = FG + 2048; LAS float* LR = (LAS float*)(lds + GL_LR); LAS float* L = (LAS float*)(lds + GL_L);
    { const int r = tid >> 5, d4 = (tid & 31) * 4; *(LAS f32x4*)(FG + r * 128 + d4) = *(const f32x4*)(fgup + r * 512 + h * 128 + d4); }
    if (tid < 32) *(LAS f32x4*)(FB + tid * 4) = *(const f32x4*)(fgb + h * 128 + tid * 4);
    if (tid < 128) { const int t = tid >> 1, hf = tid & 1; const u32x4 w = *(const u32x4*)(Z + (size_t)(row0 + t) * INWP + ZLR + dir * 16 + hf * 8);
        LAS float* o = LR + t * 16 + hf * 8; o[0] = bflo(w.x); o[1] = bfhi(w.x); o[2] = bflo(w.y); o[3] = bfhi(w.y); o[4] = bflo(w.z); o[5] = bfhi(w.z); o[6] = bflo(w.w); o[7] = bfhi(w.w); }
    __syncthreads();
    {
        const int t = tid >> 3, dg = (tid & 7) * 16;
        f32x4 a[4];
#pragma unroll
        for (int q = 0; q < 4; ++q) a[q] = *(const LAS f32x4*)(FB + dg + 4 * q);
#pragma unroll
        for (int r = 0; r < 16; ++r) { const float lr = LR[t * 16 + r];
#pragma unroll
            for (int q = 0; q < 4; ++q) a[q] += *(const LAS f32x4*)(FG + r * 128 + dg + 4 * q) * lr; }
#pragma unroll
        for (int q = 0; q < 4; ++q) { f32x4 o;
#pragma unroll
            for (int j = 0; j < 4; ++j) { const float x = a[q][j]; o[j] = (fminf(x, 0.f) - log1pf(expf(-fabsf(x)))) * (1.0f / 16.0f); }
            *(LAS f32x4*)(L + t * 132 + dg + 4 * q) = o; }
    }
    __syncthreads();
    if (tid < 128) { float run = 0.f;
        if (dir == 0) { for (int t = 0; t < 64; ++t) { run += L[t * 132 + tid]; L[t * 132 + tid] = run; } }
        else { for (int t = 63; t >= 0; --t) { run += L[t * 132 + tid]; L[t * 132 + tid] = run; } } }
    __syncthreads();
}
__device__ __forceinline__ void gla_g1_item(LAS unsigned char* lds, const Params& P, int layer, int item, int tid, int lane, int wave) {
    const bf16_t* Z = (const bf16_t*)(P.ws + WS_Z);
    const int id = item % NCH, dir = (item / NCH) & 1, h = (item / (2 * NCH)) & 3, b = item / (8 * NCH);
    const int seq = (b * 4 + h) * 2 + dir, row0 = gla_row0(b, id);
    gla_load_vT(lds, Z, row0, h, tid);
    gla_decay(lds, Z, P.fg_up + ((size_t)layer * 2 + dir) * 16 * 512, P.fg_b + ((size_t)layer * 2 + dir) * 512, row0, h, dir, tid);
    LAS float* L = (LAS float*)(lds + GL_L); LAS bf16_t* KH = (LAS bf16_t*)(lds + GL_QT);
    const int tl = dir == 0 ? 63 : 0;
    {
        const int t = tid >> 3, dg = (tid & 7) * 16;
        const u32x4* src = (const u32x4*)(Z + (size_t)(row0 + t) * INWP + ZK + h * 128 + dg);
        const u32x4 a = src[0], bq = src[1]; const unsigned w[8] = {a.x, a.y, a.z, a.w, bq.x, bq.y, bq.z, bq.w};
#pragma unroll
        for (int i = 0; i < 8; ++i) { const int d = dg + 2 * i;
            const float e0 = __expf(L[tl * 132 + d] - L[t * 132 + d]), e1 = __expf(L[tl * 132 + d + 1] - L[t * 132 + d + 1]);
            KH[d * 72 + t] = f2bf(bflo(w[i]) * e0); KH[(d + 1) * 72 + t] = f2bf(bfhi(w[i]) * e1); }
        if (tid < 128) ((float*)(P.ws + WS_GD))[((size_t)seq * NCH + id) * 128 + tid] = __expf(L[tl * 132 + tid]);
    }
    __syncthreads();
    {
        const LAS bf16_t* VT = (const LAS bf16_t*)(lds + GL_VT);
        const int eb = wave >> 1, r32 = lane & 31, hi = lane >> 5;
        float* U = (float*)(P.ws + WS_GU) + ((size_t)seq * NCH + id) * 16384;
#pragma unroll
        for (int q = 0; q < 2; ++q) { const int db = 2 * (wave & 1) + q; f32x16 acc = {};
#pragma unroll
            for (int kk = 0; kk < 4; ++kk) { const bf16x8 av = *(const LAS bf16x8*)(VT + (32 * eb + r32) * 72 + 16 * kk + 8 * hi), bv = *(const LAS bf16x8*)(KH + (32 * db + r32) * 72 + 16 * kk + 8 * hi);
                acc = __builtin_amdgcn_mfma_f32_32x32x16_bf16(av, bv, acc, 0, 0, 0); }
#pragma unroll
            for (int r = 0; r < 16; ++r) { const int e = 32 * eb + (r & 3) + 8 * (r >> 2) + 4 * hi; U[e * 128 + 32 * db + r32] = acc[r]; } }
    }
    __syncthreads();
}
__device__ __forceinline__ void gla_g2(const Params& P, int tid, int G, int bid) {
    const float* U = (const float*)(P.ws + WS_GU); const float* Dv = (const float*)(P.ws + WS_GD); bf16_t* S = (bf16_t*)(P.ws + WS_GS);
    for (int slot = bid * 512 + tid; slot < 16 * 8192; slot += G * 512) {
        const int seq = slot >> 13, el = (slot & 8191) * 2, d = el & 127, dir = seq & 1;
        float s0 = 0.f, s1 = 0.f;
#pragma unroll 4
        for (int p = 0; p < NCH; ++p) {
            const int id = dir == 0 ? p : (p < 4 ? 3 - p : 71 - p);
            const size_t base = ((size_t)seq * NCH + id);
            *(unsigned*)(S + base * 16384 + el) = cvt_pk_bf16(s0, s1);
            const f32x2 u = *(const f32x2*)(U + base * 16384 + el), dd = *(const f32x2*)(Dv + base * 128 + d);
            s0 = dd.x * s0 + u.x; s1 = dd.y * s1 + u.y;
        }
    }
}
__device__ __forceinline__ void gla_g3_item(LAS unsigned char* lds, const Params& P, int layer, int item, int tid, int lane, int wave) {
    const bf16_t* Z = (const bf16_t*)(P.ws + WS_Z);
    const int id = item % NCH, h = (item / NCH) & 3, b = item / (4 * NCH);
    const int row0 = gla_row0(b, id);
    gla_load_vT(lds, Z, row0, h, tid);
    LAS float* L = (LAS float*)(lds + GL_L); LAS bf16_t* QT = (LAS bf16_t*)(lds + GL_QT); LAS bf16_t* KT = (LAS bf16_t*)(lds + GL_KT); LAS bf16_t* PP = (LAS bf16_t*)(lds + GL_PP);
    const LAS bf16_t* VT = (const LAS bf16_t*)(lds + GL_VT);
    const int r32 = lane & 31, hi = lane >> 5, rb = wave >> 2, cb = wave & 3;
    f32x16 o = {};
    for (int dir = 0; dir < 2; ++dir) {
        const int seq = (b * 4 + h) * 2 + dir;
        const bf16_t* Sg = (const bf16_t*)(P.ws + WS_GS) + ((size_t)seq * NCH + id) * 16384 + (size_t)(32 * cb + r32) * 128 + 8 * hi;
        bf16x8 sf[8];
#pragma unroll
        for (int kk = 0; kk < 8; ++kk) sf[kk] = *(const bf16x8*)(Sg + 16 * kk);
        gla_decay(lds, Z, P.fg_up + ((size_t)layer * 2 + dir) * 16 * 512, P.fg_b + ((size_t)layer * 2 + dir) * 512, row0, h, dir, tid);
        {
            const int t = tid >> 3, dg = (tid & 7) * 16;
            const u32x4* qs = (const u32x4*)(Z + (size_t)(row0 + t) * INWP + ZQ + h * 128 + dg); const u32x4* ks = (const u32x4*)(Z + (size_t)(row0 + t) * INWP + ZK + h * 128 + dg);
            const u32x4 qa = qs[0], qb = qs[1], ka = ks[0], kb = ks[1];
            const unsigned qw[8] = {qa.x, qa.y, qa.z, qa.w, qb.x, qb.y, qb.z, qb.w}, kw[8] = {ka.x, ka.y, ka.z, ka.w, kb.x, kb.y, kb.z, kb.w};
            unsigned qo[8], ko[8];
#pragma unroll
            for (int i = 0; i < 8; ++i) { const float b0 = L[t * 132 + dg + 2 * i], b1 = L[t * 132 + dg + 2 * i + 1];
                const float eq0 = __expf(b0) * 0.08838834764831845f, eq1 = __expf(b1) * 0.08838834764831845f, ek0 = __expf(fminf(-b0, 80.f)), ek1 = __expf(fminf(-b1, 80.f));
                qo[i] = cvt_pk_bf16(bflo(qw[i]) * eq0, bfhi(qw[i]) * eq1); ko[i] = cvt_pk_bf16(bflo(kw[i]) * ek0, bfhi(kw[i]) * ek1); }
            *(LAS u32x4*)(QT + t * 136 + dg) = (u32x4){qo[0], qo[1], qo[2], qo[3]}; *(LAS u32x4*)(QT + t * 136 + dg + 8) = (u32x4){qo[4], qo[5], qo[6], qo[7]};
            *(LAS u32x4*)(KT + t * 136 + dg) = (u32x4){ko[0], ko[1], ko[2], ko[3]}; *(LAS u32x4*)(KT + t * 136 + dg + 8) = (u32x4){ko[4], ko[5], ko[6], ko[7]};
        }
        __syncthreads();
        {
            const int bi = wave >> 1, fr = lane & 15, fq = lane >> 4;
#pragma unroll
            for (int q = 0; q < 2; ++q) { const int bj = 2 * (wave & 1) + q; f32x4 acc = {0.f, 0.f, 0.f, 0.f};
#pragma unroll
                for (int kk = 0; kk < 4; ++kk) { const bf16x8 av = *(const LAS bf16x8*)(QT + (16 * bi + fr) * 136 + 32 * kk + 8 * fq), bv = *(const LAS bf16x8*)(KT + (16 * bj + fr) * 136 + 32 * kk + 8 * fq);
                    acc = __builtin_amdgcn_mfma_f32_16x16x32_bf16(av, bv, acc, 0, 0, 0); }
                const int jt = 16 * bj + fr;
#pragma unroll
                for (int r = 0; r < 4; ++r) { const int it = 16 * bi + 4 * fq + r; const bool keep = dir == 0 ? (jt <= it) : (jt >= it); PP[it * 72 + jt] = f2bf(keep ? acc[r] : 0.f); } }
        }
        __syncthreads();
        {
#pragma unroll
            for (int kk = 0; kk < 4; ++kk) { const bf16x8 av = *(const LAS bf16x8*)(PP + (32 * rb + r32) * 72 + 16 * kk + 8 * hi), bv = *(const LAS bf16x8*)(VT + (32 * cb + r32) * 72 + 16 * kk + 8 * hi);
                o = __builtin_amdgcn_mfma_f32_32x32x16_bf16(av, bv, o, 0, 0, 0); }
#pragma unroll
            for (int kk = 0; kk < 8; ++kk) { const bf16x8 av = *(const LAS bf16x8*)(QT + (32 * rb + r32) * 136 + 16 * kk + 8 * hi);
                o = __builtin_amdgcn_mfma_f32_32x32x16_bf16(av, sf[kk], o, 0, 0, 0); }
        }
        __syncthreads();
    }
#pragma unroll
    for (int r = 0; r < 16; ++r) { const int t = 32 * rb + (r & 3) + 8 * (r >> 2) + 4 * hi; L[t * 132 + 32 * cb + r32] = o[r]; }
    __syncthreads();
    {
        const int t = tid >> 3, eg = (tid & 7) * 16;
        f32x4 v[4]; float ss = 0.f;
#pragma unroll
        for (int q = 0; q < 4; ++q) { v[q] = *(const LAS f32x4*)(L + t * 132 + eg + 4 * q); ss += dot4(v[q]); }
        ss += __shfl_xor(ss, 1); ss += __shfl_xor(ss, 2); ss += __shfl_xor(ss, 4);
        const float rstd = rsqrtf(ss * (1.0f / 128.0f) + EPS);
        const u32x4* gs = (const u32x4*)(Z + (size_t)(row0 + t) * INWP + ZG + h * 128 + eg); const u32x4 ga = gs[0], gb = gs[1];
        const unsigned gw[8] = {ga.x, ga.y, ga.z, ga.w, gb.x, gb.y, gb.z, gb.w};
        const float* og = P.onorm_g + layer * 128 + eg;
        unsigned ow[8];
#pragma unroll
        for (int i = 0; i < 8; ++i) { const float g0 = bflo(gw[i]), g1 = bfhi(gw[i]);
            const float o0 = v[i >> 1][(i & 1) * 2] * rstd * og[2 * i] * siluf_(g0), o1 = v[i >> 1][(i & 1) * 2 + 1] * rstd * og[2 * i + 1] * siluf_(g1);
            ow[i] = cvt_pk_bf16(o0, o1); }
        bf16_t* mp = (bf16_t*)(P.ws + WS_MIX) + (size_t)(row0 + t) * DM + h * 128 + eg;
        *(u32x4*)(mp) = (u32x4){ow[0], ow[1], ow[2], ow[3]}; *(u32x4*)(mp + 8) = (u32x4){ow[4], ow[5], ow[6], ow[7]};
    }
    __syncthreads();
}

__device__ __forceinline__ void conf_item(LAS unsigned char* lds, const Params& P, int layer, int item, int tid, int lane, int wave) {
    const bf16_t* Z = (const bf16_t*)(P.ws + WS_Z);
    const int r0 = item * 16;
    const int s0 = r0 < ML ? (r0 & ~(SEQ - 1)) : ML + ((r0 - ML) & ~(CTX - 1)), s1 = s0 + (r0 < ML ? SEQ : CTX);
    LAS float* UB = (LAS float*)lds;
    LAS float* YB = (LAS float*)(lds + 46 * 512 * 4);
    const int c = tid;
    for (int i = 0; i < 46; ++i) { const int row = r0 - 15 + i; float u = 0.f;
        if (row >= s0 && row < s1) { const float a = bf2f(Z[(size_t)row * INWP + ZCA + c]), g = bf2f(Z[(size_t)row * INWP + ZCG + c]); u = a * sigmoidf_(g); }
        UB[i * 512 + c] = u; }
    float w[31];
#pragma unroll
    for (int j = 0; j < 31; ++j) w[j] = P.conf_dw[((size_t)layer * 31 + j) * 512 + c];
    const float bias = P.conf_dw_b[layer * 512 + c];
    LDS_WAIT();
#pragma unroll
    for (int g8 = 0; g8 < 2; ++g8) {
        float win[38];
#pragma unroll
        for (int i = 0; i < 38; ++i) win[i] = UB[(g8 * 8 + i) * 512 + c];
#pragma unroll
        for (int r = 0; r < 8; ++r) { float y = bias;
#pragma unroll
            for (int j = 0; j < 31; ++j) y += w[j] * win[r + j];
            YB[(g8 * 8 + r) * 512 + c] = y; }
    }
    __syncthreads();
    {
        const float* lg = P.conf_ln_g + layer * 512 + 8 * lane; const float* lb = P.conf_ln_b + layer * 512 + 8 * lane;
        const f32x4 g0 = *(const f32x4*)lg, g1 = *(const f32x4*)(lg + 4), b0 = *(const f32x4*)lb, b1 = *(const f32x4*)(lb + 4);
#pragma unroll
        for (int q = 0; q < 2; ++q) { const int t = 2 * wave + q;
            f32x4 y0 = *(const LAS f32x4*)(YB + t * 512 + 8 * lane), y1 = *(const LAS f32x4*)(YB + t * 512 + 8 * lane + 4);
            const float mean = wave_sum((y0[0] + y0[1]) + (y0[2] + y0[3]) + (y1[0] + y1[1]) + (y1[2] + y1[3])) * (1.0f / 512.0f);
            y0 = y0 - mean; y1 = y1 - mean;
            const float rstd = rsqrtf(wave_sum(dot4(y0) + dot4(y1)) * (1.0f / 512.0f) + EPS);
            y0 = y0 * rstd * g0 + b0; y1 = y1 * rstd * g1 + b1;
            u32x4 o; o.x = cvt_pk_bf16(siluf_(y0[0]), siluf_(y0[1])); o.y = cvt_pk_bf16(siluf_(y0[2]), siluf_(y0[3])); o.z = cvt_pk_bf16(siluf_(y1[0]), siluf_(y1[1])); o.w = cvt_pk_bf16(siluf_(y1[2]), siluf_(y1[3]));
            *(u32x4*)((bf16_t*)(P.ws + WS_MIX) + (size_t)(r0 + t) * DM + 512 + 8 * lane) = o; }
    }
    __syncthreads();
}
__device__ __forceinline__ void sconv_item(const Params& P, int layer, int item, int tid) {
    const bf16_t* Z = (const bf16_t*)(P.ws + WS_Z);
    const int row = item * 16 + (tid >> 5);
    const int s0 = row < ML ? (row & ~(SEQ - 1)) : ML + ((row - ML) & ~(CTX - 1)), s1 = s0 + (row < ML ? SEQ : CTX);
#pragma unroll
    for (int q = 0; q < 2; ++q) {
        const int c0 = ((tid & 31) + 32 * q) * 8;
        float acc[8];
#pragma unroll
        for (int i = 0; i < 8; ++i) acc[i] = 0.f;
#pragma unroll
        for (int j = 0; j < 3; ++j) { const int rr = row + j - 1;
            if (rr >= s0 && rr < s1) { const u32x4 cg = *(const u32x4*)(Z + (size_t)rr * INWP + ZSC + c0), hh = *(const u32x4*)(Z + (size_t)rr * INWP + ZSH + c0);
                const float* wp = P.sc_dw + ((size_t)layer * 3 + j) * 512 + c0; const f32x4 w0 = *(const f32x4*)wp, w1 = *(const f32x4*)(wp + 4);
                const unsigned cw[4] = {cg.x, cg.y, cg.z, cg.w}, hw[4] = {hh.x, hh.y, hh.z, hh.w};
#pragma unroll
                for (int i = 0; i < 4; ++i) { const float wa = i < 2 ? w0[2 * i] : w1[2 * i - 4], wb = i < 2 ? w0[2 * i + 1] : w1[2 * i - 3];
                    acc[2 * i] += wa * bflo(cw[i]) * bflo(hw[i]); acc[2 * i + 1] += wb * bfhi(cw[i]) * bfhi(hw[i]); } } }
        const u32x4 bg = *(const u32x4*)(Z + (size_t)row * INWP + ZSB + c0); const unsigned bw[4] = {bg.x, bg.y, bg.z, bg.w};
        u32x4 o; unsigned ow[4];
#pragma unroll
        for (int i = 0; i < 4; ++i) ow[i] = cvt_pk_bf16(bflo(bw[i]) * acc[2 * i], bfhi(bw[i]) * acc[2 * i + 1]);
        o.x = ow[0]; o.y = ow[1]; o.z = ow[2]; o.w = ow[3];
        *(u32x4*)((bf16_t*)(P.ws + WS_MIX) + (size_t)row * DM + 1024 + c0) = o;
    }
}

namespace att {
constexpr int NW = 8, QBLK = 32, KVBLK = 64;
constexpr float SCALE = 0.07216878364870322f;
constexpr float THR = 8.f;
constexpr int SHM_V = KVBLK * 128 * 2, SHM_K = KVBLK * 192 * 2;
constexpr int OFF_K = 2 * SHM_V, OFF_WS = OFF_K + 2 * SHM_K, OFF_QR = OFF_WS + 2048;
#define KSWZ(row, colB) ((row) * 384 + ((colB) ^ ((((row) >> 1) & 7) << 4)))
#define SBAR() __builtin_amdgcn_sched_barrier(0)
__device__ __forceinline__ int crow(int r, int hi) { return (r & 3) + 8 * (r >> 2) + 4 * hi; }
__device__ __forceinline__ void partialSM(f32x16& p0, f32x16& p1, float& m_reg, float& mn, float& alpha) {
    constexpr float C = SCALE * 1.4426950408889634f;
    float pmax = p0[0];
#pragma unroll
    for (int r = 1; r < 16; ++r) pmax = fmaxf(pmax, p0[r]);
#pragma unroll
    for (int r = 0; r < 16; ++r) pmax = fmaxf(pmax, p1[r]);
    { auto rr = __builtin_amdgcn_permlane32_swap(__float_as_uint(pmax), __float_as_uint(pmax), false, false);
      pmax = fmaxf(__uint_as_float(rr[0]), __uint_as_float(rr[1])); }
    if (__builtin_expect(__all(pmax - m_reg <= THR / SCALE), 1)) { mn = m_reg; alpha = 1.f; }
    else { mn = fmaxf(m_reg, pmax); alpha = __builtin_amdgcn_exp2f((m_reg - mn) * C); m_reg = mn; }
    const float mnC = -mn * C;
#pragma unroll
    for (int r = 0; r < 16; ++r) p0[r] = fmaf(p0[r], C, mnC);
#pragma unroll
    for (int r = 0; r < 16; ++r) p1[r] = fmaf(p1[r], C, mnC);
#pragma unroll
    for (int r = 0; r < 16; ++r) p0[r] = __builtin_amdgcn_exp2f(p0[r]);
}
__device__ __forceinline__ void finishSM(f32x16& p0, f32x16& p1, float alpha, float& l_reg, bf16x8& pa0, bf16x8& pa1, bf16x8& pa2, bf16x8& pa3) {
#pragma unroll
    for (int r = 0; r < 16; ++r) p1[r] = __builtin_amdgcn_exp2f(p1[r]);
    float ps = 0;
#pragma unroll
    for (int r = 0; r < 16; ++r) ps += p0[r];
#pragma unroll
    for (int r = 0; r < 16; ++r) ps += p1[r];
    { auto rr = __builtin_amdgcn_permlane32_swap(__float_as_uint(ps), __float_as_uint(ps), false, false);
      ps = __uint_as_float(rr[0]) + __uint_as_float(rr[1]); }
    l_reg = l_reg * alpha + ps;
#define PK4(Pv, BASE, OUT) do { unsigned a0 = cvt_pk_bf16(Pv[BASE + 0], Pv[BASE + 1]), a1 = cvt_pk_bf16(Pv[BASE + 2], Pv[BASE + 3]);   \
    unsigned b0 = cvt_pk_bf16(Pv[BASE + 4], Pv[BASE + 5]), b1 = cvt_pk_bf16(Pv[BASE + 6], Pv[BASE + 7]);                              \
    auto r0 = __builtin_amdgcn_permlane32_swap(a0, b0, false, false); auto r1 = __builtin_amdgcn_permlane32_swap(a1, b1, false, false); \
    u32x4 w = {r0[0], r1[0], r0[1], r1[1]}; OUT = *reinterpret_cast<bf16x8*>(&w); } while (0)
    PK4(p0, 0, pa0); PK4(p0, 8, pa1); PK4(p1, 0, pa2); PK4(p1, 8, pa3);
#undef PK4
}
__device__ __forceinline__ void qkt(f32x16& p0, f32x16& p1, const LAS unsigned char* Ks, const bf16x8* qr, const LAS unsigned char* qrp, int qsw, const int (&kq)[4], int hi) {
    p0 = f32x16{}; p1 = f32x16{};
#pragma unroll
    for (int d0 = 0; d0 < 12; ++d0) {
        const bf16x8 b0 = *(const LAS bf16x8*)(Ks + kq[d0 & 3] + 128 * (d0 >> 2));
        const bf16x8 b1 = *(const LAS bf16x8*)(Ks + kq[d0 & 3] + 128 * (d0 >> 2) + 32 * 384);
        bf16x8 qv; if (d0 < 8) qv = qr[d0]; else qv = *(const LAS bf16x8*)(qrp + (((2 * (d0 - 8) + hi) ^ qsw) << 4));
        p0 = __builtin_amdgcn_mfma_f32_32x32x16_bf16(b0, qv, p0, 0, 0, 0);
        p1 = __builtin_amdgcn_mfma_f32_32x32x16_bf16(b1, qv, p1, 0, 0, 0); }
}
__device__ __forceinline__ int v_st(int k, int c) { const int kk = (k & ~0xC) | ((k & 4) << 1) | ((k & 8) >> 1); return ((kk >> 3) * 4 + (c >> 5)) * 512 + ((kk & 7) * 32 + (c & 31)) * 2; }
__device__ __forceinline__ int v_rd_base(int lane) { return ((lane & 3) << 3) | (((lane >> 2) & 3) << 6) | (((lane >> 4) & 1) << 5) | (((lane >> 5) & 1) << 8); }
constexpr int v_rd_off(int d0, int ks, int half) { return d0 * 512 + ks * 4096 + half * 2048; }
template <int OFF> __device__ __forceinline__ s16x4 tr_read(int vb) {
    s16x4 r; asm volatile("ds_read_b64_tr_b16 %0, %1 offset:%2" : "=&v"(r) : "v"(vb), "i"(OFF) : "memory"); return r;
}
template <int D0> __device__ __forceinline__ void pv_one(f32x16& od, int vb, bf16x8 pa0, bf16x8 pa1, bf16x8 pa2, bf16x8 pa3) {
    const s16x4 l0 = tr_read<v_rd_off(D0, 0, 0)>(vb), h0 = tr_read<v_rd_off(D0, 0, 1)>(vb), l1 = tr_read<v_rd_off(D0, 1, 0)>(vb), h1 = tr_read<v_rd_off(D0, 1, 1)>(vb);
    const s16x4 l2 = tr_read<v_rd_off(D0, 2, 0)>(vb), h2 = tr_read<v_rd_off(D0, 2, 1)>(vb), l3 = tr_read<v_rd_off(D0, 3, 0)>(vb), h3 = tr_read<v_rd_off(D0, 3, 1)>(vb);
    asm volatile("s_waitcnt lgkmcnt(0)" ::: "memory"); SBAR();
#define PK(Lo, Hi) (bf16x8){Lo[0], Lo[1], Lo[2], Lo[3], Hi[0], Hi[1], Hi[2], Hi[3]}
    od = __builtin_amdgcn_mfma_f32_32x32x16_bf16(pa0, PK(l0, h0), od, 0, 0, 0);
    od = __builtin_amdgcn_mfma_f32_32x32x16_bf16(pa1, PK(l1, h1), od, 0, 0, 0);
    od = __builtin_amdgcn_mfma_f32_32x32x16_bf16(pa2, PK(l2, h2), od, 0, 0, 0);
    od = __builtin_amdgcn_mfma_f32_32x32x16_bf16(pa3, PK(l3, h3), od, 0, 0, 0);
#undef PK
}
__device__ __forceinline__ void pv_d0(f32x16* o, int vb, bf16x8 pa0, bf16x8 pa1, bf16x8 pa2, bf16x8 pa3) {
    pv_one<0>(o[0], vb, pa0, pa1, pa2, pa3); pv_one<1>(o[1], vb, pa0, pa1, pa2, pa3); pv_one<2>(o[2], vb, pa0, pa1, pa2, pa3); pv_one<3>(o[3], vb, pa0, pa1, pa2, pa3);
}
template <bool DIRECT>
__device__ __forceinline__ void attn_unit(LAS unsigned char* lds, const bf16_t* QKV, const bf16_t* Z, int qrow0, int h, int crow0, int lrow0, int t0, int NT,
                                          float* Opart, float* Lse, bf16_t* MIX, const int tid) {
    const int wid = tid >> 6, lane = tid & 63, r32 = lane & 31, hi = lane >> 5;
    LAS unsigned char* V_lds = lds; LAS unsigned char* K_lds = lds + OFF_K;
    LAS float* ws = (LAS float*)(lds + OFF_WS) + wid * 64; LAS float* li_l = ws; LAS float* al_l = ws + 32;
    float m_reg = -1e30f, l_reg = 0; f32x16 o[4] = {}; bf16x8 qr[8];
    const bf16_t* Qw = QKV + (size_t)(qrow0 + wid * QBLK + r32) * NUP + h * 192 + hi * 8;
#pragma unroll
    for (int d0 = 0; d0 < 8; ++d0) qr[d0] = *(const bf16x8*)(Qw + d0 * 16);
    LAS unsigned char* qrp = lds + OFF_QR + wid * 4096 + r32 * 128; const int qsw = (r32 >> 1) & 7;
    int kq[4];
#pragma unroll
    for (int q = 0; q < 4; ++q) kq[q] = 384 * r32 + (((2 * q + hi) ^ qsw) << 4);
#pragma unroll
    for (int d0 = 8; d0 < 12; ++d0) *(LAS bf16x8*)(qrp + (((2 * (d0 - 8) + hi) ^ qsw) << 4)) = *(const bf16x8*)(Qw + d0 * 16);
    const int sr = tid >> 4, sc = (tid & 15) * 8;
    const int vst0 = v_st(sr, sc);
    const int kst0 = KSWZ(sr, sc * 2);
    const int krst = KSWZ(tid >> 3, 256 + (tid & 7) * 16);
    const unsigned voffV = (unsigned)(sr * NUP + sc) * 2u, voffR = (unsigned)((tid >> 3) * INWP + (tid & 7) * 8) * 2u;
    const char* Vb = (const char*)(QKV + 768 + h * 256 + 128); const char* Kb = (const char*)(QKV + 768 + h * 256); const char* Rb = (const char*)(Z + ZKR);
    const int vb0 = (int)(uintptr_t)V_lds + v_rd_base(lane);
    bf16x8 vs0, vs1, ks0, ks1, ks2;
#define ROW0(kt) (((t0) + (kt)) < 4 ? crow0 + 64 * ((t0) + (kt)) : lrow0 + 64 * ((t0) + (kt) - 4))
#define SLOADV(kt) do { const size_t _r0 = (size_t)__builtin_amdgcn_readfirstlane(ROW0(kt)); const char* _v = Vb + _r0 * (NUP * 2) + voffV; \
    vs0 = *(const bf16x8*)(_v); vs1 = *(const bf16x8*)(_v + 32 * NUP * 2); } while (0)
#define SLOADK(kt) do { const size_t _r0 = (size_t)__builtin_amdgcn_readfirstlane(ROW0(kt)); const char* _k = Kb + _r0 * (NUP * 2) + voffV; \
    ks0 = *(const bf16x8*)(_k); ks1 = *(const bf16x8*)(_k + 32 * NUP * 2); ks2 = *(const bf16x8*)(Rb + _r0 * (INWP * 2) + voffR); } while (0)
#define SLOAD(kt) do { SLOADV(kt); SLOADK(kt); } while (0)
#define SWRITE(b) do { *(LAS bf16x8*)(V_lds + (b) * SHM_V + vst0) = vs0; *(LAS bf16x8*)(V_lds + (b) * SHM_V + vst0 + 8192) = vs1; \
    *(LAS bf16x8*)(K_lds + (b) * SHM_K + kst0) = ks0; *(LAS bf16x8*)(K_lds + (b) * SHM_K + kst0 + 32 * 384) = ks1; *(LAS bf16x8*)(K_lds + (b) * SHM_K + krst) = ks2; } while (0)
#define SWAIT() asm volatile("s_waitcnt vmcnt(0)" ::: "memory")
#define RESC(a) do { if (__any((a) < 1.f)) { if (hi == 0) al_l[r32] = (a); asm volatile("s_waitcnt lgkmcnt(0)" ::: "memory"); \
    _Pragma("unroll") for (int d = 0; d < 4; ++d) _Pragma("unroll") for (int r = 0; r < 16; ++r) o[d][r] *= al_l[crow(r, hi)]; } } while (0)
    f32x16 pA0, pA1, pB0, pB1; float mnA, mnB, alA, alB; bf16x8 pa0, pa1, pa2, pa3;
    SLOAD(0); SWAIT(); SWRITE(0); __syncthreads();
    qkt(pA0, pA1, K_lds, qr, qrp, qsw, kq, hi); partialSM(pA0, pA1, m_reg, mnA, alA);
    SLOAD(1);
    SWAIT(); SWRITE(1); __syncthreads();
    for (int j = 1; j + 1 < NT; j += 2) {
        SBAR(); qkt(pB0, pB1, K_lds + SHM_K, qr, qrp, qsw, kq, hi);
        finishSM(pA0, pA1, alA, l_reg, pa0, pa1, pa2, pa3); SBAR();
        SLOADV(j + 1); SBAR();
        pv_d0(o, vb0, pa0, pa1, pa2, pa3); SBAR(); SLOADK(j + 1); SBAR(); partialSM(pB0, pB1, m_reg, mnB, alB);
        __syncthreads(); SWAIT(); SWRITE(0);
        RESC(alB); __syncthreads();
        SBAR(); qkt(pA0, pA1, K_lds, qr, qrp, qsw, kq, hi);
        finishSM(pB0, pB1, alB, l_reg, pa0, pa1, pa2, pa3); SBAR();
        SLOADV(j + 2); SBAR();
        pv_d0(o, vb0 + SHM_V, pa0, pa1, pa2, pa3); SBAR(); SLOADK(j + 2); SBAR(); partialSM(pA0, pA1, m_reg, mnA, alA);
        __syncthreads(); SWAIT(); SWRITE(1);
        RESC(alA); __syncthreads();
    }
    SBAR(); qkt(pB0, pB1, K_lds + SHM_K, qr, qrp, qsw, kq, hi);
    finishSM(pA0, pA1, alA, l_reg, pa0, pa1, pa2, pa3); SBAR();
    pv_d0(o, vb0, pa0, pa1, pa2, pa3); partialSM(pB0, pB1, m_reg, mnB, alB);
    __syncthreads(); RESC(alB);
    finishSM(pB0, pB1, alB, l_reg, pa0, pa1, pa2, pa3); SBAR();
    pv_d0(o, vb0 + SHM_V, pa0, pa1, pa2, pa3);
    if (hi == 0) li_l[r32] = l_reg; asm volatile("s_waitcnt lgkmcnt(0)" ::: "memory");
    float rli[16];
#pragma unroll
    for (int r = 0; r < 16; ++r) rli[r] = __builtin_amdgcn_rcpf(li_l[crow(r, hi)]);
    const int qw0 = qrow0 + wid * QBLK;
    if constexpr (DIRECT) {
#pragma unroll
        for (int r = 0; r < 16; ++r) { const int orow = crow(r, hi);
#pragma unroll
            for (int d0 = 0; d0 < 4; ++d0) MIX[(size_t)(qw0 + orow) * DM + 1536 + h * 128 + d0 * 32 + r32] = f2bf(o[d0][r] * rli[r]); }
    } else {
#pragma unroll
        for (int r = 0; r < 16; ++r) { const int orow = crow(r, hi);
#pragma unroll
            for (int d0 = 0; d0 < 4; ++d0) Opart[(size_t)(qw0 + orow) * 512 + h * 128 + d0 * 32 + r32] = o[d0][r] * rli[r]; }
        if (hi == 0) Lse[(size_t)(qw0 + r32) * 4 + h] = m_reg * (SCALE * 1.4426950408889634f) + __builtin_amdgcn_logf(l_reg);
    }
    __syncthreads();
#undef ROW0
#undef SLOAD
#undef SWRITE
#undef SWAIT
#undef RESC
}
#undef KSWZ
#undef SBAR
}

__device__ __forceinline__ void attn_combine(const Params& P, int tid, int G, int bid) {
    const float* OP = (const float*)(P.ws + WS_OP); const float* LS = (const float*)(P.ws + WS_LSE); bf16_t* MIX = (bf16_t*)(P.ws + WS_MIX);
    for (int i = bid * 512 + tid; i < ML * 64; i += G * 512) {
        const int row = i >> 6, rem = i & 63, h = rem >> 4, cg = (rem & 15) * 8;
        const float l1 = LS[(size_t)row * 4 + h], l2 = LS[((size_t)ML + row) * 4 + h], m = fmaxf(l1, l2);
        float w1 = __builtin_amdgcn_exp2f(l1 - m), w2 = __builtin_amdgcn_exp2f(l2 - m); const float inv = 1.0f / (w1 + w2); w1 *= inv; w2 *= inv;
        const float* a = OP + (size_t)row * 512 + h * 128 + cg; const float* b = OP + ((size_t)ML + row) * 512 + h * 128 + cg;
        const f32x4 a0 = *(const f32x4*)a, a1 = *(const f32x4*)(a + 4), b0 = *(const f32x4*)b, b1 = *(const f32x4*)(b + 4);
        const f32x4 o0 = a0 * w1 + b0 * w2, o1 = a1 * w1 + b1 * w2;
        u32x4 w; w.x = cvt_pk_bf16(o0[0], o0[1]); w.y = cvt_pk_bf16(o0[2], o0[3]); w.z = cvt_pk_bf16(o1[0], o1[1]); w.w = cvt_pk_bf16(o1[2], o1[3]);
        *(u32x4*)(MIX + (size_t)row * DM + 1536 + h * 128 + cg) = w;
    }
}

constexpr int PH_PER_LAYER = 9, N_PHASES = 2 + DEPTH * PH_PER_LAYER + 1;
typedef const __attribute__((address_space(4))) Params* KParams;
__global__ void __launch_bounds__(512, 2) mk_fwd(Params Pk) {
    extern __shared__ __attribute__((aligned(16))) unsigned char lds_raw[];
    LAS unsigned char* lds = (LAS unsigned char*)lds_raw;
    const int G = gridDim.x, bid = blockIdx.x;
    KParams kp0 = (KParams)__builtin_amdgcn_kernarg_segment_ptr();
    const int wave0 = __builtin_amdgcn_readfirstlane(threadIdx.x >> 6);
#define OPQ int tid; asm volatile("v_mbcnt_lo_u32_b32 %0, -1, 0\n\tv_mbcnt_hi_u32_b32 %0, -1, %0" : "=v"(tid)); tid |= wave0 << 6; const int lane = tid & 63, wave = __builtin_amdgcn_readfirstlane(tid >> 6); (void)lane; (void)wave; \
    KParams kp = kp0; asm volatile("" : "+s"(kp)); Params P; { const __attribute__((address_space(4))) unsigned long long* _q = (const __attribute__((address_space(4))) unsigned long long*)kp; unsigned long long* _d = (unsigned long long*)&P; \
      _Pragma("unroll") for (int _i = 0; _i < (int)(sizeof(Params) / 8); ++_i) _d[_i] = _q[_i]; } unsigned char* const ws = P.ws; (void)ws;
    volatile LAS unsigned* MISC = (volatile LAS unsigned*)(lds + LDS_MISC);
    for (int u = threadIdx.x; u < 256; u += 512) ((LAS unsigned*)(lds + LDS_MISC))[u] = 0u;
    __syncthreads();
    const int lo = kp0->ph_lo, hi = kp0->ph_hi;
    XcdBarrier bar; bar.bar = (unsigned*)(kp0->ws + WS_CTL) + 1024; bar.x = 0; bar.st = nullptr;
    if (hi - lo > 1) bar = xcd_barrier_post((unsigned*)(kp0->ws + WS_CTL) + 1024, MISC + 8);
#define IN(k) (lo <= (k) && (k) < hi)
#define SEAM(k) do { if (IN(k) && IN((k) + 1)) xcd_barrier(bar); } while (0)
#define XRES ((float*)(ws + WS_XRES))
#define MODL ((const float*)(ws + WS_MODV) + (size_t)layer * 3 * 6 * DM)
#define RSTAT ((float*)(ws + WS_RSTAT) + (size_t)layer * MT * 2)
#define ROPE ((const f32x2*)(ws + WS_ROPE))
#define HB ((bf16_t*)(ws + WS_H))
#define ZB ((bf16_t*)(ws + WS_Z))
#define QKVB ((bf16_t*)(ws + WS_QKV))
#define MIXB ((bf16_t*)(ws + WS_MIX))
#define UB_ ((bf16_t*)(ws + WS_U))

    for (int rp = 0; rp < PREP(1); ++rp) { if (PHM(0) && IN(0)) { OPQ phase_p0a(P, lds, tid, lane, wave, G, bid); } if (rp + 1 < PREP(1)) { __syncthreads(); } } SEAM(0);
    if (PHM(1) && IN(1)) { OPQ phase_p0b(P, tid, G, bid); } SEAM(1);

    for (int layer = 0; layer < DEPTH; ++layer) {
        const int pb = 2 + layer * PH_PER_LAYER;
        const bool need_ctx = layer < DEPTH - 1;
        const int mrows = need_ctx ? MT : ML;

        for (int rp = 0; rp < PREP(3); ++rp) if (PHM(2) && IN(pb + 0)) { OPQ
            const float* xl = layer == 0 ? P.x : XRES; const float* xc = layer == 0 ? P.ctx : XRES + (size_t)ML * DM;
            phase_norm(xl, xc, MODL, 1, 0, HB, MT, lane, wave, G, bid); } SEAM(pb + 0);
        for (int rp = 0; rp < PREP(5); ++rp) if (PHM(3) && IN(pb + 1)) { OPQ
            pg8::Gemm g{HB, (const bf16_t*)(ws + WS_WIN) + (size_t)layer * INWP * DM, MT, INWP, DM, DM, DM}; pg8::StaticOrder S; S.init(MT, INWP, G, bid);
            pg8::EpiIn E{ZB, rp == 0 ? RSTAT : (float*)(ws + WS_OP), ROPE};
            pg8::gemm_phase<pg8::EpiIn, pg8::StaticOrder>(lds, g, S, E, tid);
        } SEAM(pb + 1);
        for (int rp = 0; rp < PREP(2); ++rp) {
        for (int rq = 0; rq < PREP(8); ++rq) if (IN(pb + 2)) { OPQ
            for (int r2 = 0; r2 < PREP(16); ++r2) if (PHM(4)) {
                pg8::Gemm g{ZB + ZCQ, (const bf16_t*)(ws + WS_WUP) + (size_t)layer * NUP * KUP, MT, NUP, KUP, INWP, KUP}; pg8::StaticOrder S; S.init(MT, NUP, G, bid);
                pg8::EpiUp E{QKVB, RSTAT, ROPE};
                pg8::gemm_phase<pg8::EpiUp, pg8::StaticOrder>(lds, g, S, E, tid);
            }
            constexpr int N_G1 = 2 * 4 * 2 * NCH, N_CF = MT / 16, N_SC = MT / 16;
            const int nup_units = (MT / 256) * (NUP / 256);
            int start = bid - (nup_units % G); if (start < 0) start += G;
            for (int it = start; it < N_G1 + N_CF + N_SC; it += G) {
                if (it < N_G1) { for (int r2 = 0; r2 < PREP(11); ++r2) if (PHM(5)) gla_g1_item(lds, P, layer, it, tid, lane, wave); }
                else if (it < N_G1 + N_CF) { for (int r2 = 0; r2 < PREP(12); ++r2) if (PHM(6)) conf_item(lds, P, layer, it - N_G1, tid, lane, wave); }
                else { for (int r2 = 0; r2 < PREP(17); ++r2) if (PHM(7)) sconv_item(P, layer, it - N_G1 - N_CF, tid); }
            }
        } SEAM(pb + 2);
        for (int rq = 0; rq < PREP(9); ++rq) if (IN(pb + 3)) { OPQ
            for (int r2 = 0; r2 < PREP(14); ++r2) if (PHM(8)) gla_g2(P, tid, G, bid);
            for (int r2 = 0; r2 < PREP(13); ++r2) if (PHM(9)) for (int u = bid; u < 256; u += G) {
                const int bh = u & 7, sub = u >> 3, b = bh >> 2, h = bh & 3, qb = sub >> 1, half = sub & 1;
                att::attn_unit<false>(lds, QKVB, ZB, b * SEQ + qb * 256, h, ML + b * CTX, b * SEQ, half * 34, 34,
                                      (float*)(ws + WS_OP) + (size_t)half * ML * 512, (float*)(ws + WS_LSE) + (size_t)half * ML * 4, MIXB, tid);
            }
        } SEAM(pb + 3);
        for (int rq = 0; rq < PREP(10); ++rq) if (IN(pb + 4)) { OPQ
            for (int r2 = 0; r2 < PREP(15); ++r2) if (PHM(10)) for (int it = bid; it < 2 * 4 * NCH; it += G) gla_g3_item(lds, P, layer, it, tid, lane, wave);
            for (int r2 = 0; r2 < PREP(18); ++r2) if (PHM(11)) attn_combine(P, tid, G, bid);
            if (PHM(12) && need_ctx) {
                int start = bid - ((2 * 4 * NCH) % G); if (start < 0) start += G;
                for (int u = start; u < 8; u += G) { const int b = u >> 2, h = u & 3;
                    att::attn_unit<true>(lds, QKVB, ZB, ML + b * CTX, h, ML + b * CTX, 0, 0, 4, nullptr, nullptr, MIXB, tid); }
            }
        } SEAM(pb + 4);
        }
        for (int rp = 0; rp < PREP(6); ++rp) if (PHM(13) && IN(pb + 5)) { OPQ
            const float* xl = layer == 0 ? P.x : XRES; const float* xc = layer == 0 ? P.ctx : XRES + (size_t)ML * DM;
            pg8::Gemm g{MIXB, (const bf16_t*)(ws + WS_WOUT) + (size_t)layer * DM * DM, mrows, DM, DM, DM, DM}; pg8::StaticOrder S; S.init(mrows, DM, G, bid);
            pg8::EpiRes E{xl, xc, rp == 0 ? XRES : (float*)(ws + WS_GU), MODL + 2 * DM};
            pg8::gemm_phase<pg8::EpiRes, pg8::StaticOrder>(lds, g, S, E, tid);
        } SEAM(pb + 5);
        for (int rp = 0; rp < PREP(3); ++rp) if (PHM(2) && IN(pb + 6)) { OPQ phase_norm(XRES, XRES + (size_t)ML * DM, MODL, 4, 3, HB, mrows, lane, wave, G, bid); } SEAM(pb + 6);
        for (int rp = 0; rp < PREP(4); ++rp) if (PHM(14) && IN(pb + 7)) { OPQ
            pg8::Gemm g{HB, (const bf16_t*)(ws + WS_W13) + (size_t)layer * 2 * DFF * DM, mrows, 2 * DFF, DM, DM, DM}; pg8::StaticOrder S; S.init(mrows, 2 * DFF, G, bid);
            pg8::EpiSwiglu E{UB_};
            pg8::gemm_phase<pg8::EpiSwiglu, pg8::StaticOrder>(lds, g, S, E, tid);
        } SEAM(pb + 7);
        for (int rp = 0; rp < PREP(7); ++rp) if (PHM(15) && IN(pb + 8)) { OPQ
            pg8::Gemm g{UB_, (const bf16_t*)(ws + WS_W2) + (size_t)layer * DM * DFF, mrows, DM, DFF, DFF, DFF}; pg8::StaticOrder S; S.init(mrows, DM, G, bid);
            pg8::EpiRes E{XRES, XRES + (size_t)ML * DM, rp == 0 ? XRES : (float*)(ws + WS_GU), MODL + 5 * DM};
            pg8::gemm_phase<pg8::EpiRes, pg8::StaticOrder>(lds, g, S, E, tid);
        } SEAM(pb + 8);
    }
    if (PHM(16) && IN(N_PHASES - 1)) { OPQ phase_final(XRES, P.final_g, P.out, lane, wave, G, bid); }
#undef IN
#undef SEAM
}

extern "C" void kernel_launch(void* const* d_in, const int* in_sizes, int n_in, void* d_out, int out_size, void* d_ws, size_t ws_size, hipStream_t stream) {
    static int grid = 0;
    if (grid == 0) {
        if (n_in != 26 || in_sizes[0] != ML * DM || out_size != ML * DM || ws_size < WS_END) {
            fprintf(stderr, "kernel_launch: shape mismatch: n_in %d in0 %d out %d ws %zu (need %zu); nothing launched\n", n_in, n_in > 0 ? in_sizes[0] : -1, out_size, ws_size, (size_t)WS_END); grid = -1; return; }
        int dev = 0, cus = 0, per_cu = 0;
        if (hipGetDevice(&dev) != hipSuccess || hipDeviceGetAttribute(&cus, hipDeviceAttributeMultiprocessorCount, dev) != hipSuccess) { fprintf(stderr, "kernel_launch: device query failed\n"); grid = -1; return; }
        if (hipFuncSetAttribute((const void*)mk_fwd, hipFuncAttributeMaxDynamicSharedMemorySize, LDS_BYTES) != hipSuccess) { fprintf(stderr, "kernel_launch: hipFuncSetAttribute failed\n"); grid = -1; return; }
        if (hipOccupancyMaxActiveBlocksPerMultiprocessor(&per_cu, (const void*)mk_fwd, 512, LDS_BYTES) != hipSuccess || per_cu < 1)
            fprintf(stderr, "kernel_launch: note: occupancy query reports %d workgroups per CU\n", per_cu);
        (void)hipGetLastError();
        grid = cus;
    }
    if (grid < 0) return;
    if (hipMemsetAsync((char*)d_ws + WS_CTL, 0, CTL_BYTES, stream) != hipSuccess) { fprintf(stderr, "kernel_launch: memset failed\n"); return; }
    Params p{};
    const float** pp = (const float**)&p;
    for (int i = 0; i < 26; ++i) pp[i] = (const float*)d_in[i];
    p.out = (float*)d_out; p.ws = (unsigned char*)d_ws;
#if MK_MULTI
    for (int ph = 0; ph < N_PHASES; ++ph) { p.ph_lo = ph; p.ph_hi = ph + 1; hipLaunchKernelGGL(mk_fwd, dim3(grid), dim3(512), LDS_BYTES, stream, p); }
#else
    p.ph_lo = 0; p.ph_hi = N_PHASES;
    hipLaunchKernelGGL(mk_fwd, dim3(grid), dim3(512), LDS_BYTES, stream, p);
#endif
    const hipError_t le = hipPeekAtLastError();
    if (le != hipSuccess) fprintf(stderr, "kernel_launch: launch failed: %s\n", hipGetErrorName(le));
}
```

```cpp
#include <hip/hip_runtime.h>
#include <cstdio>
#include <cstdint>

#ifndef MK_MULTI
#define MK_MULTI 0
#endif

#ifndef PH_MASK
#define PH_MASK 0xFFFFFFFFu
#endif
#define PHM(b) ((PH_MASK >> (b)) & 1u)
#ifndef PROBE_ID
#define PROBE_ID 0
#endif
#define PREP(id) (PROBE_ID == (id) ? 2 : 1)
#define LAS __attribute__((address_space(3)))
#define GAS __attribute__((address_space(1)))
typedef unsigned short bf16_t;
typedef short bf16x8 __attribute__((ext_vector_type(8)));
typedef short s16x4 __attribute__((ext_vector_type(4)));
typedef float f32x4 __attribute__((ext_vector_type(4)));
typedef float f32x2 __attribute__((ext_vector_type(2)));
typedef float f32x16 __attribute__((ext_vector_type(16)));
typedef unsigned u32x4 __attribute__((ext_vector_type(4)));
typedef unsigned u32x2 __attribute__((ext_vector_type(2)));

constexpr int DM = 2048, NB = 2, SEQ = 4096, CTX = 256, DEPTH = 4, DFF = 5632;
constexpr int ML = NB * SEQ, MC = NB * CTX, MT = ML + MC;
constexpr int INW = 5216, INWP = 5376;
constexpr int ZQ = 0, ZK = 512, ZV = 1024, ZG = 1536, ZLR = 2048, ZCA = 2080, ZCG = 2592, ZSB = 3104, ZSC = 3616, ZSH = 4128, ZCQ = 4640, ZCKV = 5024, ZKR = 5152;
constexpr int NUP = 1792, KUP = 512;
constexpr int NCH = 68;
constexpr float EPS = 1e-6f;

constexpr size_t al256(size_t x) { return (x + 255) / 256 * 256; }
constexpr size_t WS_CTL = 0, CTL_BYTES = 1u << 20;
constexpr size_t WS_ROPE = WS_CTL + CTL_BYTES;
constexpr size_t WS_MODP = WS_ROPE + 8192;
constexpr size_t WS_MODV = WS_MODP + al256((size_t)8 * 4 * 3 * 12288 * 4);
constexpr size_t WS_RSTAT = WS_MODV + al256((size_t)4 * 3 * 6 * 2048 * 4);
constexpr size_t WS_WIN = WS_RSTAT + al256((size_t)4 * MT * 2 * 4);
constexpr size_t WS_WOUT = WS_WIN + (size_t)4 * INWP * DM * 2;
constexpr size_t WS_W13 = WS_WOUT + (size_t)4 * DM * DM * 2;
constexpr size_t WS_W2 = WS_W13 + (size_t)4 * 2 * DFF * DM * 2;
constexpr size_t WS_WUP = WS_W2 + (size_t)4 * DM * DFF * 2;
constexpr size_t WS_XRES = WS_WUP + (size_t)4 * NUP * KUP * 2;
constexpr size_t WS_H = WS_XRES + (size_t)MT * DM * 4;
constexpr size_t WS_Z = WS_H + (size_t)MT * DM * 2;
constexpr size_t WS_QKV = WS_Z + (size_t)MT * INWP * 2;
constexpr size_t WS_MIX = WS_QKV + (size_t)MT * NUP * 2;
constexpr size_t WS_U = WS_MIX + (size_t)MT * DM * 2;
constexpr size_t WS_GU = WS_U + (size_t)MT * DFF * 2;
constexpr size_t WS_GD = WS_GU + (size_t)16 * NCH * 16384 * 4;
constexpr size_t WS_GS = WS_GD + (size_t)16 * NCH * 128 * 4;
constexpr size_t WS_OP = WS_GS + (size_t)16 * NCH * 16384 * 2;
constexpr size_t WS_LSE = WS_OP + (size_t)2 * ML * 512 * 4;
constexpr size_t WS_END = WS_LSE + (size_t)2 * ML * 4 * 4;

constexpr int LDS_MAIN = 131072, LDS_MISC = LDS_MAIN, LDS_BYTES = LDS_MAIN + 1024;

__device__ __forceinline__ unsigned cvt_pk_bf16(float lo, float hi) { unsigned r; asm volatile("v_cvt_pk_bf16_f32 %0, %1, %2" : "=v"(r) : "v"(lo), "v"(hi)); return r; }
__device__ __forceinline__ float bf2f(unsigned short b) { return __uint_as_float(((unsigned)b) << 16); }
__device__ __forceinline__ float bflo(unsigned w) { return __uint_as_float(w << 16); }
__device__ __forceinline__ float bfhi(unsigned w) { return __uint_as_float(w & 0xffff0000u); }
__device__ __forceinline__ unsigned short f2bf(float f) { return (unsigned short)(cvt_pk_bf16(f, 0.f) & 0xffffu); }
__device__ __forceinline__ float wave_sum(float v) {
#pragma unroll
    for (int o = 1; o < 64; o <<= 1) v += __shfl_xor(v, o);
    return v;
}
__device__ __forceinline__ float sigmoidf_(float x) { return 1.0f / (1.0f + __expf(-x)); }
__device__ __forceinline__ float siluf_(float x) { return x / (1.0f + __expf(-x)); }
__device__ __forceinline__ float dot4(const f32x4& v) { return (v[0] * v[0] + v[1] * v[1]) + (v[2] * v[2] + v[3] * v[3]); }
#define LDS_WAIT() asm volatile("s_waitcnt lgkmcnt(0)" ::: "memory")
#define VM_WAIT() asm volatile("s_waitcnt vmcnt(0)" ::: "memory")

namespace pg8 {
#define PG8_LAS __attribute__((address_space(3)))
constexpr int BM = 256, BK = 64, HALF = 128, HTB = HALF * BK * 2, STAGE_BYTES = 8 * HTB, NXCD = 8, WGM = 8;
__host__ __device__ __forceinline__ int lds_byte(int r, int c) { const int st = (r >> 4) * 2 + (c >> 5), rr = r & 15, cc = c & 31, ob = rr * 64 + cc * 2; return st * 1024 + (ob ^ (((ob >> 9) & 1) << 5)); }
__host__ __device__ __forceinline__ void stage_rc(int b, int& R, int& C) { const int st = b / 1024, sb = b % 1024, swz = sb ^ (((sb >> 9) & 1) << 5); R = (st >> 1) * 16 + swz / 64; C = (st & 1) * 32 + (swz % 64) / 2; }
__host__ __device__ __forceinline__ int perm32(int rho) { const int n = rho >> 4, i = rho & 15; return 8 * (i >> 2) + 4 * n + (i & 3); }
struct Unit { int pm, pn, ks; };
struct Gemm { const bf16_t* A; const bf16_t* Bt; int M, N, K, lda, ldb; };
struct StaticOrder {
    int nM, nN, nwg, G, c;
    __host__ __device__ void init(int M, int N, int G_, int c_) { nM = M / BM; nN = N / BM; nwg = nM * nN; G = G_; c = c_; }
    __host__ __device__ bool next(int i, Unit& u) const {
        const long L = (long)i * G + c; if (L >= nwg) return false;
        int wgid = (int)L; { const int q = nwg / NXCD, r = nwg % NXCD, xcd = wgid % NXCD, off = wgid / NXCD; wgid = (xcd < r ? xcd * (q + 1) : r * (q + 1) + (xcd - r) * q) + off; }
        const int nig = WGM * nN, gid = wgid / nig, fm = gid * WGM, gsz = (nM - fm) < WGM ? (nM - fm) : WGM;
        u.pm = fm + ((wgid % nig) % gsz); u.pn = (wgid % nig) / gsz; u.ks = 0; return true;
    }
    __device__ __forceinline__ void a_ready(const Unit&) const {}
    __device__ __forceinline__ void done(const Unit&) const {}
};
template <class Epi, class Sched, bool ALIGN_EPI = true, bool SP2 = true>
__device__ __forceinline__ void gemm_phase(PG8_LAS unsigned char* lds, const Gemm g, const Sched& S, const Epi& E, const int tid) {
    const int wid = __builtin_amdgcn_readfirstlane(tid >> 6), lane = tid & 63, wr = wid >> 2, wc = wid & 3, fr = lane & 15, fq = lane >> 4;
    const int K = g.K, nt = K / BK;
    unsigned voffA[2], voffB[2];
#pragma unroll
    for (int i = 0; i < 2; ++i) { int R, C; stage_rc(tid * 16 + i * 8192, R, C); const int Rb = Epi::PERM ? ((R & ~31) + perm32(R & 31)) : R;
        voffA[i] = (unsigned)(R * g.lda + C) * 2u; voffB[i] = (unsigned)(Rb * g.ldb + C) * 2u; }
    const size_t kstep = (size_t)(BK * 2);
    const size_t hstepA = (size_t)HALF * g.lda * 2, hstepB = (size_t)HALF * g.ldb * 2;
    const size_t tstepA = 2 * hstepA, tstepB = 2 * hstepB;
    const unsigned ldsw = (unsigned)wid * 1024u;
    const int aoff = lds_byte(wr * 64 + fr, fq * 8), boff = lds_byte(wc * 32 + fr, fq * 8);
#define PG8_SA(b, h) (((b) * 2 + (h)) * HTB)
#define PG8_SB(b, h) ((4 + (b) * 2 + (h)) * HTB)
#define PG8_STAGE(bufoff, gbase, voff) do { _Pragma("unroll") for (int _i = 0; _i < 2; ++_i) \
        __builtin_amdgcn_global_load_lds((const unsigned*)((const char*)(gbase) + (voff)[_i]), (PG8_LAS unsigned*)(lds + (bufoff) + ldsw + _i * 8192), 16, 0, 0); } while (0)
#define PG8_LDA(dst, b, h) do { _Pragma("unroll") for (int m = 0; m < 4; ++m) _Pragma("unroll") for (int k = 0; k < 2; ++k) dst[m][k] = *(const PG8_LAS bf16x8*)(lds + PG8_SA(b, h) + aoff + m * 2048 + k * 1024); } while (0)
#define PG8_LDB(dst, b, h) do { _Pragma("unroll") for (int n = 0; n < 2; ++n) _Pragma("unroll") for (int k = 0; k < 2; ++k) dst[n][k] = *(const PG8_LAS bf16x8*)(lds + PG8_SB(b, h) + boff + n * 2048 + k * 1024); } while (0)
#define PG8_MMA(ai, bj, At, Bt) do { __builtin_amdgcn_s_setprio(1); _Pragma("unroll") for (int m = 0; m < 4; ++m) _Pragma("unroll") for (int n = 0; n < 2; ++n) _Pragma("unroll") for (int k = 0; k < 2; ++k) \
        acc[ai][bj][m][n] = __builtin_amdgcn_mfma_f32_16x16x32_bf16(Bt[n][k], At[m][k], acc[ai][bj][m][n], 0, 0, 0); __builtin_amdgcn_s_setprio(0); } while (0)
#define PG8_WAIT_V(n) asm volatile("s_waitcnt vmcnt(" #n ")" ::: "memory")
#define PG8_WAIT_L(n) asm volatile("s_waitcnt lgkmcnt(" #n ")" ::: "memory")
#define PG8_BAR __builtin_amdgcn_s_barrier()
#define PG8_SCHED __builtin_amdgcn_sched_barrier(0)
    Unit cur, nxt; int ui = 0;
    if (!S.next(0, cur)) return;
    f32x4 acc[2][2][4][2];
#pragma unroll
    for (int a = 0; a < 2; ++a)
#pragma unroll
        for (int b = 0; b < 2; ++b)
#pragma unroll
            for (int m = 0; m < 4; ++m)
#pragma unroll
                for (int n = 0; n < 2; ++n) acc[a][b][m][n] = (f32x4){0.f, 0.f, 0.f, 0.f};
    bf16x8 At[4][2], B0[2][2], B1[2][2];
    const size_t kspan = (size_t)K * 2;
    const char* cA = (const char*)g.A + (size_t)cur.pm * tstepA + (size_t)cur.ks * kspan; const char* cB = (const char*)g.Bt + (size_t)cur.pn * tstepB + (size_t)cur.ks * kspan;
    S.a_ready(cur);
    if constexpr (SP2) {
        PG8_STAGE(PG8_SB(0, 0), cB, voffB); PG8_STAGE(PG8_SB(0, 1), cB + hstepB, voffB); PG8_STAGE(PG8_SA(0, 0), cA, voffA); PG8_STAGE(PG8_SA(0, 1), cA + hstepA, voffA);
        if (wr == 1) PG8_BAR;
        PG8_WAIT_V(2); PG8_BAR;
        PG8_STAGE(PG8_SB(1, 0), cB + kstep, voffB); PG8_STAGE(PG8_SA(1, 0), cA + kstep, voffA); PG8_STAGE(PG8_SB(1, 1), cB + hstepB + kstep, voffB);
        PG8_WAIT_V(6); PG8_BAR;
    } else {
        PG8_STAGE(PG8_SB(0, 0), cB, voffB); PG8_STAGE(PG8_SA(0, 0), cA, voffA); PG8_STAGE(PG8_SB(0, 1), cB + hstepB, voffB); PG8_STAGE(PG8_SA(0, 1), cA + hstepA, voffA);
        if (wr == 1) PG8_BAR;
        PG8_WAIT_V(4); PG8_BAR;
        PG8_STAGE(PG8_SB(1, 0), cB + kstep, voffB); PG8_STAGE(PG8_SA(1, 0), cA + kstep, voffA); PG8_STAGE(PG8_SB(1, 1), cB + hstepB + kstep, voffB);
        PG8_WAIT_V(6); PG8_BAR;
    }
    for (;;) {
        const bool has_next = S.next(ui + 1, nxt);
        const char* nA = has_next ? (const char*)g.A + (size_t)nxt.pm * tstepA + (size_t)nxt.ks * kspan : cA; const char* nB = has_next ? (const char*)g.Bt + (size_t)nxt.pn * tstepB + (size_t)nxt.ks * kspan : cB;
        for (int t = 0; t < nt; t += 2) {
            const bool last = (t == nt - 2);
            const char* a1 = cA + (size_t)(t + 1) * kstep;
            const char* a2 = last ? nA : cA + (size_t)(t + 2) * kstep; const char* b2 = last ? nB : cB + (size_t)(t + 2) * kstep;
            const char* a3 = a2 + kstep; const char* b3 = b2 + kstep;
            if (last && has_next) S.a_ready(nxt);
            if constexpr (SP2) {
            PG8_LDB(B0, 0, 0); PG8_LDB(B1, 0, 1); PG8_SCHED; PG8_LDA(At, 0, 0); PG8_STAGE(PG8_SA(1, 1), a1 + hstepA, voffA);
            PG8_WAIT_V(8); PG8_WAIT_L(0); PG8_BAR; PG8_MMA(0, 0, At, B0); PG8_MMA(0, 1, At, B1); PG8_BAR; PG8_SCHED;
            PG8_LDA(At, 0, 1); PG8_STAGE(PG8_SB(0, 0), b2, voffB); PG8_STAGE(PG8_SB(0, 1), b2 + hstepB, voffB); PG8_STAGE(PG8_SA(0, 0), a2, voffA);
            PG8_WAIT_V(8); PG8_WAIT_L(0); PG8_BAR; PG8_MMA(1, 0, At, B0); PG8_MMA(1, 1, At, B1); PG8_BAR; PG8_SCHED;
            PG8_LDB(B0, 1, 0); PG8_LDB(B1, 1, 1); PG8_SCHED; PG8_LDA(At, 1, 0); PG8_STAGE(PG8_SA(0, 1), a2 + hstepA, voffA);
            PG8_WAIT_V(8); PG8_WAIT_L(0); PG8_BAR; PG8_MMA(0, 0, At, B0); PG8_MMA(0, 1, At, B1); PG8_BAR; PG8_SCHED;
            PG8_LDA(At, 1, 1); PG8_STAGE(PG8_SB(1, 0), b3, voffB); PG8_STAGE(PG8_SB(1, 1), b3 + hstepB, voffB); PG8_STAGE(PG8_SA(1, 0), a3, voffA);
            PG8_WAIT_V(8); PG8_WAIT_L(0); PG8_BAR; PG8_MMA(1, 0, At, B0); PG8_MMA(1, 1, At, B1); PG8_BAR; PG8_SCHED;
            } else {
            PG8_LDB(B0, 0, 0); PG8_SCHED; PG8_LDA(At, 0, 0); PG8_STAGE(PG8_SA(1, 1), a1 + hstepA, voffA);
            PG8_WAIT_L(8); PG8_BAR; PG8_WAIT_L(0); PG8_MMA(0, 0, At, B0); PG8_BAR; PG8_SCHED;
            PG8_LDB(B1, 0, 1); PG8_STAGE(PG8_SB(0, 0), b2, voffB);
            PG8_BAR; PG8_WAIT_L(0); PG8_MMA(0, 1, At, B1); PG8_BAR;
            PG8_LDA(At, 0, 1); PG8_STAGE(PG8_SA(0, 0), a2, voffA);
            PG8_BAR; PG8_WAIT_L(0); PG8_MMA(1, 0, At, B0); PG8_BAR; PG8_SCHED;
            PG8_STAGE(PG8_SB(0, 1), b2 + hstepB, voffB);
            PG8_WAIT_V(6); PG8_BAR; PG8_MMA(1, 1, At, B1); PG8_BAR;
            PG8_LDB(B0, 1, 0); PG8_SCHED; PG8_LDA(At, 1, 0); PG8_STAGE(PG8_SA(0, 1), a2 + hstepA, voffA);
            PG8_WAIT_L(8); PG8_BAR; PG8_WAIT_L(0); PG8_MMA(0, 0, At, B0); PG8_BAR; PG8_SCHED;
            PG8_LDB(B1, 1, 1); PG8_STAGE(PG8_SB(1, 0), b3, voffB);
            PG8_BAR; PG8_WAIT_L(0); PG8_MMA(0, 1, At, B1); PG8_BAR;
            PG8_LDA(At, 1, 1); PG8_STAGE(PG8_SA(1, 0), a3, voffA);
            PG8_BAR; PG8_WAIT_L(0); PG8_MMA(1, 0, At, B0); PG8_BAR; PG8_SCHED;
            PG8_STAGE(PG8_SB(1, 1), b3 + hstepB, voffB);
            PG8_WAIT_V(6); PG8_BAR; PG8_MMA(1, 1, At, B1); PG8_BAR;
            }
        }
        if constexpr (ALIGN_EPI) { if (wr == 0) PG8_BAR; }
        E(acc, cur, wr, wc, fr, fq);
        if (!has_next) break;
#pragma unroll
        for (int a = 0; a < 2; ++a)
#pragma unroll
            for (int b = 0; b < 2; ++b)
#pragma unroll
                for (int m = 0; m < 4; ++m)
#pragma unroll
                    for (int n = 0; n < 2; ++n) acc[a][b][m][n] = (f32x4){0.f, 0.f, 0.f, 0.f};
        cur = nxt; cA = nA; cB = nB; ++ui;
        if constexpr (ALIGN_EPI) { if (wr == 1) PG8_BAR; }
    }
    PG8_WAIT_V(0);
    if constexpr (!ALIGN_EPI) { if (wr == 0) PG8_BAR; }
    PG8_BAR;
#undef PG8_SA
#undef PG8_SB
#undef PG8_STAGE
#undef PG8_LDA
#undef PG8_LDB
#undef PG8_MMA
#undef PG8_WAIT_V
#undef PG8_WAIT_L
#undef PG8_BAR
#undef PG8_SCHED
}

struct SplitKOrder {
    int nunits, G, c;
    __host__ __device__ void init(int nsplit, int G_, int c_) { nunits = 16 * nsplit; G = G_; c = c_; }
    __host__ __device__ bool next(int i, Unit& u) const { const int L = i * G + c; if (L >= nunits) return false; u.pm = L & 1; const int rest = L >> 1; u.pn = rest & 7; u.ks = rest >> 3; return true; }
    __device__ __forceinline__ void a_ready(const Unit&) const {}
    __device__ __forceinline__ void done(const Unit&) const {}
};
__device__ __forceinline__ void rope8(f32x4& v0, f32x4& v1, const f32x2* cs) {
    const f32x2 c0 = cs[0], c1 = cs[1], c2 = cs[2], c3 = cs[3];
    float a, b;
    a = v0[0]; b = v0[1]; v0[0] = a * c0.x - b * c0.y; v0[1] = b * c0.x + a * c0.y;
    a = v0[2]; b = v0[3]; v0[2] = a * c1.x - b * c1.y; v0[3] = b * c1.x + a * c1.y;
    a = v1[0]; b = v1[1]; v1[0] = a * c2.x - b * c2.y; v1[1] = b * c2.x + a * c2.y;
    a = v1[2]; b = v1[3]; v1[2] = a * c3.x - b * c3.y; v1[3] = b * c3.x + a * c3.y;
}

struct EpiIn {
    static constexpr bool PERM = true;
    bf16_t* Z; float* rstat; const f32x2* rope;
    __device__ __forceinline__ void operator()(const f32x4 (&acc)[2][2][4][2], const Unit& u, int wr, int wc, int fr, int fq) const {
        const int row0 = u.pm * BM + wr * 64 + fr; const int colw0 = u.pn * BM + wc * 32;
        const bool special = (u.pn >= 18);
#pragma unroll
        for (int ai = 0; ai < 2; ++ai)
#pragma unroll
            for (int m = 0; m < 4; ++m) {
                const int row = row0 + ai * HALF + m * 16;
                bf16_t* rowp = Z + (size_t)row * INWP + colw0 + 8 * fq;
                float sq = 0.f, skv = 0.f;
#pragma unroll
                for (int bj = 0; bj < 2; ++bj) {
                    f32x4 v0 = acc[ai][bj][m][0], v1 = acc[ai][bj][m][1];
                    if (special) {
                        const int colw = colw0 + bj * HALF;
                        if (colw >= ZCQ && colw < ZCKV) sq += dot4(v0) + dot4(v1);
                        else if (colw >= ZCKV && colw < ZKR) skv += dot4(v0) + dot4(v1);
                        else if (colw >= ZKR && colw < INW && u.pm < 32) {
                            const int axis = (colw - ZKR) >> 5, t = row & (SEQ - 1), pos = axis ? (t & 63) : (t >> 6);
                            rope8(v0, v1, rope + pos * 16 + 4 * fq);
                        }
                    }
                    u32x4 w; w.x = cvt_pk_bf16(v0[0], v0[1]); w.y = cvt_pk_bf16(v0[2], v0[3]); w.z = cvt_pk_bf16(v1[0], v1[1]); w.w = cvt_pk_bf16(v1[2], v1[3]);
                    *(u32x4*)(rowp + bj * HALF) = w;
                }
                if (special) {
                    sq += __shfl_xor(sq, 16); sq += __shfl_xor(sq, 32); skv += __shfl_xor(skv, 16); skv += __shfl_xor(skv, 32);
                    if (fq == 0) { if (sq != 0.f) atomicAdd(rstat + (size_t)row * 2, sq); if (skv != 0.f) atomicAdd(rstat + (size_t)row * 2 + 1, skv); }
                }
            }
    }
};
struct EpiUp {
    static constexpr bool PERM = true;
    bf16_t* O; const float* rstat; const f32x2* rope;
    __device__ __forceinline__ void operator()(const f32x4 (&acc)[2][2][4][2], const Unit& u, int wr, int wc, int fr, int fq) const {
        const int row0 = u.pm * BM + wr * 64 + fr; const int colw0 = u.pn * BM + wc * 32;
#pragma unroll
        for (int ai = 0; ai < 2; ++ai)
#pragma unroll
            for (int m = 0; m < 4; ++m) {
                const int row = row0 + ai * HALF + m * 16;
                const f32x2 ss = *(const f32x2*)(rstat + (size_t)row * 2);
                const float rq = rsqrtf(ss.x * (1.0f / 384.0f) + EPS), rkv = rsqrtf(ss.y * (1.0f / 128.0f) + EPS);
                bf16_t* rowp = O + (size_t)row * NUP + colw0 + 8 * fq;
#pragma unroll
                for (int bj = 0; bj < 2; ++bj) {
                    const int colw = colw0 + bj * HALF;
                    const float sc = colw < 768 ? rq : rkv;
                    f32x4 v0 = acc[ai][bj][m][0] * sc, v1 = acc[ai][bj][m][1] * sc;
                    if (colw < 768 && u.pm < 32) {
                        const int within = colw % 192;
                        if (within >= 128) { const int axis = (within - 128) >> 5, t = row & (SEQ - 1), pos = axis ? (t & 63) : (t >> 6); rope8(v0, v1, rope + pos * 16 + 4 * fq); }
                    }
                    u32x4 w; w.x = cvt_pk_bf16(v0[0], v0[1]); w.y = cvt_pk_bf16(v0[2], v0[3]); w.z = cvt_pk_bf16(v1[0], v1[1]); w.w = cvt_pk_bf16(v1[2], v1[3]);
                    *(u32x4*)(rowp + bj * HALF) = w;
                }
            }
    }
};
struct EpiRes {
    static constexpr bool PERM = false;
    const float* base_lat; const float* base_ctx; float* out; const float* gate;
    __device__ __forceinline__ void operator()(const f32x4 (&acc)[2][2][4][2], const Unit& u, int wr, int wc, int fr, int fq) const {
        const int row0 = u.pm * BM + wr * 64 + fr, col0 = u.pn * BM + wc * 32 + 4 * fq;
        const int r = u.pm < 16 ? 0 : (u.pm < 32 ? 1 : 2);
        const float* gp = gate + (size_t)r * 6 * DM + col0;
        f32x4 gv[2][2];
#pragma unroll
        for (int bj = 0; bj < 2; ++bj)
#pragma unroll
            for (int n = 0; n < 2; ++n) gv[bj][n] = *(const f32x4*)(gp + bj * HALF + n * 16);
#pragma unroll
        for (int ai = 0; ai < 2; ++ai)
#pragma unroll
            for (int m = 0; m < 4; ++m) {
                const int row = row0 + ai * HALF + m * 16;
                const float* bp = (u.pm < 32 ? base_lat + (size_t)row * DM : base_ctx + (size_t)(row - ML) * DM) + col0;
                float* op = out + (size_t)row * DM + col0;
#pragma unroll
                for (int bj = 0; bj < 2; ++bj)
#pragma unroll
                    for (int n = 0; n < 2; ++n) { const f32x4 b = *(const f32x4*)(bp + bj * HALF + n * 16); *(f32x4*)(op + bj * HALF + n * 16) = b + gv[bj][n] * acc[ai][bj][m][n]; }
            }
    }
};
struct EpiSlab {
    static constexpr bool PERM = false;
    float* slab;
    __device__ __forceinline__ void operator()(const f32x4 (&acc)[2][2][4][2], const Unit& u, int wr, int wc, int fr, int fq) const {
        const int row0 = u.pm * BM + wr * 64 + fr, col0 = u.pn * BM + wc * 32 + 4 * fq;
#pragma unroll
        for (int ai = 0; ai < 2; ++ai)
#pragma unroll
            for (int m = 0; m < 4; ++m) { float* op = slab + ((size_t)u.ks * MC + row0 + ai * HALF + m * 16) * DM + col0;
#pragma unroll
                for (int bj = 0; bj < 2; ++bj)
#pragma unroll
                    for (int n = 0; n < 2; ++n) *(f32x4*)(op + bj * HALF + n * 16) = acc[ai][bj][m][n]; }
    }
};
struct EpiSwiglu {
    static constexpr bool PERM = true;
    bf16_t* U;
    __device__ __forceinline__ void operator()(const f32x4 (&acc)[2][2][4][2], const Unit& u, int wr, int wc, int fr, int fq) const {
        const int row0 = u.pm * BM + wr * 64 + fr, oc = u.pn * HALF + wc * 32 + 8 * fq;
#pragma unroll
        for (int ai = 0; ai < 2; ++ai)
#pragma unroll
            for (int m = 0; m < 4; ++m) {
                const int row = row0 + ai * HALF + m * 16;
                float o[8];
#pragma unroll
                for (int n = 0; n < 2; ++n)
#pragma unroll
                    for (int j = 0; j < 4; ++j) { const float a = acc[ai][0][m][n][j], b = acc[ai][1][m][n][j]; o[n * 4 + j] = a * b * __builtin_amdgcn_rcpf(1.0f + __builtin_amdgcn_exp2f(-1.4426950408889634f * a)); }
                u32x4 w; w.x = cvt_pk_bf16(o[0], o[1]); w.y = cvt_pk_bf16(o[2], o[3]); w.z = cvt_pk_bf16(o[4], o[5]); w.w = cvt_pk_bf16(o[6], o[7]);
                *(u32x4*)(U + (size_t)row * DFF + oc) = w;
            }
    }
};
}

#define XB_TMO      128
#define XB_XCNT(j)  (256  + 64 * (j))
#define XB_XSUB(j)  (1280 + 64 * (j))
#define XB_XGEN(j)  (2304 + 64 * (j))
#define XB_TOP      3328
#define XB_TOPGEN   3392
#define XCD_BAR_WORDS 3456
#define XB_SPIN_CAP (1u << 18)
__device__ __forceinline__ unsigned xb_ld(unsigned* p)              { return __hip_atomic_load(p, __ATOMIC_RELAXED, __HIP_MEMORY_SCOPE_AGENT); }
__device__ __forceinline__ unsigned xb_add(unsigned* p, unsigned v) { return __hip_atomic_fetch_add(p, v, __ATOMIC_RELAXED, __HIP_MEMORY_SCOPE_AGENT); }
__device__ __forceinline__ unsigned xb_xcc_id() { return (unsigned)__builtin_amdgcn_s_getreg((3 << 11) | 20) & 0xFu; }
#define XB_SPIN(cond, bar) do { unsigned _sp = 0; while (cond) { __builtin_amdgcn_s_sleep(1); \
    if ((++_sp & 255u) == 0u) { if (xb_ld(&(bar)[XB_TMO])) break; if (_sp > XB_SPIN_CAP) { atomicAdd(&(bar)[XB_TMO], 1u); break; } } } } while (0)
struct XcdBarrier { unsigned* bar; unsigned x; volatile LAS unsigned* st; };
__device__ __forceinline__ XcdBarrier xcd_barrier_post(unsigned* bar, volatile LAS unsigned* st) {
    XcdBarrier b; b.bar = bar; b.x = xb_xcc_id(); b.st = st;
    if (threadIdx.x == 0) (void)xb_add(&bar[XB_XCNT(b.x)], 1u);
    return b;
}
__device__ __forceinline__ void xcd_barrier_complete(unsigned* bar, unsigned x, unsigned& nloc, unsigned& nx) {
    const unsigned G = gridDim.x * gridDim.y * gridDim.z;
    unsigned sum, cnt, mine, sp = 0u;
    for (;;) {
        sum = 0u; cnt = 0u; mine = 0u;
#pragma unroll
        for (unsigned j = 0; j < 16; ++j) { const unsigned c = xb_ld(&bar[XB_XCNT(j)]); sum += c; cnt += (c > 0u) ? 1u : 0u; mine = (j == x) ? c : mine; }
        if (sum == G) break;
        __builtin_amdgcn_s_sleep(1);
        if ((++sp & 255u) == 0u) { if (xb_ld(&bar[XB_TMO])) break; if (sp > XB_SPIN_CAP) { atomicAdd(&bar[XB_TMO], 1u); break; } }
    }
    nloc = mine > 0u ? mine : 1u; nx = cnt > 0u ? cnt : 1u;
}
__device__ __forceinline__ void xcd_barrier(const XcdBarrier& b) {
    asm volatile("s_waitcnt vmcnt(0)" ::: "memory");
    __syncthreads();
    if (threadIdx.x == 0) {
        unsigned* bar = b.bar;
        __builtin_amdgcn_s_waitcnt(0);
        unsigned nloc = b.st[0], nx = b.st[1];
        if (nloc == 0u) { xcd_barrier_complete(bar, b.x, nloc, nx); b.st[0] = nloc; b.st[1] = nx; }
        const unsigned old = xb_add(&bar[XB_XSUB(b.x)], 1u);
        const unsigned gen = old / nloc;
        if (old + 1u == (gen + 1u) * nloc) {
            __builtin_amdgcn_fence(__ATOMIC_RELEASE, "agent");
            asm volatile("s_waitcnt vmcnt(0)" ::: "memory");
            const unsigned og = xb_add(&bar[XB_TOP], 1u);
            const unsigned tg = og / nx;
            if (og + 1u == (tg + 1u) * nx) xb_add(&bar[XB_TOPGEN], 1u);
            else XB_SPIN(xb_ld(&bar[XB_TOPGEN]) == tg, bar);
            __builtin_amdgcn_fence(__ATOMIC_ACQUIRE, "agent");
            xb_add(&bar[XB_XGEN(b.x)], 1u);
            asm volatile("s_waitcnt vmcnt(0)" ::: "memory");
        } else {
            XB_SPIN(xb_ld(&bar[XB_XGEN(b.x)]) == gen, bar);
            __builtin_amdgcn_fence(__ATOMIC_ACQUIRE, "agent");
            asm volatile("s_waitcnt vmcnt(0)" ::: "memory");
        }
    }
    __syncthreads();
}

struct Params {
    const float *x, *c, *ctx, *c_ctx, *norm1_g, *w_mod, *b_mod, *w_in, *fg_up, *fg_b, *onorm_g, *conf_dw, *conf_dw_b, *conf_ln_g, *conf_ln_b, *sc_dw,
                *qn_g, *kvn_g, *w_uq, *w_ukv, *w_out, *norm2_g, *w1, *w3, *w2, *final_g;
    float* out; unsigned char* ws; int ph_lo, ph_hi;
};

template <class RowMap>
__device__ __forceinline__ void transpose_item64(const float* W, int N, bf16_t* WT, int ldk, int kofs, const RowMap& rm, const float* gain, LAS unsigned* scr, int item, int lane) {
    const int nblk = (N + 63) >> 6, kb = item / nblk, nb = item % nblk, k0 = 64 * kb, n0 = 64 * nb;
    const bool nvalid = (n0 + lane) < N;
    const float* src = W + (size_t)k0 * N + n0 + (nvalid ? lane : 0);
    float v[64];
#pragma unroll
    for (int kk = 0; kk < 64; ++kk) v[kk] = src[(size_t)kk * N];
    if (gain) {
#pragma unroll
        for (int kk = 0; kk < 64; ++kk) v[kk] *= gain[k0 + kk];
    }
#pragma unroll
    for (int j = 0; j < 32; ++j) scr[lane * 33 + j] = cvt_pk_bf16(v[2 * j], v[2 * j + 1]);
    LDS_WAIT(); asm volatile("" ::: "memory");
    const int c = lane & 7;
#pragma unroll
    for (int j = 0; j < 8; ++j) { const int n = (lane >> 3) + 8 * j;
        if (n0 + n < N) { const LAS unsigned* q = scr + n * 33 + 4 * c; u32x4 o; o.x = q[0]; o.y = q[1]; o.z = q[2]; o.w = q[3];
            *(u32x4*)(WT + (size_t)rm(n0 + n) * ldk + kofs + k0 + 8 * c) = o; } }
    LDS_WAIT(); asm volatile("" ::: "memory");
}
struct RmId { __device__ __forceinline__ int operator()(int n) const { return n; } };
struct RmIn { __device__ __forceinline__ int operator()(int n) const { if (n < ZKR) return n; const int rc = n - ZKR, a = rc >> 5, hf = (rc >> 4) & 1, i = rc & 15; return ZKR + a * 32 + 2 * i + hf; } };
struct RmUq { __device__ __forceinline__ int operator()(int n) const { const int hd = n / 192, within = n % 192; if (within < 128) return n; const int rc = within - 128, a = rc >> 5, hf = (rc >> 4) & 1, i = rc & 15; return hd * 192 + 128 + a * 32 + 2 * i + hf; } };
struct RmOff { int off; __device__ __forceinline__ int operator()(int n) const { return off + n; } };
struct RmFf { int off; __device__ __forceinline__ int operator()(int n) const { return (n >> 7) * 256 + off + (n & 127); } };

struct Frame {
    LAS unsigned char* lds; int tid, lane, wave, G, bid; unsigned char* ws; const Params* p;
};

__device__ __forceinline__ void phase_p0a(const Params& P, LAS unsigned char* lds, int tid, int lane, int wave, int G, int bid) {
    unsigned char* ws = P.ws;
    const int gw = bid * 8 + wave, NGW = G * 8;
    const int gt = bid * 512 + tid, NGT = G * 512;
    LAS float* act = (LAS float*)(lds + 8 * 8448);
    for (int i = tid; i < 3 * DM; i += 512) { const int r = i / DM, k = i % DM; const float v = r < 2 ? P.c[r * DM + k] : P.c_ctx[k]; act[i] = v / (1.0f + expf(-v)); }
    __syncthreads();
    {
        float* modp = (float*)(ws + WS_MODP);
        for (int it = gw; it < 4 * 48 * 8; it += NGW) {
            const int layer = it / 384, rem = it % 384, cb = rem / 8, ks = rem % 8;
            const int col0 = cb * 256 + lane * 4;
            const float* Wp = P.w_mod + ((size_t)layer * DM + (size_t)ks * 256) * 12288 + col0;
            const LAS float* a0 = act + ks * 256;
            f32x4 s0 = {0.f, 0.f, 0.f, 0.f}, s1 = s0, s2 = s0;
#pragma unroll 16
            for (int k = 0; k < 256; ++k) { const f32x4 w = *(const f32x4*)(Wp + (size_t)k * 12288); s0 += w * a0[k]; s1 += w * a0[DM + k]; s2 += w * a0[2 * DM + k]; }
            float* o = modp + (((size_t)ks * 4 + layer) * 3) * 12288 + col0;
            *(f32x4*)(o) = s0; *(f32x4*)(o + 12288) = s1; *(f32x4*)(o + 2 * 12288) = s2;
        }
    }
    {
        LAS unsigned* scr = (LAS unsigned*)(lds + wave * 8448);
        constexpr int I_IN = (DM / 64) * ((INW + 63) / 64), I_OUT = (DM / 64) * (DM / 64), I_FF = (DM / 64) * (DFF / 64), I_W2 = (DFF / 64) * (DM / 64), I_UQ = (384 / 64) * (768 / 64), I_UKV = (128 / 64) * (1024 / 64);
        constexpr int PER_LAYER = I_IN + I_OUT + 2 * I_FF + I_W2 + I_UQ + I_UKV;
        for (int it = gw; it < 4 * PER_LAYER; it += NGW) {
            const int layer = it / PER_LAYER; int r = it % PER_LAYER;
            if (r < I_IN) { transpose_item64(P.w_in + (size_t)layer * DM * INW, INW, (bf16_t*)(ws + WS_WIN) + (size_t)layer * INWP * DM, DM, 0, RmIn{}, nullptr, scr, r, lane); continue; } r -= I_IN;
            if (r < I_OUT) { transpose_item64(P.w_out + (size_t)layer * DM * DM, DM, (bf16_t*)(ws + WS_WOUT) + (size_t)layer * DM * DM, DM, 0, RmId{}, nullptr, scr, r, lane); continue; } r -= I_OUT;
            if (r < I_FF) { transpose_item64(P.w1 + (size_t)layer * DM * DFF, DFF, (bf16_t*)(ws + WS_W13) + (size_t)layer * 2 * DFF * DM, DM, 0, RmFf{0}, nullptr, scr, r, lane); continue; } r -= I_FF;
            if (r < I_FF) { transpose_item64(P.w3 + (size_t)layer * DM * DFF, DFF, (bf16_t*)(ws + WS_W13) + (size_t)layer * 2 * DFF * DM, DM, 0, RmFf{128}, nullptr, scr, r, lane); continue; } r -= I_FF;
            if (r < I_W2) { transpose_item64(P.w2 + (size_t)layer * DFF * DM, DM, (bf16_t*)(ws + WS_W2) + (size_t)layer * DM * DFF, DFF, 0, RmId{}, nullptr, scr, r, lane); continue; } r -= I_W2;
            if (r < I_UQ) { transpose_item64(P.w_uq + (size_t)layer * 384 * 768, 768, (bf16_t*)(ws + WS_WUP) + (size_t)layer * NUP * KUP, KUP, 0, RmUq{}, P.qn_g + layer * 384, scr, r, lane); continue; } r -= I_UQ;
            transpose_item64(P.w_ukv + (size_t)layer * 128 * 1024, 1024, (bf16_t*)(ws + WS_WUP) + (size_t)layer * NUP * KUP, KUP, 384, RmOff{768}, P.kvn_g + layer * 128, scr, r, lane);
        }
    }
    {
        constexpr int PADW = (INWP - INW) * DM / 8;
        for (int i = gt; i < 4 * PADW; i += NGT) { const int layer = i / PADW, j = i % PADW;
            *(u32x4*)((bf16_t*)(ws + WS_WIN) + ((size_t)layer * INWP + INW) * DM + (size_t)j * 8) = (u32x4){0u, 0u, 0u, 0u}; }
        constexpr int ZQ_ = 768 * 16, ZKV_ = 1024 * 48;
        for (int i = gt; i < 4 * (ZQ_ + ZKV_); i += NGT) { const int layer = i / (ZQ_ + ZKV_), j = i % (ZQ_ + ZKV_);
            bf16_t* WU = (bf16_t*)(ws + WS_WUP) + (size_t)layer * NUP * KUP;
            if (j < ZQ_) *(u32x4*)(WU + (size_t)(j >> 4) * KUP + 384 + (j & 15) * 8) = (u32x4){0u, 0u, 0u, 0u};
            else { const int jj = j - ZQ_; *(u32x4*)(WU + (size_t)(768 + jj / 48) * KUP + (jj % 48) * 8) = (u32x4){0u, 0u, 0u, 0u}; } }
    }
    {
        f32x2* rope = (f32x2*)(ws + WS_ROPE);
        for (int i = gt; i < 1024; i += NGT) { const int pos = i >> 4, f = i & 15; const float inv = powf(10000.0f, -(float)f * 2.0f / 32.0f); const float ang = (float)pos * inv; rope[i] = (f32x2){cosf(ang), sinf(ang)}; }
        float* rs = (float*)(ws + WS_RSTAT);
        for (int i = gt; i < 4 * MT * 2; i += NGT) rs[i] = 0.f;
    }
}
__device__ __forceinline__ void phase_p0b(const Params& P, int tid, int G, int bid) {
    const float* modp = (const float*)(P.ws + WS_MODP); float* modv = (float*)(P.ws + WS_MODV);
    for (int i = bid * 512 + tid; i < 4 * 3 * 12288; i += G * 512) {
        const int layer = i / (3 * 12288), rem = i % (3 * 12288), r = rem / 12288, c12 = rem % 12288, j = c12 / DM, col = c12 % DM;
        float s = P.b_mod[layer * 12288 + c12];
#pragma unroll
        for (int ks = 0; ks < 8; ++ks) s += modp[(((size_t)ks * 4 + layer) * 3 + r) * 12288 + c12];
        if (j == 1) s = P.norm1_g[layer * DM + col] * (1.0f + s);
        if (j == 4) s = P.norm2_g[layer * DM + col] * (1.0f + s);
        modv[(((size_t)layer * 3 + r) * 6 + j) * DM + col] = s;
    }
}

__device__ __forceinline__ void phase_norm(LAS unsigned char* lds, const float* xlat, const float* xctx, const float* modl  , int jg, int jsh, bf16_t* H, bool with_ctx,
                                           const float* slab, int nslab, const float* sgate, float* xctx_out, int tid, int lane, int wave, int G, int bid) {
    if (with_ctx) {
        LAS float* red = (LAS float*)lds;
        const float* gp = modl + ((size_t)2 * 6 + jg) * DM; const float* sp = modl + ((size_t)2 * 6 + jsh) * DM;
        for (int r0 = bid * 2; r0 < MC; r0 += G * 2) {
            const int col = wave * 256 + lane * 4;
            f32x4 v[2]; float ss[2];
#pragma unroll
            for (int q = 0; q < 2; ++q) { const int row = r0 + q;
                v[q] = *(const f32x4*)(xctx + (size_t)row * DM + col);
                if (nslab > 0) { f32x4 a = {0.f, 0.f, 0.f, 0.f};
                    for (int sI = 0; sI < nslab; ++sI) a += *(const f32x4*)(slab + ((size_t)sI * MC + row) * DM + col);
                    v[q] += *(const f32x4*)(sgate + col) * a;
                    *(f32x4*)(xctx_out + (size_t)row * DM + col) = v[q]; }
                ss[q] = wave_sum(dot4(v[q])); }
            if (lane == 0) { red[wave * 2] = ss[0]; red[wave * 2 + 1] = ss[1]; }
            __syncthreads();
            const f32x4 gs = *(const f32x4*)(gp + col), sh = *(const f32x4*)(sp + col);
#pragma unroll
            for (int q = 0; q < 2; ++q) { float t = 0.f;
#pragma unroll
                for (int w = 0; w < 8; ++w) t += red[w * 2 + q];
                const float rstd = rsqrtf(t * (1.0f / DM) + EPS);
                const f32x4 o = v[q] * rstd * gs + sh; u32x2 w2; w2.x = cvt_pk_bf16(o[0], o[1]); w2.y = cvt_pk_bf16(o[2], o[3]);
                *(u32x2*)(H + (size_t)(ML + r0 + q) * DM + col) = w2; }
            __syncthreads();
        }
    }
    const int rpw = (ML + G - 1) / G;
    int cur = -1; f32x4 gsv[8], shv[8];
    for (int k = wave; k < rpw; k += 8) {
        const int row = bid * rpw + k; if (row >= ML) break;
        const int r = row < SEQ ? 0 : 1;
        if (r != cur) { cur = r; const float* gp = modl + ((size_t)r * 6 + jg) * DM; const float* sp = modl + ((size_t)r * 6 + jsh) * DM;
#pragma unroll
            for (int j = 0; j < 8; ++j) { gsv[j] = *(const f32x4*)(gp + (lane + 64 * j) * 4); shv[j] = *(const f32x4*)(sp + (lane + 64 * j) * 4); } }
        const float* xr = xlat + (size_t)row * DM;
        f32x4 v[8]; float ss = 0.f;
#pragma unroll
        for (int j = 0; j < 8; ++j) { v[j] = *(const f32x4*)(xr + (lane + 64 * j) * 4); ss += dot4(v[j]); }
        const float rstd = rsqrtf(wave_sum(ss) * (1.0f / DM) + EPS);
        bf16_t* hr = H + (size_t)row * DM;
#pragma unroll
        for (int j = 0; j < 8; ++j) { const f32x4 o = v[j] * rstd * gsv[j] + shv[j]; u32x2 w; w.x = cvt_pk_bf16(o[0], o[1]); w.y = cvt_pk_bf16(o[2], o[3]); *(u32x2*)(hr + (lane + 64 * j) * 4) = w; }
    }
}
__device__ __forceinline__ void phase_final(const float* X, const float* g, float* out, int lane, int wave, int G, int bid) {
    for (int row = bid * 8 + wave; row < ML; row += G * 8) {
        const float* xr = X + (size_t)row * DM; f32x4 v[8]; float ss = 0.f;
#pragma unroll
        for (int j = 0; j < 8; ++j) { v[j] = *(const f32x4*)(xr + (lane + 64 * j) * 4); ss += dot4(v[j]); }
        const float rstd = rsqrtf(wave_sum(ss) * (1.0f / DM) + EPS);
#pragma unroll
        for (int j = 0; j < 8; ++j) { const f32x4 gg = *(const f32x4*)(g + (lane + 64 * j) * 4); *(f32x4*)(out + (size_t)row * DM + (lane + 64 * j) * 4) = v[j] * rstd * gg; }
    }
}

constexpr int GL_RQ = 0;
constexpr int GL_RK = 16384;
constexpr int GL_RV = 32768;
constexpr int GL_QT = 49152;
constexpr int GL_KT = 66560;
constexpr int GL_PP = 83968;
constexpr int GL_VT = 93184;
constexpr int GL_LR = 111616;
constexpr int GL_TOT = 119808;
__device__ __forceinline__ int gla_row0(int b, int id) { return id < 4 ? ML + b * CTX + id * 64 : b * SEQ + (id - 4) * 64; }
template <bool WITH_Q>
__device__ __forceinline__ void gla_stage(LAS unsigned char* lds, const bf16_t* Z, int row0, int h, int tid) {
    const int t = tid >> 3, dg = (tid & 7) * 16;
    const bf16_t* zr = Z + (size_t)(row0 + t) * INWP + h * 128 + dg;
    const u32x4 k0 = *(const u32x4*)(zr + ZK), k1 = *(const u32x4*)(zr + ZK + 8), v0 = *(const u32x4*)(zr + ZV), v1 = *(const u32x4*)(zr + ZV + 8);
    u32x4 q0 = {0u, 0u, 0u, 0u}, q1 = q0; if (WITH_Q) { q0 = *(const u32x4*)(zr + ZQ); q1 = *(const u32x4*)(zr + ZQ + 8); }
    u32x4 l0 = {0u, 0u, 0u, 0u}, l1 = l0;
    if (tid < 128) { const bf16_t* lp = Z + (size_t)(row0 + (tid >> 1)) * INWP + ZLR + (tid & 1) * 8; l0 = *(const u32x4*)lp; l1 = *(const u32x4*)(lp + 16); }
    *(LAS u32x4*)(lds + GL_RK + t * 256 + dg * 2) = k0; *(LAS u32x4*)(lds + GL_RK + t * 256 + dg * 2 + 16) = k1;
    *(LAS u32x4*)(lds + GL_RV + t * 256 + dg * 2) = v0; *(LAS u32x4*)(lds + GL_RV + t * 256 + dg * 2 + 16) = v1;
    if (WITH_Q) { *(LAS u32x4*)(lds + GL_RQ + t * 256 + dg * 2) = q0; *(LAS u32x4*)(lds + GL_RQ + t * 256 + dg * 2 + 16) = q1; }
    if (tid < 128) { LAS float* LR = (LAS float*)(lds + GL_LR) + (tid >> 1) * 16 + (tid & 1) * 8;
        LR[0] = bflo(l0.x); LR[1] = bfhi(l0.x); LR[2] = bflo(l0.y); LR[3] = bfhi(l0.y); LR[4] = bflo(l0.z); LR[5] = bfhi(l0.z); LR[6] = bflo(l0.w); LR[7] = bfhi(l0.w);
        LAS float* L1 = LR + 1024;
        L1[0] = bflo(l1.x); L1[1] = bfhi(l1.x); L1[2] = bflo(l1.y); L1[3] = bfhi(l1.y); L1[4] = bflo(l1.z); L1[5] = bfhi(l1.z); L1[6] = bflo(l1.w); L1[7] = bfhi(l1.w); }
}
__device__ __forceinline__ void gla_decay_local(LAS unsigned char* lds, const float* fgup  , const float* fgb  , int h, int dir, int tid, float (&p)[16]) {
    const int d = tid & 127, seg = tid >> 7;
    float fg[16];
#pragma unroll
    for (int r = 0; r < 16; ++r) fg[r] = fgup[r * 512 + h * 128 + d];
    const float fb = fgb[h * 128 + d];
    const LAS float* LR = (const LAS float*)(lds + GL_LR) + dir * 1024 + seg * 256;
#pragma unroll
    for (int i = 0; i < 16; ++i) { float x = fb;
#pragma unroll
        for (int r4 = 0; r4 < 4; ++r4) { const f32x4 l = *(const LAS f32x4*)(LR + i * 16 + r4 * 4); x += l[0] * fg[r4 * 4] + l[1] * fg[r4 * 4 + 1] + l[2] * fg[r4 * 4 + 2] + l[3] * fg[r4 * 4 + 3]; }
        p[i] = (fminf(x, 0.f) - __logf(1.0f + __expf(-fabsf(x)))) * (1.0f / 16.0f); }
    if (dir == 0) {
#pragma unroll
        for (int i = 1; i < 16; ++i) p[i] += p[i - 1];
        ((LAS float*)(lds + GL_TOT))[seg * 128 + d] = p[15];
    } else {
#pragma unroll
        for (int i = 14; i >= 0; --i) p[i] += p[i + 1];
        ((LAS float*)(lds + GL_TOT))[seg * 128 + d] = p[0];
    }
}
__device__ __forceinline__ float gla_offsets(const LAS unsigned char* lds, int dir, int tid, float (&p)[16]) {
    const int d = tid & 127, seg = tid >> 7;
    const LAS float* T = (const LAS float*)(lds + GL_TOT) + d;
    const float t0 = T[0], t1 = T[128], t2 = T[256], t3 = T[384];
    float off;
    if (dir == 0) off = (seg > 0 ? t0 : 0.f) + (seg > 1 ? t1 : 0.f) + (seg > 2 ? t2 : 0.f);
    else off = (seg < 3 ? t3 : 0.f) + (seg < 2 ? t2 : 0.f) + (seg < 1 ? t1 : 0.f);
#pragma unroll
    for (int i = 0; i < 16; ++i) p[i] += off;
    return (t0 + t1) + (t2 + t3);
}
__device__ __forceinline__ void gla_build_vT(LAS unsigned char* lds, int tid) {
    const int e = tid & 127, seg = tid >> 7;
    const LAS bf16_t* RV = (const LAS bf16_t*)(lds + GL_RV) + (16 * seg) * 128 + e;
    unsigned w[8];
#pragma unroll
    for (int i = 0; i < 8; ++i) w[i] = (unsigned)RV[(2 * i) * 128] | ((unsigned)RV[(2 * i + 1) * 128] << 16);
    LAS u32x4* dst = (LAS u32x4*)(lds + GL_VT + e * 144 + seg * 32);
    dst[0] = (u32x4){w[0], w[1], w[2], w[3]}; dst[1] = (u32x4){w[4], w[5], w[6], w[7]};
}
__device__ __forceinline__ void gla_g1_item(LAS unsigned char* lds, const Params& P, int layer, int item, int tid, int lane, int wave) {
    const bf16_t* Z = (const bf16_t*)(P.ws + WS_Z);
    const int id = item % NCH, h = (item / NCH) & 3, b = item / (4 * NCH);
    const int row0 = gla_row0(b, id);
    gla_stage<false>(lds, Z, row0, h, tid);
    __syncthreads();
    LAS bf16_t* KH = (LAS bf16_t*)(lds + GL_QT);
    const LAS bf16_t* VT = (const LAS bf16_t*)(lds + GL_VT);
    const int d = tid & 127, seg = tid >> 7;
    for (int dir = 0; dir < 2; ++dir) {
        const int seq = (b * 4 + h) * 2 + dir;
        float p[16];
        gla_decay_local(lds, P.fg_up + ((size_t)layer * 2 + dir) * 16 * 512, P.fg_b + ((size_t)layer * 2 + dir) * 512, h, dir, tid, p);
        __syncthreads();
        const float blast = gla_offsets(lds, dir, tid, p);
        {
            const LAS bf16_t* RK = (const LAS bf16_t*)(lds + GL_RK) + (16 * seg) * 128 + d;
            unsigned w[8];
#pragma unroll
            for (int i = 0; i < 8; ++i) w[i] = cvt_pk_bf16(bf2f(RK[(2 * i) * 128]) * __expf(blast - p[2 * i]), bf2f(RK[(2 * i + 1) * 128]) * __expf(blast - p[2 * i + 1]));
            LAS u32x4* dst = (LAS u32x4*)(lds + GL_QT + d * 144 + seg * 32);
            dst[0] = (u32x4){w[0], w[1], w[2], w[3]}; dst[1] = (u32x4){w[4], w[5], w[6], w[7]};
            if (dir == 0) gla_build_vT(lds, tid);
            if (seg == 0) ((float*)(P.ws + WS_GD))[((size_t)seq * NCH + id) * 128 + d] = __expf(blast);
        }
        __syncthreads();
        {
            const int eb = wave >> 1, r32 = lane & 31, hi = lane >> 5;
            float* U = (float*)(P.ws + WS_GU) + ((size_t)seq * NCH + id) * 16384;
#pragma unroll
            for (int q = 0; q < 2; ++q) { const int db = 2 * (wave & 1) + q; f32x16 acc = {};
#pragma unroll
                for (int kk = 0; kk < 4; ++kk) { const bf16x8 av = *(const LAS bf16x8*)(VT + (32 * eb + r32) * 72 + 16 * kk + 8 * hi), bv = *(const LAS bf16x8*)(KH + (32 * db + r32) * 72 + 16 * kk + 8 * hi);
                    acc = __builtin_amdgcn_mfma_f32_32x32x16_bf16(av, bv, acc, 0, 0, 0); }
#pragma unroll
                for (int r = 0; r < 16; ++r) { const int e = 32 * eb + (r & 3) + 8 * (r >> 2) + 4 * hi; U[e * 128 + 32 * db + r32] = acc[r]; } }
        }
        __syncthreads();
    }
}
__device__ __forceinline__ void gla_g2(const Params& P, int tid, int G, int bid) {
    const float* U = (const float*)(P.ws + WS_GU); const float* Dv = (const float*)(P.ws + WS_GD); bf16_t* S = (bf16_t*)(P.ws + WS_GS);
    for (int slot = bid * 512 + tid; slot < 16 * 8192; slot += G * 512) {
        const int seq = slot >> 13, el = (slot & 8191) * 2, d = el & 127, dir = seq & 1;
        float s0 = 0.f, s1 = 0.f;
#pragma unroll 4
        for (int p = 0; p < NCH; ++p) {
            const int id = dir == 0 ? p : (p < 4 ? 3 - p : 71 - p);
            const size_t base = ((size_t)seq * NCH + id);
            *(unsigned*)(S + base * 16384 + el) = cvt_pk_bf16(s0, s1);
            const f32x2 u = *(const f32x2*)(U + base * 16384 + el), dd = *(const f32x2*)(Dv + base * 128 + d);
            s0 = dd.x * s0 + u.x; s1 = dd.y * s1 + u.y;
        }
    }
}
__device__ __forceinline__ void gla_g3_item(LAS unsigned char* lds, const Params& P, int layer, int item, int tid, int lane, int wave) {
    const bf16_t* Z = (const bf16_t*)(P.ws + WS_Z);
    const int id = item % NCH, h = (item / NCH) & 3, b = item / (4 * NCH);
    const int row0 = gla_row0(b, id);
    const int r32 = lane & 31, hi = lane >> 5, rb = wave >> 2, cb = wave & 3;
    const int d = tid & 127, seg = tid >> 7;
    const u32x4* gsrc = (const u32x4*)(Z + (size_t)(row0 + (tid >> 3)) * INWP + ZG + h * 128 + (tid & 7) * 16); const u32x4 ga = gsrc[0], gb = gsrc[1];
    gla_stage<true>(lds, Z, row0, h, tid);
    __syncthreads();
    LAS bf16_t* QT = (LAS bf16_t*)(lds + GL_QT); LAS bf16_t* KT = (LAS bf16_t*)(lds + GL_KT); LAS bf16_t* PP = (LAS bf16_t*)(lds + GL_PP);
    const LAS bf16_t* VT = (const LAS bf16_t*)(lds + GL_VT);
    f32x16 o = {};
    for (int dir = 0; dir < 2; ++dir) {
        const int seq = (b * 4 + h) * 2 + dir;
        const bf16_t* Sg = (const bf16_t*)(P.ws + WS_GS) + ((size_t)seq * NCH + id) * 16384 + (size_t)(32 * cb + r32) * 128 + 8 * hi;
        bf16x8 sf[8];
#pragma unroll
        for (int kk = 0; kk < 8; ++kk) sf[kk] = *(const bf16x8*)(Sg + 16 * kk);
        float p[16];
        gla_decay_local(lds, P.fg_up + ((size_t)layer * 2 + dir) * 16 * 512, P.fg_b + ((size_t)layer * 2 + dir) * 512, h, dir, tid, p);
        __syncthreads();
        (void)gla_offsets(lds, dir, tid, p);
        {
            const LAS bf16_t* RQ = (const LAS bf16_t*)(lds + GL_RQ) + (16 * seg) * 128 + d; const LAS bf16_t* RK = (const LAS bf16_t*)(lds + GL_RK) + (16 * seg) * 128 + d;
#pragma unroll
            for (int i = 0; i < 16; ++i) { const int t = 16 * seg + i;
                QT[t * 136 + d] = f2bf(bf2f(RQ[i * 128]) * (0.08838834764831845f * __expf(p[i])));
                KT[t * 136 + d] = f2bf(bf2f(RK[i * 128]) * __expf(fminf(-p[i], 80.f))); }
            if (dir == 0) gla_build_vT(lds, tid);
        }
        __syncthreads();
        {
            const int bi = wave >> 1, fr = lane & 15, fq = lane >> 4;
#pragma unroll
            for (int q = 0; q < 2; ++q) { const int bj = 2 * (wave & 1) + q; f32x4 acc = {0.f, 0.f, 0.f, 0.f};
#pragma unroll
                for (int kk = 0; kk < 4; ++kk) { const bf16x8 av = *(const LAS bf16x8*)(QT + (16 * bi + fr) * 136 + 32 * kk + 8 * fq), bv = *(const LAS bf16x8*)(KT + (16 * bj + fr) * 136 + 32 * kk + 8 * fq);
                    acc = __builtin_amdgcn_mfma_f32_16x16x32_bf16(av, bv, acc, 0, 0, 0); }
                const int jt = 16 * bj + fr;
#pragma unroll
                for (int r = 0; r < 4; ++r) { const int it = 16 * bi + 4 * fq + r; const bool keep = dir == 0 ? (jt <= it) : (jt >= it); PP[it * 72 + jt] = f2bf(keep ? acc[r] : 0.f); } }
        }
        __syncthreads();
        {
#pragma unroll
            for (int kk = 0; kk < 4; ++kk) { const bf16x8 av = *(const LAS bf16x8*)(PP + (32 * rb + r32) * 72 + 16 * kk + 8 * hi), bv = *(const LAS bf16x8*)(VT + (32 * cb + r32) * 72 + 16 * kk + 8 * hi);
                o = __builtin_amdgcn_mfma_f32_32x32x16_bf16(av, bv, o, 0, 0, 0); }
#pragma unroll
            for (int kk = 0; kk < 8; ++kk) { const bf16x8 av = *(const LAS bf16x8*)(QT + (32 * rb + r32) * 136 + 16 * kk + 8 * hi);
                o = __builtin_amdgcn_mfma_f32_32x32x16_bf16(av, sf[kk], o, 0, 0, 0); }
        }
        __syncthreads();
    }
    LAS float* OS = (LAS float*)(lds + GL_RQ);
#pragma unroll
    for (int r = 0; r < 16; ++r) { const int t = 32 * rb + (r & 3) + 8 * (r >> 2) + 4 * hi; OS[t * 132 + 32 * cb + r32] = o[r]; }
    __syncthreads();
    {
        const int t = tid >> 3, eg = (tid & 7) * 16;
        f32x4 v[4]; float ss = 0.f;
#pragma unroll
        for (int q = 0; q < 4; ++q) { v[q] = *(const LAS f32x4*)(OS + t * 132 + eg + 4 * q); ss += dot4(v[q]); }
        ss += __shfl_xor(ss, 1); ss += __shfl_xor(ss, 2); ss += __shfl_xor(ss, 4);
        const float rstd = rsqrtf(ss * (1.0f / 128.0f) + EPS);
        const unsigned gw[8] = {ga.x, ga.y, ga.z, ga.w, gb.x, gb.y, gb.z, gb.w};
        const float* og = P.onorm_g + layer * 128 + eg;
        unsigned ow[8];
#pragma unroll
        for (int i = 0; i < 8; ++i) { const float g0 = bflo(gw[i]), g1 = bfhi(gw[i]);
            const float o0 = v[i >> 1][(i & 1) * 2] * rstd * og[2 * i] * siluf_(g0), o1 = v[i >> 1][(i & 1) * 2 + 1] * rstd * og[2 * i + 1] * siluf_(g1);
            ow[i] = cvt_pk_bf16(o0, o1); }
        bf16_t* mp = (bf16_t*)(P.ws + WS_MIX) + (size_t)(row0 + t) * DM + h * 128 + eg;
        *(u32x4*)(mp) = (u32x4){ow[0], ow[1], ow[2], ow[3]}; *(u32x4*)(mp + 8) = (u32x4){ow[4], ow[5], ow[6], ow[7]};
    }
    __syncthreads();
}

__device__ __forceinline__ void conf_item(LAS unsigned char* lds, const Params& P, int layer, int item, int tid, int lane, int wave) {
    const bf16_t* Z = (const bf16_t*)(P.ws + WS_Z);
    const int r0 = item * 16;
    const int s0 = r0 < ML ? (r0 & ~(SEQ - 1)) : ML + ((r0 - ML) & ~(CTX - 1)), s1 = s0 + (r0 < ML ? SEQ : CTX);
    LAS float* UB = (LAS float*)lds;
    LAS float* YB = (LAS float*)(lds + 46 * 512 * 4);
    const int c = tid;
    u32x4 av[6], gv[6];
#pragma unroll
    for (int i = 0; i < 6; ++i) { const int pc = tid + 512 * i, rr = pc >> 6, ch = pc & 63, row = r0 - 15 + rr;
        const bool ok = (pc < 46 * 64) && row >= s0 && row < s1; const bf16_t* zp = Z + (size_t)(ok ? row : s0) * INWP + ch * 8;
        av[i] = *(const u32x4*)(zp + ZCA); gv[i] = *(const u32x4*)(zp + ZCG);
        if (!ok) { av[i] = (u32x4){0u, 0u, 0u, 0u}; } }
    float w[31];
#pragma unroll
    for (int j = 0; j < 31; ++j) w[j] = P.conf_dw[((size_t)layer * 31 + j) * 512 + c];
    const float bias = P.conf_dw_b[layer * 512 + c];
#pragma unroll
    for (int i = 0; i < 6; ++i) { const int pc = tid + 512 * i, rr = pc >> 6, ch = pc & 63;
        if (pc < 46 * 64) { const unsigned aw[4] = {av[i].x, av[i].y, av[i].z, av[i].w}, gw[4] = {gv[i].x, gv[i].y, gv[i].z, gv[i].w};
            f32x4 u0, u1;
            u0[0] = bflo(aw[0]) * sigmoidf_(bflo(gw[0])); u0[1] = bfhi(aw[0]) * sigmoidf_(bfhi(gw[0])); u0[2] = bflo(aw[1]) * sigmoidf_(bflo(gw[1])); u0[3] = bfhi(aw[1]) * sigmoidf_(bfhi(gw[1]));
            u1[0] = bflo(aw[2]) * sigmoidf_(bflo(gw[2])); u1[1] = bfhi(aw[2]) * sigmoidf_(bfhi(gw[2])); u1[2] = bflo(aw[3]) * sigmoidf_(bflo(gw[3])); u1[3] = bfhi(aw[3]) * sigmoidf_(bfhi(gw[3]));
            *(LAS f32x4*)(UB + rr * 512 + ch * 8) = u0; *(LAS f32x4*)(UB + rr * 512 + ch * 8 + 4) = u1; } }
    __syncthreads();
#pragma unroll
    for (int g8 = 0; g8 < 2; ++g8) {
        float win[38];
#pragma unroll
        for (int i = 0; i < 38; ++i) win[i] = UB[(g8 * 8 + i) * 512 + c];
#pragma unroll
        for (int r = 0; r < 8; ++r) { float y = bias;
#pragma unroll
            for (int j = 0; j < 31; ++j) y += w[j] * win[r + j];
            YB[(g8 * 8 + r) * 512 + c] = y; }
    }
    __syncthreads();
    {
        const float* lg = P.conf_ln_g + layer * 512 + 8 * lane; const float* lb = P.conf_ln_b + layer * 512 + 8 * lane;
        const f32x4 g0 = *(const f32x4*)lg, g1 = *(const f32x4*)(lg + 4), b0 = *(const f32x4*)lb, b1 = *(const f32x4*)(lb + 4);
#pragma unroll
        for (int q = 0; q < 2; ++q) { const int t = 2 * wave + q;
            f32x4 y0 = *(const LAS f32x4*)(YB + t * 512 + 8 * lane), y1 = *(const LAS f32x4*)(YB + t * 512 + 8 * lane + 4);
            const float mean = wave_sum((y0[0] + y0[1]) + (y0[2] + y0[3]) + (y1[0] + y1[1]) + (y1[2] + y1[3])) * (1.0f / 512.0f);
            y0 = y0 - mean; y1 = y1 - mean;
            const float rstd = rsqrtf(wave_sum(dot4(y0) + dot4(y1)) * (1.0f / 512.0f) + EPS);
            y0 = y0 * rstd * g0 + b0; y1 = y1 * rstd * g1 + b1;
            u32x4 o; o.x = cvt_pk_bf16(siluf_(y0[0]), siluf_(y0[1])); o.y = cvt_pk_bf16(siluf_(y0[2]), siluf_(y0[3])); o.z = cvt_pk_bf16(siluf_(y1[0]), siluf_(y1[1])); o.w = cvt_pk_bf16(siluf_(y1[2]), siluf_(y1[3]));
            *(u32x4*)((bf16_t*)(P.ws + WS_MIX) + (size_t)(r0 + t) * DM + 512 + 8 * lane) = o; }
    }
    __syncthreads();
}
__device__ __forceinline__ void sconv_item(const Params& P, int layer, int item, int tid) {
    const bf16_t* Z = (const bf16_t*)(P.ws + WS_Z);
    const int row = item * 16 + (tid >> 5);
    const int s0 = row < ML ? (row & ~(SEQ - 1)) : ML + ((row - ML) & ~(CTX - 1)), s1 = s0 + (row < ML ? SEQ : CTX);
#pragma unroll
    for (int q = 0; q < 2; ++q) {
        const int c0 = ((tid & 31) + 32 * q) * 8;
        float acc[8];
#pragma unroll
        for (int i = 0; i < 8; ++i) acc[i] = 0.f;
#pragma unroll
        for (int j = 0; j < 3; ++j) { const int rr = row + j - 1;
            if (rr >= s0 && rr < s1) { const u32x4 cg = *(const u32x4*)(Z + (size_t)rr * INWP + ZSC + c0), hh = *(const u32x4*)(Z + (size_t)rr * INWP + ZSH + c0);
                const float* wp = P.sc_dw + ((size_t)layer * 3 + j) * 512 + c0; const f32x4 w0 = *(const f32x4*)wp, w1 = *(const f32x4*)(wp + 4);
                const unsigned cw[4] = {cg.x, cg.y, cg.z, cg.w}, hw[4] = {hh.x, hh.y, hh.z, hh.w};
#pragma unroll
                for (int i = 0; i < 4; ++i) { const float wa = i < 2 ? w0[2 * i] : w1[2 * i - 4], wb = i < 2 ? w0[2 * i + 1] : w1[2 * i - 3];
                    acc[2 * i] += wa * bflo(cw[i]) * bflo(hw[i]); acc[2 * i + 1] += wb * bfhi(cw[i]) * bfhi(hw[i]); } } }
        const u32x4 bg = *(const u32x4*)(Z + (size_t)row * INWP + ZSB + c0); const unsigned bw[4] = {bg.x, bg.y, bg.z, bg.w};
        u32x4 o; unsigned ow[4];
#pragma unroll
        for (int i = 0; i < 4; ++i) ow[i] = cvt_pk_bf16(bflo(bw[i]) * acc[2 * i], bfhi(bw[i]) * acc[2 * i + 1]);
        o.x = ow[0]; o.y = ow[1]; o.z = ow[2]; o.w = ow[3];
        *(u32x4*)((bf16_t*)(P.ws + WS_MIX) + (size_t)row * DM + 1024 + c0) = o;
    }
}

namespace att {
constexpr int NW = 8, QBLK = 32, KVBLK = 64;
constexpr float SCALE = 0.07216878364870322f;
constexpr float THR = 8.f;
constexpr int SHM_V = KVBLK * 128 * 2, SHM_K = KVBLK * 192 * 2;
constexpr int OFF_K = 2 * SHM_V, OFF_WS = OFF_K + 2 * SHM_K, OFF_QR = OFF_WS + 2048;
#define KSWZ(row, colB) ((row) * 384 + ((colB) ^ ((((row) >> 1) & 7) << 4)))
#define SBAR() __builtin_amdgcn_sched_barrier(0)
__device__ __forceinline__ int crow(int r, int hi) { return (r & 3) + 8 * (r >> 2) + 4 * hi; }
__device__ __forceinline__ void partialSM(f32x16& p0, f32x16& p1, float& m_reg, float& mn, float& alpha) {
    constexpr float C = SCALE * 1.4426950408889634f;
    float pmax = p0[0];
#pragma unroll
    for (int r = 1; r < 16; ++r) pmax = fmaxf(pmax, p0[r]);
#pragma unroll
    for (int r = 0; r < 16; ++r) pmax = fmaxf(pmax, p1[r]);
    { auto rr = __builtin_amdgcn_permlane32_swap(__float_as_uint(pmax), __float_as_uint(pmax), false, false);
      pmax = fmaxf(__uint_as_float(rr[0]), __uint_as_float(rr[1])); }
    if (__builtin_expect(__all(pmax - m_reg <= THR / SCALE), 1)) { mn = m_reg; alpha = 1.f; }
    else { mn = fmaxf(m_reg, pmax); alpha = __builtin_amdgcn_exp2f((m_reg - mn) * C); m_reg = mn; }
    const float mnC = -mn * C;
#pragma unroll
    for (int r = 0; r < 16; ++r) p0[r] = fmaf(p0[r], C, mnC);
#pragma unroll
    for (int r = 0; r < 16; ++r) p1[r] = fmaf(p1[r], C, mnC);
#pragma unroll
    for (int r = 0; r < 16; ++r) p0[r] = __builtin_amdgcn_exp2f(p0[r]);
}
__device__ __forceinline__ void finishSM(f32x16& p0, f32x16& p1, float alpha, float& l_reg, bf16x8& pa0, bf16x8& pa1, bf16x8& pa2, bf16x8& pa3) {
#pragma unroll
    for (int r = 0; r < 16; ++r) p1[r] = __builtin_amdgcn_exp2f(p1[r]);
    float ps = 0;
#pragma unroll
    for (int r = 0; r < 16; ++r) ps += p0[r];
#pragma unroll
    for (int r = 0; r < 16; ++r) ps += p1[r];
    { auto rr = __builtin_amdgcn_permlane32_swap(__float_as_uint(ps), __float_as_uint(ps), false, false);
      ps = __uint_as_float(rr[0]) + __uint_as_float(rr[1]); }
    l_reg = l_reg * alpha + ps;
#define PK4(Pv, BASE, OUT) do { unsigned a0 = cvt_pk_bf16(Pv[BASE + 0], Pv[BASE + 1]), a1 = cvt_pk_bf16(Pv[BASE + 2], Pv[BASE + 3]);   \
    unsigned b0 = cvt_pk_bf16(Pv[BASE + 4], Pv[BASE + 5]), b1 = cvt_pk_bf16(Pv[BASE + 6], Pv[BASE + 7]);                              \
    auto r0 = __builtin_amdgcn_permlane32_swap(a0, b0, false, false); auto r1 = __builtin_amdgcn_permlane32_swap(a1, b1, false, false); \
    u32x4 w = {r0[0], r1[0], r0[1], r1[1]}; OUT = *reinterpret_cast<bf16x8*>(&w); } while (0)
    PK4(p0, 0, pa0); PK4(p0, 8, pa1); PK4(p1, 0, pa2); PK4(p1, 8, pa3);
#undef PK4
}
__device__ __forceinline__ void qkt(f32x16& p0, f32x16& p1, const LAS unsigned char* Ks, const bf16x8* qr, const LAS unsigned char* qrp, int qsw, const int (&kq)[4], int hi) {
    p0 = f32x16{}; p1 = f32x16{};
#pragma unroll
    for (int d0 = 0; d0 < 12; ++d0) {
        const bf16x8 b0 = *(const LAS bf16x8*)(Ks + kq[d0 & 3] + 128 * (d0 >> 2));
        const bf16x8 b1 = *(const LAS bf16x8*)(Ks + kq[d0 & 3] + 128 * (d0 >> 2) + 32 * 384);
        bf16x8 qv; if (d0 < 8) qv = qr[d0]; else qv = *(const LAS bf16x8*)(qrp + (((2 * (d0 - 8) + hi) ^ qsw) << 4));
        p0 = __builtin_amdgcn_mfma_f32_32x32x16_bf16(b0, qv, p0, 0, 0, 0);
        p1 = __builtin_amdgcn_mfma_f32_32x32x16_bf16(b1, qv, p1, 0, 0, 0); }
}
__device__ __forceinline__ int v_st(int k, int c) { const int kk = (k & ~0xC) | ((k & 4) << 1) | ((k & 8) >> 1); return ((kk >> 3) * 4 + (c >> 5)) * 512 + ((kk & 7) * 32 + (c & 31)) * 2; }
__device__ __forceinline__ int v_rd_base(int lane) { return ((lane & 3) << 3) | (((lane >> 2) & 3) << 6) | (((lane >> 4) & 1) << 5) | (((lane >> 5) & 1) << 8); }
constexpr int v_rd_off(int d0, int ks, int half) { return d0 * 512 + ks * 4096 + half * 2048; }
template <int OFF> __device__ __forceinline__ s16x4 tr_read(int vb) {
    s16x4 r; asm volatile("ds_read_b64_tr_b16 %0, %1 offset:%2" : "=&v"(r) : "v"(vb), "i"(OFF) : "memory"); return r;
}
template <int D0> __device__ __forceinline__ void pv_one(f32x16& od, int vb, bf16x8 pa0, bf16x8 pa1, bf16x8 pa2, bf16x8 pa3) {
    const s16x4 l0 = tr_read<v_rd_off(D0, 0, 0)>(vb), h0 = tr_read<v_rd_off(D0, 0, 1)>(vb), l1 = tr_read<v_rd_off(D0, 1, 0)>(vb), h1 = tr_read<v_rd_off(D0, 1, 1)>(vb);
    const s16x4 l2 = tr_read<v_rd_off(D0, 2, 0)>(vb), h2 = tr_read<v_rd_off(D0, 2, 1)>(vb), l3 = tr_read<v_rd_off(D0, 3, 0)>(vb), h3 = tr_read<v_rd_off(D0, 3, 1)>(vb);
    asm volatile("s_waitcnt lgkmcnt(0)" ::: "memory"); SBAR();
#define PK(Lo, Hi) (bf16x8){Lo[0], Lo[1], Lo[2], Lo[3], Hi[0], Hi[1], Hi[2], Hi[3]}
    od = __builtin_amdgcn_mfma_f32_32x32x16_bf16(pa0, PK(l0, h0), od, 0, 0, 0);
    od = __builtin_amdgcn_mfma_f32_32x32x16_bf16(pa1, PK(l1, h1), od, 0, 0, 0);
    od = __builtin_amdgcn_mfma_f32_32x32x16_bf16(pa2, PK(l2, h2), od, 0, 0, 0);
    od = __builtin_amdgcn_mfma_f32_32x32x16_bf16(pa3, PK(l3, h3), od, 0, 0, 0);
#undef PK
}
__device__ __forceinline__ void pv_d0(f32x16* o, int vb, bf16x8 pa0, bf16x8 pa1, bf16x8 pa2, bf16x8 pa3) {
    pv_one<0>(o[0], vb, pa0, pa1, pa2, pa3); pv_one<1>(o[1], vb, pa0, pa1, pa2, pa3); pv_one<2>(o[2], vb, pa0, pa1, pa2, pa3); pv_one<3>(o[3], vb, pa0, pa1, pa2, pa3);
}
template <bool DIRECT>
__device__ __forceinline__ void attn_unit(LAS unsigned char* lds, const bf16_t* QKV, const bf16_t* Z, int qrow0, int h, int crow0, int lrow0, int t0, int NT,
                                          float* Opart, float* Lse, bf16_t* MIX, const int tid) {
    const int wid = tid >> 6, lane = tid & 63, r32 = lane & 31, hi = lane >> 5;
    LAS unsigned char* V_lds = lds; LAS unsigned char* K_lds = lds + OFF_K;
    LAS float* ws = (LAS float*)(lds + OFF_WS) + wid * 64; LAS float* li_l = ws; LAS float* al_l = ws + 32;
    float m_reg = -1e30f, l_reg = 0; f32x16 o[4] = {}; bf16x8 qr[8];
    const bf16_t* Qw = QKV + (size_t)(qrow0 + wid * QBLK + r32) * NUP + h * 192 + hi * 8;
#pragma unroll
    for (int d0 = 0; d0 < 8; ++d0) qr[d0] = *(const bf16x8*)(Qw + d0 * 16);
    LAS unsigned char* qrp = lds + OFF_QR + wid * 4096 + r32 * 128; const int qsw = (r32 >> 1) & 7;
    int kq[4];
#pragma unroll
    for (int q = 0; q < 4; ++q) kq[q] = 384 * r32 + (((2 * q + hi) ^ qsw) << 4);
#pragma unroll
    for (int d0 = 8; d0 < 12; ++d0) *(LAS bf16x8*)(qrp + (((2 * (d0 - 8) + hi) ^ qsw) << 4)) = *(const bf16x8*)(Qw + d0 * 16);
    const int sr = tid >> 4, sc = (tid & 15) * 8;
    const int vst0 = v_st(sr, sc);
    const int kst0 = KSWZ(sr, sc * 2);
    const int krst = KSWZ(tid >> 3, 256 + (tid & 7) * 16);
    const unsigned voffV = (unsigned)(sr * NUP + sc) * 2u, voffR = (unsigned)((tid >> 3) * INWP + (tid & 7) * 8) * 2u;
    const char* Vb = (const char*)(QKV + 768 + h * 256 + 128); const char* Kb = (const char*)(QKV + 768 + h * 256); const char* Rb = (const char*)(Z + ZKR);
    const int vb0 = (int)(uintptr_t)V_lds + v_rd_base(lane);
    bf16x8 vs0, vs1, ks0, ks1, ks2;
#define ROW0(kt) (((t0) + (kt)) < 4 ? crow0 + 64 * ((t0) + (kt)) : lrow0 + 64 * ((t0) + (kt) - 4))
#define SLOADV(kt) do { const size_t _r0 = (size_t)__builtin_amdgcn_readfirstlane(ROW0(kt)); const char* _v = Vb + _r0 * (NUP * 2) + voffV; \
    vs0 = *(const bf16x8*)(_v); vs1 = *(const bf16x8*)(_v + 32 * NUP * 2); } while (0)
#define SLOADK(kt) do { const size_t _r0 = (size_t)__builtin_amdgcn_readfirstlane(ROW0(kt)); const char* _k = Kb + _r0 * (NUP * 2) + voffV; \
    ks0 = *(const bf16x8*)(_k); ks1 = *(const bf16x8*)(_k + 32 * NUP * 2); ks2 = *(const bf16x8*)(Rb + _r0 * (INWP * 2) + voffR); } while (0)
#define SLOAD(kt) do { SLOADV(kt); SLOADK(kt); } while (0)
#define SWRITE(b) do { *(LAS bf16x8*)(V_lds + (b) * SHM_V + vst0) = vs0; *(LAS bf16x8*)(V_lds + (b) * SHM_V + vst0 + 8192) = vs1; \
    *(LAS bf16x8*)(K_lds + (b) * SHM_K + kst0) = ks0; *(LAS bf16x8*)(K_lds + (b) * SHM_K + kst0 + 32 * 384) = ks1; *(LAS bf16x8*)(K_lds + (b) * SHM_K + krst) = ks2; } while (0)
#define SWAIT() asm volatile("s_waitcnt vmcnt(0)" ::: "memory")
#define RESC(a) do { if (__any((a) < 1.f)) { if (hi == 0) al_l[r32] = (a); asm volatile("s_waitcnt lgkmcnt(0)" ::: "memory"); \
    _Pragma("unroll") for (int d = 0; d < 4; ++d) _Pragma("unroll") for (int r = 0; r < 16; ++r) o[d][r] *= al_l[crow(r, hi)]; } } while (0)
    f32x16 pA0, pA1, pB0, pB1; float mnA, mnB, alA, alB; bf16x8 pa0, pa1, pa2, pa3;
    SLOAD(0); SWAIT(); SWRITE(0); __syncthreads();
    qkt(pA0, pA1, K_lds, qr, qrp, qsw, kq, hi); partialSM(pA0, pA1, m_reg, mnA, alA);
    SLOAD(1);
    SWAIT(); SWRITE(1); __syncthreads();
    for (int j = 1; j + 1 < NT; j += 2) {
        SBAR(); qkt(pB0, pB1, K_lds + SHM_K, qr, qrp, qsw, kq, hi);
        finishSM(pA0, pA1, alA, l_reg, pa0, pa1, pa2, pa3); SBAR();
        SLOADV(j + 1); SBAR();
        pv_d0(o, vb0, pa0, pa1, pa2, pa3); SBAR(); SLOADK(j + 1); SBAR(); partialSM(pB0, pB1, m_reg, mnB, alB);
        __syncthreads(); SWAIT(); SWRITE(0);
        RESC(alB); __syncthreads();
        SBAR(); qkt(pA0, pA1, K_lds, qr, qrp, qsw, kq, hi);
        finishSM(pB0, pB1, alB, l_reg, pa0, pa1, pa2, pa3); SBAR();
        SLOADV(j + 2); SBAR();
        pv_d0(o, vb0 + SHM_V, pa0, pa1, pa2, pa3); SBAR(); SLOADK(j + 2); SBAR(); partialSM(pA0, pA1, m_reg, mnA, alA);
        __syncthreads(); SWAIT(); SWRITE(1);
        RESC(alA); __syncthreads();
    }
    SBAR(); qkt(pB0, pB1, K_lds + SHM_K, qr, qrp, qsw, kq, hi);
    finishSM(pA0, pA1, alA, l_reg, pa0, pa1, pa2, pa3); SBAR();
    pv_d0(o, vb0, pa0, pa1, pa2, pa3); partialSM(pB0, pB1, m_reg, mnB, alB);
    __syncthreads(); RESC(alB);
    finishSM(pB0, pB1, alB, l_reg, pa0, pa1, pa2, pa3); SBAR();
    pv_d0(o, vb0 + SHM_V, pa0, pa1, pa2, pa3);
    if (hi == 0) li_l[r32] = l_reg; asm volatile("s_waitcnt lgkmcnt(0)" ::: "memory");
    float rli[16];
#pragma unroll
    for (int r = 0; r < 16; ++r) rli[r] = __builtin_amdgcn_rcpf(li_l[crow(r, hi)]);
    const int qw0 = qrow0 + wid * QBLK;
    if constexpr (DIRECT) {
#pragma unroll
        for (int r = 0; r < 16; ++r) { const int orow = crow(r, hi);
#pragma unroll
            for (int d0 = 0; d0 < 4; ++d0) MIX[(size_t)(qw0 + orow) * DM + 1536 + h * 128 + d0 * 32 + r32] = f2bf(o[d0][r] * rli[r]); }
    } else {
#pragma unroll
        for (int r = 0; r < 16; ++r) { const int orow = crow(r, hi);
#pragma unroll
            for (int d0 = 0; d0 < 4; ++d0) Opart[(size_t)(qw0 + orow) * 512 + h * 128 + d0 * 32 + r32] = o[d0][r] * rli[r]; }
        if (hi == 0) Lse[(size_t)(qw0 + r32) * 4 + h] = m_reg * (SCALE * 1.4426950408889634f) + __builtin_amdgcn_logf(l_reg);
    }
    __syncthreads();
#undef ROW0
#undef SLOAD
#undef SWRITE
#undef SWAIT
#undef RESC
}
#undef KSWZ
#undef SBAR
}

__device__ __forceinline__ void attn_combine(const Params& P, int tid, int G, int bid) {
    const float* OP = (const float*)(P.ws + WS_OP); const float* LS = (const float*)(P.ws + WS_LSE); bf16_t* MIX = (bf16_t*)(P.ws + WS_MIX);
    for (int i = bid * 512 + tid; i < ML * 64; i += G * 512) {
        const int row = i >> 6, rem = i & 63, h = rem >> 4, cg = (rem & 15) * 8;
        const float l1 = LS[(size_t)row * 4 + h], l2 = LS[((size_t)ML + row) * 4 + h], m = fmaxf(l1, l2);
        float w1 = __builtin_amdgcn_exp2f(l1 - m), w2 = __builtin_amdgcn_exp2f(l2 - m); const float inv = 1.0f / (w1 + w2); w1 *= inv; w2 *= inv;
        const float* a = OP + (size_t)row * 512 + h * 128 + cg; const float* b = OP + ((size_t)ML + row) * 512 + h * 128 + cg;
        const f32x4 a0 = *(const f32x4*)a, a1 = *(const f32x4*)(a + 4), b0 = *(const f32x4*)b, b1 = *(const f32x4*)(b + 4);
        const f32x4 o0 = a0 * w1 + b0 * w2, o1 = a1 * w1 + b1 * w2;
        u32x4 w; w.x = cvt_pk_bf16(o0[0], o0[1]); w.y = cvt_pk_bf16(o0[2], o0[3]); w.z = cvt_pk_bf16(o1[0], o1[1]); w.w = cvt_pk_bf16(o1[2], o1[3]);
        *(u32x4*)(MIX + (size_t)row * DM + 1536 + h * 128 + cg) = w;
    }
}

constexpr int PH_PER_LAYER = 9, N_PHASES = 2 + DEPTH * PH_PER_LAYER + 1;
typedef const __attribute__((address_space(4))) Params* KParams;
__global__ void __launch_bounds__(512, 2) mk_fwd(Params Pk) {
    extern __shared__ __attribute__((aligned(16))) unsigned char lds_raw[];
    LAS unsigned char* lds = (LAS unsigned char*)lds_raw;
    const int G = gridDim.x, bid = blockIdx.x;
    KParams kp0 = (KParams)__builtin_amdgcn_kernarg_segment_ptr();
    const int wave0 = __builtin_amdgcn_readfirstlane(threadIdx.x >> 6);
#define OPQ int tid; asm volatile("v_mbcnt_lo_u32_b32 %0, -1, 0\n\tv_mbcnt_hi_u32_b32 %0, -1, %0" : "=v"(tid)); tid |= wave0 << 6; const int lane = tid & 63, wave = __builtin_amdgcn_readfirstlane(tid >> 6); (void)lane; (void)wave; \
    KParams kp = kp0; asm volatile("" : "+s"(kp)); Params P; {   \
      const GAS float* const __attribute__((address_space(4)))* _q = (const GAS float* const __attribute__((address_space(4)))*)kp; const float** _d = (const float**)&P; \
      _Pragma("unroll") for (int _i = 0; _i < 28; ++_i) _d[_i] = (const float*)_q[_i]; P.ph_lo = kp->ph_lo; P.ph_hi = kp->ph_hi; } \
    unsigned char* const ws = P.ws; (void)ws;
    volatile LAS unsigned* MISC = (volatile LAS unsigned*)(lds + LDS_MISC);
    for (int u = threadIdx.x; u < 256; u += 512) ((LAS unsigned*)(lds + LDS_MISC))[u] = 0u;
    __syncthreads();
    const int lo = kp0->ph_lo, hi = kp0->ph_hi;
    XcdBarrier bar; bar.bar = (unsigned*)(kp0->ws + WS_CTL) + 1024; bar.x = 0; bar.st = nullptr;
    if (hi - lo > 1) bar = xcd_barrier_post((unsigned*)(kp0->ws + WS_CTL) + 1024, MISC + 8);
#define IN(k) (lo <= (k) && (k) < hi)
#define SEAM(k) do { if (IN(k) && IN((k) + 1)) xcd_barrier(bar); } while (0)
#define XRES ((float*)(ws + WS_XRES))
#define MODL ((const float*)(ws + WS_MODV) + (size_t)layer * 3 * 6 * DM)
#define RSTAT ((float*)(ws + WS_RSTAT) + (size_t)layer * MT * 2)
#define ROPE ((const f32x2*)(ws + WS_ROPE))
#define HB ((bf16_t*)(ws + WS_H))
#define ZB ((bf16_t*)(ws + WS_Z))
#define QKVB ((bf16_t*)(ws + WS_QKV))
#define MIXB ((bf16_t*)(ws + WS_MIX))
#define UB_ ((bf16_t*)(ws + WS_U))
#define SLAB ((float*)(ws + WS_GU))

    for (int rp = 0; rp < PREP(1); ++rp) { if (PHM(0) && IN(0)) { OPQ phase_p0a(P, lds, tid, lane, wave, G, bid); } if (rp + 1 < PREP(1)) { __syncthreads(); } } SEAM(0);
    if (PHM(1) && IN(1)) { OPQ phase_p0b(P, tid, G, bid); } SEAM(1);

    for (int layer = 0; layer < DEPTH; ++layer) {
        const int pb = 2 + layer * PH_PER_LAYER;
        const bool need_ctx = layer < DEPTH - 1;
        const int mrows = need_ctx ? MT : ML;

        for (int rp = 0; rp < PREP(3); ++rp) if (PHM(2) && IN(pb + 0)) { OPQ
            const float* xl = layer == 0 ? P.x : XRES; const float* xc = layer == 0 ? P.ctx : XRES + (size_t)ML * DM;
            phase_norm(lds, xl, xc, MODL, 1, 0, HB, true, SLAB, layer == 0 ? 0 : 11, MODL - (size_t)3 * 6 * DM + ((size_t)2 * 6 + 5) * DM, XRES + (size_t)ML * DM, tid, lane, wave, G, bid); } SEAM(pb + 0);
        for (int rp = 0; rp < PREP(5); ++rp) if (PHM(3) && IN(pb + 1)) { OPQ
            pg8::Gemm g{HB, (const bf16_t*)(ws + WS_WIN) + (size_t)layer * INWP * DM, MT, INWP, DM, DM, DM}; pg8::StaticOrder S; S.init(MT, INWP, G, bid);
            pg8::EpiIn E{ZB, rp == 0 ? RSTAT : (float*)(ws + WS_OP), ROPE};
            pg8::gemm_phase<pg8::EpiIn, pg8::StaticOrder>(lds, g, S, E, tid);
        } SEAM(pb + 1);
        for (int rp = 0; rp < PREP(2); ++rp) {
        for (int rq = 0; rq < PREP(8); ++rq) if (IN(pb + 2)) {
            { OPQ
            for (int r2 = 0; r2 < PREP(16); ++r2) if (PHM(4)) {
                pg8::Gemm g{ZB + ZCQ, (const bf16_t*)(ws + WS_WUP) + (size_t)layer * NUP * KUP, MT, NUP, KUP, INWP, KUP}; pg8::StaticOrder S; S.init(MT, NUP, G, bid);
                pg8::EpiUp E{QKVB, RSTAT, ROPE};
                pg8::gemm_phase<pg8::EpiUp, pg8::StaticOrder>(lds, g, S, E, tid);
            }
            constexpr int N_G1 = 2 * 4 * NCH, N_CF = MT / 16, N_SC = MT / 16;
            const int nup_units = (MT / 256) * (NUP / 256);
            int start = bid - (nup_units % G); if (start < 0) start += G;
#define FIRST_OF(base) ((base) + ((((start) - (base)) % G) + G) % G)
            for (int r2 = 0; r2 < PREP(11); ++r2) if (PHM(5)) for (int it = FIRST_OF(0); it < N_G1; it += G) gla_g1_item(lds, P, layer, it, tid, lane, wave);
            }
            { OPQ
            const int nup_units = (MT / 256) * (NUP / 256); constexpr int N_G1 = 2 * 4 * NCH, N_CF = MT / 16;
            int start = bid - (nup_units % G); if (start < 0) start += G;
            for (int r2 = 0; r2 < PREP(12); ++r2) if (PHM(6)) for (int it = FIRST_OF(N_G1); it < N_G1 + N_CF; it += G) conf_item(lds, P, layer, it - N_G1, tid, lane, wave);
            }
            { OPQ
            const int nup_units = (MT / 256) * (NUP / 256); constexpr int N_G1 = 2 * 4 * NCH, N_CF = MT / 16, N_SC = MT / 16;
            int start = bid - (nup_units % G); if (start < 0) start += G;
            for (int r2 = 0; r2 < PREP(17); ++r2) if (PHM(7)) for (int it = FIRST_OF(N_G1 + N_CF); it < N_G1 + N_CF + N_SC; it += G) sconv_item(P, layer, it - N_G1 - N_CF, tid);
#undef FIRST_OF
            }
        } SEAM(pb + 2);
        for (int rq = 0; rq < PREP(9); ++rq) if (IN(pb + 3)) { OPQ
            for (int r2 = 0; r2 < PREP(14); ++r2) if (PHM(8)) gla_g2(P, tid, G, bid);
            for (int r2 = 0; r2 < PREP(13); ++r2) if (PHM(9)) for (int u = bid; u < 256; u += G) {
                const int bh = u & 7, sub = u >> 3, b = bh >> 2, h = bh & 3, qb = sub >> 1, half = sub & 1;
                att::attn_unit<false>(lds, QKVB, ZB, b * SEQ + qb * 256, h, ML + b * CTX, b * SEQ, half * 34, 34,
                                      (float*)(ws + WS_OP) + (size_t)half * ML * 512, (float*)(ws + WS_LSE) + (size_t)half * ML * 4, MIXB, tid);
            }
        } SEAM(pb + 3);
        for (int rq = 0; rq < PREP(10); ++rq) if (IN(pb + 4)) { OPQ
            for (int r2 = 0; r2 < PREP(15); ++r2) if (PHM(10)) for (int it = bid; it < 2 * 4 * NCH; it += G) gla_g3_item(lds, P, layer, it, tid, lane, wave);
            for (int r2 = 0; r2 < PREP(18); ++r2) if (PHM(11)) attn_combine(P, tid, G, bid);
            if (PHM(12) && need_ctx) {
                int start = bid - ((2 * 4 * NCH) % G); if (start < 0) start += G;
                for (int u = start; u < 8; u += G) { const int b = u >> 2, h = u & 3;
                    att::attn_unit<true>(lds, QKVB, ZB, ML + b * CTX, h, ML + b * CTX, 0, 0, 4, nullptr, nullptr, MIXB, tid); }
            }
        } SEAM(pb + 4);
        }
        for (int rp = 0; rp < PREP(6); ++rp) if (PHM(13) && IN(pb + 5)) { OPQ
            const float* xl = layer == 0 ? P.x : XRES; const float* xc = layer == 0 ? P.ctx : XRES + (size_t)ML * DM;
            pg8::Gemm g{MIXB, (const bf16_t*)(ws + WS_WOUT) + (size_t)layer * DM * DM, ML, DM, DM, DM, DM}; pg8::StaticOrder S; S.init(ML, DM, G, bid);
            pg8::EpiRes E{xl, xc, rp == 0 ? XRES : (float*)(ws + WS_OP), MODL + 2 * DM};
            pg8::gemm_phase<pg8::EpiRes, pg8::StaticOrder>(lds, g, S, E, tid);
            if (need_ctx) {
                pg8::Gemm g2{MIXB + (size_t)ML * DM, (const bf16_t*)(ws + WS_WOUT) + (size_t)layer * DM * DM, MC, DM, 256, DM, DM}; pg8::SplitKOrder S2; S2.init(8, G, bid);
                pg8::EpiSlab E2{SLAB};
                pg8::gemm_phase<pg8::EpiSlab, pg8::SplitKOrder>(lds, g2, S2, E2, tid);
            }
        } SEAM(pb + 5);
        for (int rp = 0; rp < PREP(3); ++rp) if (PHM(2) && IN(pb + 6)) { OPQ
            const float* xc = layer == 0 ? P.ctx : XRES + (size_t)ML * DM;
            phase_norm(lds, XRES, xc, MODL, 4, 3, HB, need_ctx, SLAB, 8, MODL + ((size_t)2 * 6 + 2) * DM, XRES + (size_t)ML * DM, tid, lane, wave, G, bid); } SEAM(pb + 6);
        for (int rp = 0; rp < PREP(4); ++rp) if (PHM(14) && IN(pb + 7)) { OPQ
            pg8::Gemm g{HB, (const bf16_t*)(ws + WS_W13) + (size_t)layer * 2 * DFF * DM, mrows, 2 * DFF, DM, DM, DM}; pg8::StaticOrder S; S.init(mrows, 2 * DFF, G, bid);
            pg8::EpiSwiglu E{UB_};
            pg8::gemm_phase<pg8::EpiSwiglu, pg8::StaticOrder>(lds, g, S, E, tid);
        } SEAM(pb + 7);
        for (int rp = 0; rp < PREP(7); ++rp) if (PHM(15) && IN(pb + 8)) { OPQ
            pg8::Gemm g{UB_, (const bf16_t*)(ws + WS_W2) + (size_t)layer * DM * DFF, ML, DM, DFF, DFF, DFF}; pg8::StaticOrder S; S.init(ML, DM, G, bid);
            pg8::EpiRes E{XRES, XRES + (size_t)ML * DM, rp == 0 ? XRES : (float*)(ws + WS_OP), MODL + 5 * DM};
            pg8::gemm_phase<pg8::EpiRes, pg8::StaticOrder>(lds, g, S, E, tid);
            if (need_ctx) {
                pg8::Gemm g2{UB_ + (size_t)ML * DFF, (const bf16_t*)(ws + WS_W2) + (size_t)layer * DM * DFF, MC, DM, 512, DFF, DFF}; pg8::SplitKOrder S2; S2.init(11, G, bid);
                pg8::EpiSlab E2{SLAB};
                pg8::gemm_phase<pg8::EpiSlab, pg8::SplitKOrder>(lds, g2, S2, E2, tid);
            }
        } SEAM(pb + 8);
    }
    if (PHM(16) && IN(N_PHASES - 1)) { OPQ phase_final(XRES, P.final_g, P.out, lane, wave, G, bid); }
#undef IN
#undef SEAM
}

extern "C" void kernel_launch(void* const* d_in, const int* in_sizes, int n_in, void* d_out, int out_size, void* d_ws, size_t ws_size, hipStream_t stream) {
    static int grid = 0;
    if (grid == 0) {
        if (n_in != 26 || in_sizes[0] != ML * DM || out_size != ML * DM || ws_size < WS_END) {
            fprintf(stderr, "kernel_launch: shape mismatch: n_in %d in0 %d out %d ws %zu (need %zu); nothing launched\n", n_in, n_in > 0 ? in_sizes[0] : -1, out_size, ws_size, (size_t)WS_END); grid = -1; return; }
        int dev = 0, cus = 0, per_cu = 0;
        if (hipGetDevice(&dev) != hipSuccess || hipDeviceGetAttribute(&cus, hipDeviceAttributeMultiprocessorCount, dev) != hipSuccess) { fprintf(stderr, "kernel_launch: device query failed\n"); grid = -1; return; }
        if (hipFuncSetAttribute((const void*)mk_fwd, hipFuncAttributeMaxDynamicSharedMemorySize, LDS_BYTES) != hipSuccess) { fprintf(stderr, "kernel_launch: hipFuncSetAttribute failed\n"); grid = -1; return; }
        if (hipOccupancyMaxActiveBlocksPerMultiprocessor(&per_cu, (const void*)mk_fwd, 512, LDS_BYTES) != hipSuccess || per_cu < 1)
            fprintf(stderr, "kernel_launch: note: occupancy query reports %d workgroups per CU\n", per_cu);
        (void)hipGetLastError();
        grid = cus;
    }
    if (grid < 0) return;
    if (hipMemsetAsync((char*)d_ws + WS_CTL, 0, CTL_BYTES, stream) != hipSuccess) { fprintf(stderr, "kernel_launch: memset failed\n"); return; }
    Params p{};
    const float** pp = (const float**)&p;
    for (int i = 0; i < 26; ++i) pp[i] = (const float*)d_in[i];
    p.out = (float*)d_out; p.ws = (unsigned char*)d_ws;
#if MK_MULTI
    for (int ph = 0; ph < N_PHASES; ++ph) { p.ph_lo = ph; p.ph_hi = ph + 1; hipLaunchKernelGGL(mk_fwd, dim3(grid), dim3(512), LDS_BYTES, stream, p); }
#else
    p.ph_lo = 0; p.ph_hi = N_PHASES;
    hipLaunchKernelGGL(mk_fwd, dim3(grid), dim3(512), LDS_BYTES, stream, p);
#endif
    const hipError_t le = hipPeekAtLastError();
    if (le != hipSuccess) fprintf(stderr, "kernel_launch: launch failed: %s\n", hipGetErrorName(le));
}
```

```cpp
#include <hip/hip_runtime.h>
#include <cstdio>
#include <cstdint>

#ifndef MK_MULTI
#define MK_MULTI 0
#endif

#ifndef PH_MASK
#define PH_MASK 0xFFFFFFFFu
#endif
#define PHM(b) ((PH_MASK >> (b)) & 1u)
#ifndef PROBE_ID
#define PROBE_ID 0
#endif
#define PREP(id) (PROBE_ID == (id) ? 2 : 1)
#define LAS __attribute__((address_space(3)))
#define GAS __attribute__((address_space(1)))
typedef unsigned short bf16_t;
typedef short bf16x8 __attribute__((ext_vector_type(8)));
typedef short s16x4 __attribute__((ext_vector_type(4)));
typedef float f32x4 __attribute__((ext_vector_type(4)));
typedef float f32x2 __attribute__((ext_vector_type(2)));
typedef float f32x16 __attribute__((ext_vector_type(16)));
typedef unsigned u32x4 __attribute__((ext_vector_type(4)));
typedef unsigned u32x2 __attribute__((ext_vector_type(2)));

constexpr int DM = 2048, NB = 2, SEQ = 4096, CTX = 256, DEPTH = 4, DFF = 5632;
constexpr int ML = NB * SEQ, MC = NB * CTX, MT = ML + MC;
constexpr int INW = 5216, INWP = 5376;
constexpr int ZQ = 0, ZK = 512, ZV = 1024, ZG = 1536, ZLR = 2048, ZCA = 2080, ZCG = 2592, ZSB = 3104, ZSC = 3616, ZSH = 4128, ZCQ = 4640, ZCKV = 5024, ZKR = 5152;
constexpr int NUP = 1792, KUP = 512;
constexpr int NCH = 68;
constexpr float EPS = 1e-6f;

constexpr size_t al256(size_t x) { return (x + 255) / 256 * 256; }
constexpr size_t WS_CTL = 0, CTL_BYTES = 1u << 20;
constexpr size_t WS_ROPE = WS_CTL + CTL_BYTES;
constexpr size_t WS_MODP = WS_ROPE + 8192;
constexpr size_t WS_MODV = WS_MODP + al256((size_t)8 * 4 * 3 * 12288 * 4);
constexpr size_t WS_RSTAT = WS_MODV + al256((size_t)4 * 3 * 6 * 2048 * 4);
constexpr size_t WS_WIN = WS_RSTAT + al256((size_t)4 * MT * 2 * 4);
constexpr size_t WS_WOUT = WS_WIN + (size_t)4 * INWP * DM * 2;
constexpr size_t WS_W13 = WS_WOUT + (size_t)4 * DM * DM * 2;
constexpr size_t WS_W2 = WS_W13 + (size_t)4 * 2 * DFF * DM * 2;
constexpr size_t WS_WUP = WS_W2 + (size_t)4 * DM * DFF * 2;
constexpr size_t WS_XRES = WS_WUP + (size_t)4 * NUP * KUP * 2;
constexpr size_t WS_H = WS_XRES + (size_t)MT * DM * 4;
constexpr size_t WS_Z = WS_H + (size_t)MT * DM * 2;
constexpr size_t WS_QKV = WS_Z + (size_t)MT * INWP * 2;
constexpr size_t WS_MIX = WS_QKV + (size_t)MT * NUP * 2;
constexpr size_t WS_U = WS_MIX + (size_t)MT * DM * 2;
constexpr size_t WS_GU = WS_U + (size_t)MT * DFF * 2;
constexpr size_t WS_GD = WS_GU + (size_t)16 * NCH * 16384 * 4;
constexpr size_t WS_GS = WS_GD + (size_t)16 * NCH * 128 * 4;
constexpr size_t WS_OP = WS_GS + (size_t)16 * NCH * 16384 * 2;
constexpr size_t WS_LSE = WS_OP + (size_t)2 * ML * 512 * 4;
constexpr size_t WS_END = WS_LSE + (size_t)2 * ML * 4 * 4;

constexpr int LDS_MAIN = 131072, LDS_MISC = LDS_MAIN, LDS_BYTES = LDS_MAIN + 1024;

__device__ __forceinline__ unsigned cvt_pk_bf16(float lo, float hi) { unsigned r; asm volatile("v_cvt_pk_bf16_f32 %0, %1, %2" : "=v"(r) : "v"(lo), "v"(hi)); return r; }
__device__ __forceinline__ float bf2f(unsigned short b) { return __uint_as_float(((unsigned)b) << 16); }
__device__ __forceinline__ float bflo(unsigned w) { return __uint_as_float(w << 16); }
__device__ __forceinline__ float bfhi(unsigned w) { return __uint_as_float(w & 0xffff0000u); }
__device__ __forceinline__ unsigned short f2bf(float f) { return (unsigned short)(cvt_pk_bf16(f, 0.f) & 0xffffu); }
__device__ __forceinline__ float wave_sum(float v) {
#pragma unroll
    for (int o = 1; o < 64; o <<= 1) v += __shfl_xor(v, o);
    return v;
}
__device__ __forceinline__ float sigmoidf_(float x) { return __builtin_amdgcn_rcpf(1.0f + __builtin_amdgcn_exp2f(-1.4426950408889634f * x)); }
__device__ __forceinline__ float siluf_(float x) { return x * __builtin_amdgcn_rcpf(1.0f + __builtin_amdgcn_exp2f(-1.4426950408889634f * x)); }
__device__ __forceinline__ float dot4(const f32x4& v) { return (v[0] * v[0] + v[1] * v[1]) + (v[2] * v[2] + v[3] * v[3]); }
#define LDS_WAIT() asm volatile("s_waitcnt lgkmcnt(0)" ::: "memory")
#define VM_WAIT() asm volatile("s_waitcnt vmcnt(0)" ::: "memory")

namespace pg8 {
#define PG8_LAS __attribute__((address_space(3)))
constexpr int BM = 256, BK = 64, HALF = 128, HTB = HALF * BK * 2, STAGE_BYTES = 8 * HTB, NXCD = 8, WGM = 8;
__host__ __device__ __forceinline__ int lds_byte(int r, int c) { const int st = (r >> 4) * 2 + (c >> 5), rr = r & 15, cc = c & 31, ob = rr * 64 + cc * 2; return st * 1024 + (ob ^ (((ob >> 9) & 1) << 5)); }
__host__ __device__ __forceinline__ void stage_rc(int b, int& R, int& C) { const int st = b / 1024, sb = b % 1024, swz = sb ^ (((sb >> 9) & 1) << 5); R = (st >> 1) * 16 + swz / 64; C = (st & 1) * 32 + (swz % 64) / 2; }
__host__ __device__ __forceinline__ int perm32(int rho) { const int n = rho >> 4, i = rho & 15; return 8 * (i >> 2) + 4 * n + (i & 3); }
struct Unit { int pm, pn, ks; };
struct Gemm { const bf16_t* A; const bf16_t* Bt; int M, N, K, lda, ldb; };
struct StaticOrder {
    int nM, nN, nwg, G, c;
    __host__ __device__ void init(int M, int N, int G_, int c_) { nM = M / BM; nN = N / BM; nwg = nM * nN; G = G_; c = c_; }
    __host__ __device__ bool next(int i, Unit& u) const {
        const long L = (long)i * G + c; if (L >= nwg) return false;
        int wgid = (int)L; { const int q = nwg / NXCD, r = nwg % NXCD, xcd = wgid % NXCD, off = wgid / NXCD; wgid = (xcd < r ? xcd * (q + 1) : r * (q + 1) + (xcd - r) * q) + off; }
        const int nig = WGM * nN, gid = wgid / nig, fm = gid * WGM, gsz = (nM - fm) < WGM ? (nM - fm) : WGM;
        u.pm = fm + ((wgid % nig) % gsz); u.pn = (wgid % nig) / gsz; u.ks = 0; return true;
    }
    __device__ __forceinline__ void a_ready(const Unit&) const {}
    __device__ __forceinline__ void done(const Unit&) const {}
};
template <class Epi, class Sched, bool ALIGN_EPI = true, bool SP2 = true>
__device__ __forceinline__ void gemm_phase(PG8_LAS unsigned char* lds, const Gemm g, const Sched& S, const Epi& E, const int tid) {
    const int wid = __builtin_amdgcn_readfirstlane(tid >> 6), lane = tid & 63, wr = wid >> 2, wc = wid & 3, fr = lane & 15, fq = lane >> 4;
    const int K = g.K, nt = K / BK;
    unsigned voffA[2], voffB[2];
#pragma unroll
    for (int i = 0; i < 2; ++i) { int R, C; stage_rc(tid * 16 + i * 8192, R, C); const int Rb = Epi::PERM ? ((R & ~31) + perm32(R & 31)) : R;
        voffA[i] = (unsigned)(R * g.lda + C) * 2u; voffB[i] = (unsigned)(Rb * g.ldb + C) * 2u; }
    const size_t kstep = (size_t)(BK * 2);
    const size_t hstepA = (size_t)HALF * g.lda * 2, hstepB = (size_t)HALF * g.ldb * 2;
    const size_t tstepA = 2 * hstepA, tstepB = 2 * hstepB;
    const unsigned ldsw = (unsigned)wid * 1024u;
    const int aoff = lds_byte(wr * 64 + fr, fq * 8), boff = lds_byte(wc * 32 + fr, fq * 8);
#define PG8_SA(b, h) (((b) * 2 + (h)) * HTB)
#define PG8_SB(b, h) ((4 + (b) * 2 + (h)) * HTB)
#define PG8_STAGE(bufoff, gbase, voff) do { _Pragma("unroll") for (int _i = 0; _i < 2; ++_i) \
        __builtin_amdgcn_global_load_lds((const unsigned*)((const char*)(gbase) + (voff)[_i]), (PG8_LAS unsigned*)(lds + (bufoff) + ldsw + _i * 8192), 16, 0, 0); } while (0)
#define PG8_LDA(dst, b, h) do { _Pragma("unroll") for (int m = 0; m < 4; ++m) _Pragma("unroll") for (int k = 0; k < 2; ++k) dst[m][k] = *(const PG8_LAS bf16x8*)(lds + PG8_SA(b, h) + aoff + m * 2048 + k * 1024); } while (0)
#define PG8_LDB(dst, b, h) do { _Pragma("unroll") for (int n = 0; n < 2; ++n) _Pragma("unroll") for (int k = 0; k < 2; ++k) dst[n][k] = *(const PG8_LAS bf16x8*)(lds + PG8_SB(b, h) + boff + n * 2048 + k * 1024); } while (0)
#define PG8_MMA(ai, bj, At, Bt) do { __builtin_amdgcn_s_setprio(1); _Pragma("unroll") for (int m = 0; m < 4; ++m) _Pragma("unroll") for (int n = 0; n < 2; ++n) _Pragma("unroll") for (int k = 0; k < 2; ++k) \
        acc[ai][bj][m][n] = __builtin_amdgcn_mfma_f32_16x16x32_bf16(Bt[n][k], At[m][k], acc[ai][bj][m][n], 0, 0, 0); __builtin_amdgcn_s_setprio(0); } while (0)
#define PG8_WAIT_V(n) asm volatile("s_waitcnt vmcnt(" #n ")" ::: "memory")
#define PG8_WAIT_L(n) asm volatile("s_waitcnt lgkmcnt(" #n ")" ::: "memory")
#define PG8_BAR __builtin_amdgcn_s_barrier()
#define PG8_SCHED __builtin_amdgcn_sched_barrier(0)
    Unit cur, nxt; int ui = 0;
    if (!S.next(0, cur)) return;
    f32x4 acc[2][2][4][2];
#pragma unroll
    for (int a = 0; a < 2; ++a)
#pragma unroll
        for (int b = 0; b < 2; ++b)
#pragma unroll
            for (int m = 0; m < 4; ++m)
#pragma unroll
                for (int n = 0; n < 2; ++n) acc[a][b][m][n] = (f32x4){0.f, 0.f, 0.f, 0.f};
    bf16x8 At[4][2], B0[2][2], B1[2][2];
    const size_t kspan = (size_t)K * 2;
    const char* cA = (const char*)g.A + (size_t)cur.pm * tstepA + (size_t)cur.ks * kspan; const char* cB = (const char*)g.Bt + (size_t)cur.pn * tstepB + (size_t)cur.ks * kspan;
    S.a_ready(cur);
    if constexpr (SP2) {
        PG8_STAGE(PG8_SB(0, 0), cB, voffB); PG8_STAGE(PG8_SB(0, 1), cB + hstepB, voffB); PG8_STAGE(PG8_SA(0, 0), cA, voffA); PG8_STAGE(PG8_SA(0, 1), cA + hstepA, voffA);
        if (wr == 1) PG8_BAR;
        PG8_WAIT_V(2); PG8_BAR;
        PG8_STAGE(PG8_SB(1, 0), cB + kstep, voffB); PG8_STAGE(PG8_SA(1, 0), cA + kstep, voffA); PG8_STAGE(PG8_SB(1, 1), cB + hstepB + kstep, voffB);
        PG8_WAIT_V(6); PG8_BAR;
    } else {
        PG8_STAGE(PG8_SB(0, 0), cB, voffB); PG8_STAGE(PG8_SA(0, 0), cA, voffA); PG8_STAGE(PG8_SB(0, 1), cB + hstepB, voffB); PG8_STAGE(PG8_SA(0, 1), cA + hstepA, voffA);
        if (wr == 1) PG8_BAR;
        PG8_WAIT_V(4); PG8_BAR;
        PG8_STAGE(PG8_SB(1, 0), cB + kstep, voffB); PG8_STAGE(PG8_SA(1, 0), cA + kstep, voffA); PG8_STAGE(PG8_SB(1, 1), cB + hstepB + kstep, voffB);
        PG8_WAIT_V(6); PG8_BAR;
    }
    for (;;) {
        const bool has_next = S.next(ui + 1, nxt);
        const char* nA = has_next ? (const char*)g.A + (size_t)nxt.pm * tstepA + (size_t)nxt.ks * kspan : cA; const char* nB = has_next ? (const char*)g.Bt + (size_t)nxt.pn * tstepB + (size_t)nxt.ks * kspan : cB;
        for (int t = 0; t < nt; t += 2) {
            const bool last = (t == nt - 2);
            const char* a1 = cA + (size_t)(t + 1) * kstep;
            const char* a2 = last ? nA : cA + (size_t)(t + 2) * kstep; const char* b2 = last ? nB : cB + (size_t)(t + 2) * kstep;
            const char* a3 = a2 + kstep; const char* b3 = b2 + kstep;
            if (last && has_next) S.a_ready(nxt);
            if constexpr (SP2) {
            PG8_LDB(B0, 0, 0); PG8_LDB(B1, 0, 1); PG8_SCHED; PG8_LDA(At, 0, 0); PG8_STAGE(PG8_SA(1, 1), a1 + hstepA, voffA);
            PG8_WAIT_V(8); PG8_WAIT_L(0); PG8_BAR; PG8_MMA(0, 0, At, B0); PG8_MMA(0, 1, At, B1); PG8_BAR; PG8_SCHED;
            PG8_LDA(At, 0, 1); PG8_STAGE(PG8_SB(0, 0), b2, voffB); PG8_STAGE(PG8_SB(0, 1), b2 + hstepB, voffB); PG8_STAGE(PG8_SA(0, 0), a2, voffA);
            PG8_WAIT_V(8); PG8_WAIT_L(0); PG8_BAR; PG8_MMA(1, 0, At, B0); PG8_MMA(1, 1, At, B1); PG8_BAR; PG8_SCHED;
            PG8_LDB(B0, 1, 0); PG8_LDB(B1, 1, 1); PG8_SCHED; PG8_LDA(At, 1, 0); PG8_STAGE(PG8_SA(0, 1), a2 + hstepA, voffA);
            PG8_WAIT_V(8); PG8_WAIT_L(0); PG8_BAR; PG8_MMA(0, 0, At, B0); PG8_MMA(0, 1, At, B1); PG8_BAR; PG8_SCHED;
            PG8_LDA(At, 1, 1); PG8_STAGE(PG8_SB(1, 0), b3, voffB); PG8_STAGE(PG8_SB(1, 1), b3 + hstepB, voffB); PG8_STAGE(PG8_SA(1, 0), a3, voffA);
            PG8_WAIT_V(8); PG8_WAIT_L(0); PG8_BAR; PG8_MMA(1, 0, At, B0); PG8_MMA(1, 1, At, B1); PG8_BAR; PG8_SCHED;
            } else {
            PG8_LDB(B0, 0, 0); PG8_SCHED; PG8_LDA(At, 0, 0); PG8_STAGE(PG8_SA(1, 1), a1 + hstepA, voffA);
            PG8_WAIT_L(8); PG8_BAR; PG8_WAIT_L(0); PG8_MMA(0, 0, At, B0); PG8_BAR; PG8_SCHED;
            PG8_LDB(B1, 0, 1); PG8_STAGE(PG8_SB(0, 0), b2, voffB);
            PG8_BAR; PG8_WAIT_L(0); PG8_MMA(0, 1, At, B1); PG8_BAR;
            PG8_LDA(At, 0, 1); PG8_STAGE(PG8_SA(0, 0), a2, voffA);
            PG8_BAR; PG8_WAIT_L(0); PG8_MMA(1, 0, At, B0); PG8_BAR; PG8_SCHED;
            PG8_STAGE(PG8_SB(0, 1), b2 + hstepB, voffB);
            PG8_WAIT_V(6); PG8_BAR; PG8_MMA(1, 1, At, B1); PG8_BAR;
            PG8_LDB(B0, 1, 0); PG8_SCHED; PG8_LDA(At, 1, 0); PG8_STAGE(PG8_SA(0, 1), a2 + hstepA, voffA);
            PG8_WAIT_L(8); PG8_BAR; PG8_WAIT_L(0); PG8_MMA(0, 0, At, B0); PG8_BAR; PG8_SCHED;
            PG8_LDB(B1, 1, 1); PG8_STAGE(PG8_SB(1, 0), b3, voffB);
            PG8_BAR; PG8_WAIT_L(0); PG8_MMA(0, 1, At, B1); PG8_BAR;
            PG8_LDA(At, 1, 1); PG8_STAGE(PG8_SA(1, 0), a3, voffA);
            PG8_BAR; PG8_WAIT_L(0); PG8_MMA(1, 0, At, B0); PG8_BAR; PG8_SCHED;
            PG8_STAGE(PG8_SB(1, 1), b3 + hstepB, voffB);
            PG8_WAIT_V(6); PG8_BAR; PG8_MMA(1, 1, At, B1); PG8_BAR;
            }
        }
        if constexpr (ALIGN_EPI) { if (wr == 0) PG8_BAR; }
        E(acc, cur, wr, wc, fr, fq);
        if (!has_next) break;
#pragma unroll
        for (int a = 0; a < 2; ++a)
#pragma unroll
            for (int b = 0; b < 2; ++b)
#pragma unroll
                for (int m = 0; m < 4; ++m)
#pragma unroll
                    for (int n = 0; n < 2; ++n) acc[a][b][m][n] = (f32x4){0.f, 0.f, 0.f, 0.f};
        cur = nxt; cA = nA; cB = nB; ++ui;
        if constexpr (ALIGN_EPI) { if (wr == 1) PG8_BAR; }
    }
    PG8_WAIT_V(0);
    if constexpr (!ALIGN_EPI) { if (wr == 0) PG8_BAR; }
    PG8_BAR;
#undef PG8_SA
#undef PG8_SB
#undef PG8_STAGE
#undef PG8_LDA
#undef PG8_LDB
#undef PG8_MMA
#undef PG8_WAIT_V
#undef PG8_WAIT_L
#undef PG8_BAR
#undef PG8_SCHED
}

struct SplitKOrder {
    int nunits, G, c;
    __host__ __device__ void init(int nsplit, int G_, int c_) { nunits = 16 * nsplit; G = G_; c = c_; }
    __host__ __device__ bool next(int i, Unit& u) const { const int L = i * G + c; if (L >= nunits) return false; u.pm = L & 1; const int rest = L >> 1; u.pn = rest & 7; u.ks = rest >> 3; return true; }
    __device__ __forceinline__ void a_ready(const Unit&) const {}
    __device__ __forceinline__ void done(const Unit&) const {}
};
__device__ __forceinline__ void rope8(f32x4& v0, f32x4& v1, const f32x2* cs) {
    const f32x2 c0 = cs[0], c1 = cs[1], c2 = cs[2], c3 = cs[3];
    float a, b;
    a = v0[0]; b = v0[1]; v0[0] = a * c0.x - b * c0.y; v0[1] = b * c0.x + a * c0.y;
    a = v0[2]; b = v0[3]; v0[2] = a * c1.x - b * c1.y; v0[3] = b * c1.x + a * c1.y;
    a = v1[0]; b = v1[1]; v1[0] = a * c2.x - b * c2.y; v1[1] = b * c2.x + a * c2.y;
    a = v1[2]; b = v1[3]; v1[2] = a * c3.x - b * c3.y; v1[3] = b * c3.x + a * c3.y;
}

struct EpiIn {
    static constexpr bool PERM = true;
    bf16_t* Z; float* rstat; const f32x2* rope;
    __device__ __forceinline__ void operator()(const f32x4 (&acc)[2][2][4][2], const Unit& u, int wr, int wc, int fr, int fq) const {
        const int row0 = u.pm * BM + wr * 64 + fr; const int colw0 = u.pn * BM + wc * 32;
        const bool special = (u.pn >= 18);
#pragma unroll
        for (int ai = 0; ai < 2; ++ai)
#pragma unroll
            for (int m = 0; m < 4; ++m) {
                const int row = row0 + ai * HALF + m * 16;
                bf16_t* rowp = Z + (size_t)row * INWP + colw0 + 8 * fq;
                float sq = 0.f, skv = 0.f;
#pragma unroll
                for (int bj = 0; bj < 2; ++bj) {
                    f32x4 v0 = acc[ai][bj][m][0], v1 = acc[ai][bj][m][1];
                    if (special) {
                        const int colw = colw0 + bj * HALF;
                        if (colw >= ZCQ && colw < ZCKV) sq += dot4(v0) + dot4(v1);
                        else if (colw >= ZCKV && colw < ZKR) skv += dot4(v0) + dot4(v1);
                        else if (colw >= ZKR && colw < INW && u.pm < 32) {
                            const int axis = (colw - ZKR) >> 5, t = row & (SEQ - 1), pos = axis ? (t & 63) : (t >> 6);
                            rope8(v0, v1, rope + pos * 16 + 4 * fq);
                        }
                    }
                    u32x4 w; w.x = cvt_pk_bf16(v0[0], v0[1]); w.y = cvt_pk_bf16(v0[2], v0[3]); w.z = cvt_pk_bf16(v1[0], v1[1]); w.w = cvt_pk_bf16(v1[2], v1[3]);
                    *(u32x4*)(rowp + bj * HALF) = w;
                }
                if (special) {
                    sq += __shfl_xor(sq, 16); sq += __shfl_xor(sq, 32); skv += __shfl_xor(skv, 16); skv += __shfl_xor(skv, 32);
                    if (fq == 0) { if (sq != 0.f) atomicAdd(rstat + (size_t)row * 2, sq); if (skv != 0.f) atomicAdd(rstat + (size_t)row * 2 + 1, skv); }
                }
            }
    }
};
struct EpiUp {
    static constexpr bool PERM = true;
    bf16_t* O; const float* rstat; const f32x2* rope;
    __device__ __forceinline__ void operator()(const f32x4 (&acc)[2][2][4][2], const Unit& u, int wr, int wc, int fr, int fq) const {
        const int row0 = u.pm * BM + wr * 64 + fr; const int colw0 = u.pn * BM + wc * 32;
#pragma unroll
        for (int ai = 0; ai < 2; ++ai)
#pragma unroll
            for (int m = 0; m < 4; ++m) {
                const int row = row0 + ai * HALF + m * 16;
                const f32x2 ss = *(const f32x2*)(rstat + (size_t)row * 2);
                const float rq = rsqrtf(ss.x * (1.0f / 384.0f) + EPS), rkv = rsqrtf(ss.y * (1.0f / 128.0f) + EPS);
                bf16_t* rowp = O + (size_t)row * NUP + colw0 + 8 * fq;
#pragma unroll
                for (int bj = 0; bj < 2; ++bj) {
                    const int colw = colw0 + bj * HALF;
                    const float sc = colw < 768 ? rq : rkv;
                    f32x4 v0 = acc[ai][bj][m][0] * sc, v1 = acc[ai][bj][m][1] * sc;
                    if (colw < 768 && u.pm < 32) {
                        const int within = colw % 192;
                        if (within >= 128) { const int axis = (within - 128) >> 5, t = row & (SEQ - 1), pos = axis ? (t & 63) : (t >> 6); rope8(v0, v1, rope + pos * 16 + 4 * fq); }
                    }
                    u32x4 w; w.x = cvt_pk_bf16(v0[0], v0[1]); w.y = cvt_pk_bf16(v0[2], v0[3]); w.z = cvt_pk_bf16(v1[0], v1[1]); w.w = cvt_pk_bf16(v1[2], v1[3]);
                    *(u32x4*)(rowp + bj * HALF) = w;
                }
            }
    }
};
struct EpiRes {
    static constexpr bool PERM = false;
    const float* base_lat; const float* base_ctx; float* out; const float* gate;
    __device__ __forceinline__ void operator()(const f32x4 (&acc)[2][2][4][2], const Unit& u, int wr, int wc, int fr, int fq) const {
        const int row0 = u.pm * BM + wr * 64 + fr, col0 = u.pn * BM + wc * 32 + 4 * fq;
        const int r = u.pm < 16 ? 0 : (u.pm < 32 ? 1 : 2);
        const float* gp = gate + (size_t)r * 6 * DM + col0;
        f32x4 gv[2][2];
#pragma unroll
        for (int bj = 0; bj < 2; ++bj)
#pragma unroll
            for (int n = 0; n < 2; ++n) gv[bj][n] = *(const f32x4*)(gp + bj * HALF + n * 16);
#pragma unroll
        for (int ai = 0; ai < 2; ++ai)
#pragma unroll
            for (int m = 0; m < 4; ++m) {
                const int row = row0 + ai * HALF + m * 16;
                const float* bp = (u.pm < 32 ? base_lat + (size_t)row * DM : base_ctx + (size_t)(row - ML) * DM) + col0;
                float* op = out + (size_t)row * DM + col0;
#pragma unroll
                for (int bj = 0; bj < 2; ++bj)
#pragma unroll
                    for (int n = 0; n < 2; ++n) { const f32x4 b = *(const f32x4*)(bp + bj * HALF + n * 16); *(f32x4*)(op + bj * HALF + n * 16) = b + gv[bj][n] * acc[ai][bj][m][n]; }
            }
    }
};
struct EpiSlab {
    static constexpr bool PERM = false;
    float* slab;
    __device__ __forceinline__ void operator()(const f32x4 (&acc)[2][2][4][2], const Unit& u, int wr, int wc, int fr, int fq) const {
        const int row0 = u.pm * BM + wr * 64 + fr, col0 = u.pn * BM + wc * 32 + 4 * fq;
#pragma unroll
        for (int ai = 0; ai < 2; ++ai)
#pragma unroll
            for (int m = 0; m < 4; ++m) { float* op = slab + ((size_t)u.ks * MC + row0 + ai * HALF + m * 16) * DM + col0;
#pragma unroll
                for (int bj = 0; bj < 2; ++bj)
#pragma unroll
                    for (int n = 0; n < 2; ++n) *(f32x4*)(op + bj * HALF + n * 16) = acc[ai][bj][m][n]; }
    }
};
struct EpiSwiglu {
    static constexpr bool PERM = true;
    bf16_t* U;
    __device__ __forceinline__ void operator()(const f32x4 (&acc)[2][2][4][2], const Unit& u, int wr, int wc, int fr, int fq) const {
        const int row0 = u.pm * BM + wr * 64 + fr, oc = u.pn * HALF + wc * 32 + 8 * fq;
#pragma unroll
        for (int ai = 0; ai < 2; ++ai)
#pragma unroll
            for (int m = 0; m < 4; ++m) {
                const int row = row0 + ai * HALF + m * 16;
                float o[8];
#pragma unroll
                for (int n = 0; n < 2; ++n)
#pragma unroll
                    for (int j = 0; j < 4; ++j) { const float a = acc[ai][0][m][n][j], b = acc[ai][1][m][n][j]; o[n * 4 + j] = a * b * __builtin_amdgcn_rcpf(1.0f + __builtin_amdgcn_exp2f(-1.4426950408889634f * a)); }
                u32x4 w; w.x = cvt_pk_bf16(o[0], o[1]); w.y = cvt_pk_bf16(o[2], o[3]); w.z = cvt_pk_bf16(o[4], o[5]); w.w = cvt_pk_bf16(o[6], o[7]);
                *(u32x4*)(U + (size_t)row * DFF + oc) = w;
            }
    }
};
}

#define XB_TMO      128
#define XB_XCNT(j)  (256  + 64 * (j))
#define XB_XSUB(j)  (1280 + 64 * (j))
#define XB_XGEN(j)  (2304 + 64 * (j))
#define XB_TOP      3328
#define XB_TOPGEN   3392
#define XCD_BAR_WORDS 3456
#define XB_SPIN_CAP (1u << 18)
__device__ __forceinline__ unsigned xb_ld(unsigned* p)              { return __hip_atomic_load(p, __ATOMIC_RELAXED, __HIP_MEMORY_SCOPE_AGENT); }
__device__ __forceinline__ unsigned xb_add(unsigned* p, unsigned v) { return __hip_atomic_fetch_add(p, v, __ATOMIC_RELAXED, __HIP_MEMORY_SCOPE_AGENT); }
__device__ __forceinline__ unsigned xb_xcc_id() { return (unsigned)__builtin_amdgcn_s_getreg((3 << 11) | 20) & 0xFu; }
#define XB_SPIN(cond, bar) do { unsigned _sp = 0; while (cond) { __builtin_amdgcn_s_sleep(1); \
    if ((++_sp & 255u) == 0u) { if (xb_ld(&(bar)[XB_TMO])) break; if (_sp > XB_SPIN_CAP) { atomicAdd(&(bar)[XB_TMO], 1u); break; } } } } while (0)
struct XcdBarrier { unsigned* bar; unsigned x; volatile LAS unsigned* st; };
__device__ __forceinline__ XcdBarrier xcd_barrier_post(unsigned* bar, volatile LAS unsigned* st) {
    XcdBarrier b; b.bar = bar; b.x = xb_xcc_id(); b.st = st;
    if (threadIdx.x == 0) (void)xb_add(&bar[XB_XCNT(b.x)], 1u);
    return b;
}
__device__ __forceinline__ void xcd_barrier_complete(unsigned* bar, unsigned x, unsigned& nloc, unsigned& nx) {
    const unsigned G = gridDim.x * gridDim.y * gridDim.z;
    unsigned sum, cnt, mine, sp = 0u;
    for (;;) {
        sum = 0u; cnt = 0u; mine = 0u;
#pragma unroll
        for (unsigned j = 0; j < 16; ++j) { const unsigned c = xb_ld(&bar[XB_XCNT(j)]); sum += c; cnt += (c > 0u) ? 1u : 0u; mine = (j == x) ? c : mine; }
        if (sum == G) break;
        __builtin_amdgcn_s_sleep(1);
        if ((++sp & 255u) == 0u) { if (xb_ld(&bar[XB_TMO])) break; if (sp > XB_SPIN_CAP) { atomicAdd(&bar[XB_TMO], 1u); break; } }
    }
    nloc = mine > 0u ? mine : 1u; nx = cnt > 0u ? cnt : 1u;
}
__device__ __forceinline__ void xcd_barrier(const XcdBarrier& b) {
    asm volatile("s_waitcnt vmcnt(0)" ::: "memory");
    __syncthreads();
    if (threadIdx.x == 0) {
        unsigned* bar = b.bar;
        __builtin_amdgcn_s_waitcnt(0);
        unsigned nloc = b.st[0], nx = b.st[1];
        if (nloc == 0u) { xcd_barrier_complete(bar, b.x, nloc, nx); b.st[0] = nloc; b.st[1] = nx; }
        const unsigned old = xb_add(&bar[XB_XSUB(b.x)], 1u);
        const unsigned gen = old / nloc;
        if (old + 1u == (gen + 1u) * nloc) {
            __builtin_amdgcn_fence(__ATOMIC_RELEASE, "agent");
            asm volatile("s_waitcnt vmcnt(0)" ::: "memory");
            const unsigned og = xb_add(&bar[XB_TOP], 1u);
            const unsigned tg = og / nx;
            if (og + 1u == (tg + 1u) * nx) xb_add(&bar[XB_TOPGEN], 1u);
            else XB_SPIN(xb_ld(&bar[XB_TOPGEN]) == tg, bar);
            __builtin_amdgcn_fence(__ATOMIC_ACQUIRE, "agent");
            xb_add(&bar[XB_XGEN(b.x)], 1u);
            asm volatile("s_waitcnt vmcnt(0)" ::: "memory");
        } else {
            XB_SPIN(xb_ld(&bar[XB_XGEN(b.x)]) == gen, bar);
            __builtin_amdgcn_fence(__ATOMIC_ACQUIRE, "agent");
            asm volatile("s_waitcnt vmcnt(0)" ::: "memory");
        }
    }
    __syncthreads();
}

struct Params {
    const float *x, *c, *ctx, *c_ctx, *norm1_g, *w_mod, *b_mod, *w_in, *fg_up, *fg_b, *onorm_g, *conf_dw, *conf_dw_b, *conf_ln_g, *conf_ln_b, *sc_dw,
                *qn_g, *kvn_g, *w_uq, *w_ukv, *w_out, *norm2_g, *w1, *w3, *w2, *final_g;
    float* out; unsigned char* ws; int ph_lo, ph_hi;
};

template <class RowMap>
__device__ __forceinline__ void transpose_item64(const float* W, int N, bf16_t* WT, int ldk, int kofs, const RowMap& rm, const float* gain, LAS unsigned* scr, int item, int lane) {
    const int nblk = (N + 63) >> 6, kb = item / nblk, nb = item % nblk, k0 = 64 * kb, n0 = 64 * nb;
    const bool nvalid = (n0 + lane) < N;
    const float* src = W + (size_t)k0 * N + n0 + (nvalid ? lane : 0);
    float v[64];
#pragma unroll
    for (int kk = 0; kk < 64; ++kk) v[kk] = src[(size_t)kk * N];
    if (gain) {
#pragma unroll
        for (int kk = 0; kk < 64; ++kk) v[kk] *= gain[k0 + kk];
    }
#pragma unroll
    for (int j = 0; j < 32; ++j) scr[lane * 33 + j] = cvt_pk_bf16(v[2 * j], v[2 * j + 1]);
    LDS_WAIT(); asm volatile("" ::: "memory");
    const int c = lane & 7;
#pragma unroll
    for (int j = 0; j < 8; ++j) { const int n = (lane >> 3) + 8 * j;
        if (n0 + n < N) { const LAS unsigned* q = scr + n * 33 + 4 * c; u32x4 o; o.x = q[0]; o.y = q[1]; o.z = q[2]; o.w = q[3];
            *(u32x4*)(WT + (size_t)rm(n0 + n) * ldk + kofs + k0 + 8 * c) = o; } }
    LDS_WAIT(); asm volatile("" ::: "memory");
}
struct RmId { __device__ __forceinline__ int operator()(int n) const { return n; } };
struct RmIn { __device__ __forceinline__ int operator()(int n) const { if (n < ZKR) return n; const int rc = n - ZKR, a = rc >> 5, hf = (rc >> 4) & 1, i = rc & 15; return ZKR + a * 32 + 2 * i + hf; } };
struct RmUq { __device__ __forceinline__ int operator()(int n) const { const int hd = n / 192, within = n % 192; if (within < 128) return n; const int rc = within - 128, a = rc >> 5, hf = (rc >> 4) & 1, i = rc & 15; return hd * 192 + 128 + a * 32 + 2 * i + hf; } };
struct RmOff { int off; __device__ __forceinline__ int operator()(int n) const { return off + n; } };
struct RmFf { int off; __device__ __forceinline__ int operator()(int n) const { return (n >> 7) * 256 + off + (n & 127); } };

struct Frame {
    LAS unsigned char* lds; int tid, lane, wave, G, bid; unsigned char* ws; const Params* p;
};

__device__ __forceinline__ void phase_p0a(const Params& P, LAS unsigned char* lds, int tid, int lane, int wave, int G, int bid) {
    unsigned char* ws = P.ws;
    const int gw = bid * 8 + wave, NGW = G * 8;
    const int gt = bid * 512 + tid, NGT = G * 512;
    LAS float* act = (LAS float*)(lds + 8 * 8448);
    for (int i = tid; i < 3 * DM; i += 512) { const int r = i / DM, k = i % DM; const float v = r < 2 ? P.c[r * DM + k] : P.c_ctx[k]; act[i] = v / (1.0f + expf(-v)); }
    __syncthreads();
    {
        float* modp = (float*)(ws + WS_MODP);
        for (int it = gw; it < 4 * 48 * 8; it += NGW) {
            const int layer = it / 384, rem = it % 384, cb = rem / 8, ks = rem % 8;
            const int col0 = cb * 256 + lane * 4;
            const float* Wp = P.w_mod + ((size_t)layer * DM + (size_t)ks * 256) * 12288 + col0;
            const LAS float* a0 = act + ks * 256;
            f32x4 s0 = {0.f, 0.f, 0.f, 0.f}, s1 = s0, s2 = s0;
#pragma unroll 16
            for (int k = 0; k < 256; ++k) { const f32x4 w = *(const f32x4*)(Wp + (size_t)k * 12288); s0 += w * a0[k]; s1 += w * a0[DM + k]; s2 += w * a0[2 * DM + k]; }
            float* o = modp + (((size_t)ks * 4 + layer) * 3) * 12288 + col0;
            *(f32x4*)(o) = s0; *(f32x4*)(o + 12288) = s1; *(f32x4*)(o + 2 * 12288) = s2;
        }
    }
    {
        LAS unsigned* scr = (LAS unsigned*)(lds + wave * 8448);
        constexpr int I_IN = (DM / 64) * ((INW + 63) / 64), I_OUT = (DM / 64) * (DM / 64), I_FF = (DM / 64) * (DFF / 64), I_W2 = (DFF / 64) * (DM / 64), I_UQ = (384 / 64) * (768 / 64), I_UKV = (128 / 64) * (1024 / 64);
        constexpr int PER_LAYER = I_IN + I_OUT + 2 * I_FF + I_W2 + I_UQ + I_UKV;
        for (int it = gw; it < 4 * PER_LAYER; it += NGW) {
            const int layer = it / PER_LAYER; int r = it % PER_LAYER;
            if (r < I_IN) { transpose_item64(P.w_in + (size_t)layer * DM * INW, INW, (bf16_t*)(ws + WS_WIN) + (size_t)layer * INWP * DM, DM, 0, RmIn{}, nullptr, scr, r, lane); continue; } r -= I_IN;
            if (r < I_OUT) { transpose_item64(P.w_out + (size_t)layer * DM * DM, DM, (bf16_t*)(ws + WS_WOUT) + (size_t)layer * DM * DM, DM, 0, RmId{}, nullptr, scr, r, lane); continue; } r -= I_OUT;
            if (r < I_FF) { transpose_item64(P.w1 + (size_t)layer * DM * DFF, DFF, (bf16_t*)(ws + WS_W13) + (size_t)layer * 2 * DFF * DM, DM, 0, RmFf{0}, nullptr, scr, r, lane); continue; } r -= I_FF;
            if (r < I_FF) { transpose_item64(P.w3 + (size_t)layer * DM * DFF, DFF, (bf16_t*)(ws + WS_W13) + (size_t)layer * 2 * DFF * DM, DM, 0, RmFf{128}, nullptr, scr, r, lane); continue; } r -= I_FF;
            if (r < I_W2) { transpose_item64(P.w2 + (size_t)layer * DFF * DM, DM, (bf16_t*)(ws + WS_W2) + (size_t)layer * DM * DFF, DFF, 0, RmId{}, nullptr, scr, r, lane); continue; } r -= I_W2;
            if (r < I_UQ) { transpose_item64(P.w_uq + (size_t)layer * 384 * 768, 768, (bf16_t*)(ws + WS_WUP) + (size_t)layer * NUP * KUP, KUP, 0, RmUq{}, P.qn_g + layer * 384, scr, r, lane); continue; } r -= I_UQ;
            transpose_item64(P.w_ukv + (size_t)layer * 128 * 1024, 1024, (bf16_t*)(ws + WS_WUP) + (size_t)layer * NUP * KUP, KUP, 384, RmOff{768}, P.kvn_g + layer * 128, scr, r, lane);
        }
    }
    {
        constexpr int PADW = (INWP - INW) * DM / 8;
        for (int i = gt; i < 4 * PADW; i += NGT) { const int layer = i / PADW, j = i % PADW;
            *(u32x4*)((bf16_t*)(ws + WS_WIN) + ((size_t)layer * INWP + INW) * DM + (size_t)j * 8) = (u32x4){0u, 0u, 0u, 0u}; }
        constexpr int ZQ_ = 768 * 16, ZKV_ = 1024 * 48;
        for (int i = gt; i < 4 * (ZQ_ + ZKV_); i += NGT) { const int layer = i / (ZQ_ + ZKV_), j = i % (ZQ_ + ZKV_);
            bf16_t* WU = (bf16_t*)(ws + WS_WUP) + (size_t)layer * NUP * KUP;
            if (j < ZQ_) *(u32x4*)(WU + (size_t)(j >> 4) * KUP + 384 + (j & 15) * 8) = (u32x4){0u, 0u, 0u, 0u};
            else { const int jj = j - ZQ_; *(u32x4*)(WU + (size_t)(768 + jj / 48) * KUP + (jj % 48) * 8) = (u32x4){0u, 0u, 0u, 0u}; } }
    }
    {
        f32x2* rope = (f32x2*)(ws + WS_ROPE);
        for (int i = gt; i < 1024; i += NGT) { const int pos = i >> 4, f = i & 15; const float inv = powf(10000.0f, -(float)f * 2.0f / 32.0f); const float ang = (float)pos * inv; rope[i] = (f32x2){cosf(ang), sinf(ang)}; }
        float* rs = (float*)(ws + WS_RSTAT);
        for (int i = gt; i < 4 * MT * 2; i += NGT) rs[i] = 0.f;
    }
}
__device__ __forceinline__ void phase_p0b(const Params& P, int tid, int G, int bid) {
    const float* modp = (const float*)(P.ws + WS_MODP); float* modv = (float*)(P.ws + WS_MODV);
    for (int i = bid * 512 + tid; i < 4 * 3 * 12288; i += G * 512) {
        const int layer = i / (3 * 12288), rem = i % (3 * 12288), r = rem / 12288, c12 = rem % 12288, j = c12 / DM, col = c12 % DM;
        float s = P.b_mod[layer * 12288 + c12];
#pragma unroll
        for (int ks = 0; ks < 8; ++ks) s += modp[(((size_t)ks * 4 + layer) * 3 + r) * 12288 + c12];
        if (j == 1) s = P.norm1_g[layer * DM + col] * (1.0f + s);
        if (j == 4) s = P.norm2_g[layer * DM + col] * (1.0f + s);
        modv[(((size_t)layer * 3 + r) * 6 + j) * DM + col] = s;
    }
}

__device__ __forceinline__ void phase_norm(LAS unsigned char* lds, const float* xlat, const float* xctx, const float* modl  , int jg, int jsh, bf16_t* H, bool with_ctx,
                                           const float* slab, int nslab, const float* sgate, float* xctx_out, int tid, int lane, int wave, int G, int bid) {
    if (with_ctx) {
        LAS float* red = (LAS float*)lds;
        const float* gp = modl + ((size_t)2 * 6 + jg) * DM; const float* sp = modl + ((size_t)2 * 6 + jsh) * DM;
        for (int r0 = bid * 2; r0 < MC; r0 += G * 2) {
            const int col = wave * 256 + lane * 4;
            f32x4 v[2]; float ss[2];
#pragma unroll
            for (int q = 0; q < 2; ++q) { const int row = r0 + q;
                v[q] = *(const f32x4*)(xctx + (size_t)row * DM + col);
                if (nslab > 0) { f32x4 a = {0.f, 0.f, 0.f, 0.f};
                    for (int sI = 0; sI < nslab; ++sI) a += *(const f32x4*)(slab + ((size_t)sI * MC + row) * DM + col);
                    v[q] += *(const f32x4*)(sgate + col) * a;
                    *(f32x4*)(xctx_out + (size_t)row * DM + col) = v[q]; }
                ss[q] = wave_sum(dot4(v[q])); }
            if (lane == 0) { red[wave * 2] = ss[0]; red[wave * 2 + 1] = ss[1]; }
            __syncthreads();
            const f32x4 gs = *(const f32x4*)(gp + col), sh = *(const f32x4*)(sp + col);
#pragma unroll
            for (int q = 0; q < 2; ++q) { float t = 0.f;
#pragma unroll
                for (int w = 0; w < 8; ++w) t += red[w * 2 + q];
                const float rstd = rsqrtf(t * (1.0f / DM) + EPS);
                const f32x4 o = v[q] * rstd * gs + sh; u32x2 w2; w2.x = cvt_pk_bf16(o[0], o[1]); w2.y = cvt_pk_bf16(o[2], o[3]);
                *(u32x2*)(H + (size_t)(ML + r0 + q) * DM + col) = w2; }
            __syncthreads();
        }
    }
    const int rpw = (ML + G - 1) / G;
    int cur = -1; f32x4 gsv[8], shv[8];
    for (int k = wave; k < rpw; k += 8) {
        const int row = bid * rpw + k; if (row >= ML) break;
        const int r = row < SEQ ? 0 : 1;
        if (r != cur) { cur = r; const float* gp = modl + ((size_t)r * 6 + jg) * DM; const float* sp = modl + ((size_t)r * 6 + jsh) * DM;
#pragma unroll
            for (int j = 0; j < 8; ++j) { gsv[j] = *(const f32x4*)(gp + (lane + 64 * j) * 4); shv[j] = *(const f32x4*)(sp + (lane + 64 * j) * 4); } }
        const float* xr = xlat + (size_t)row * DM;
        f32x4 v[8]; float ss = 0.f;
#pragma unroll
        for (int j = 0; j < 8; ++j) { v[j] = *(const f32x4*)(xr + (lane + 64 * j) * 4); ss += dot4(v[j]); }
        const float rstd = rsqrtf(wave_sum(ss) * (1.0f / DM) + EPS);
        bf16_t* hr = H + (size_t)row * DM;
#pragma unroll
        for (int j = 0; j < 8; ++j) { const f32x4 o = v[j] * rstd * gsv[j] + shv[j]; u32x2 w; w.x = cvt_pk_bf16(o[0], o[1]); w.y = cvt_pk_bf16(o[2], o[3]); *(u32x2*)(hr + (lane + 64 * j) * 4) = w; }
    }
}
__device__ __forceinline__ void phase_final(const float* X, const float* g, float* out, int lane, int wave, int G, int bid) {
    for (int row = bid * 8 + wave; row < ML; row += G * 8) {
        const float* xr = X + (size_t)row * DM; f32x4 v[8]; float ss = 0.f;
#pragma unroll
        for (int j = 0; j < 8; ++j) { v[j] = *(const f32x4*)(xr + (lane + 64 * j) * 4); ss += dot4(v[j]); }
        const float rstd = rsqrtf(wave_sum(ss) * (1.0f / DM) + EPS);
#pragma unroll
        for (int j = 0; j < 8; ++j) { const f32x4 gg = *(const f32x4*)(g + (lane + 64 * j) * 4); *(f32x4*)(out + (size_t)row * DM + (lane + 64 * j) * 4) = v[j] * rstd * gg; }
    }
}

constexpr int GL_RQ = 0;
constexpr int GL_RK = 16384;
constexpr int GL_RV = 32768;
constexpr int GL_QT = 49152;
constexpr int GL_KT = 66560;
constexpr int GL_PP = 83968;
constexpr int GL_VT = 93184;
constexpr int GL_LR = 111616;
constexpr int GL_TOT = 119808;
__device__ __forceinline__ int gla_row0(int b, int id) { return id < 4 ? ML + b * CTX + id * 64 : b * SEQ + (id - 4) * 64; }
struct GlaRaw { u32x4 q0, q1, k0, k1, v0, v1, l0, l1, ga, gb; };
template <bool WITH_Q>
__device__ __forceinline__ void gla_load_raw(GlaRaw& R, const bf16_t* Z, int row0, int h, int tid) {
    const int t = tid >> 3, dg = (tid & 7) * 16;
    const bf16_t* zr = Z + (size_t)(row0 + t) * INWP + h * 128 + dg;
    R.k0 = *(const u32x4*)(zr + ZK); R.k1 = *(const u32x4*)(zr + ZK + 8); R.v0 = *(const u32x4*)(zr + ZV); R.v1 = *(const u32x4*)(zr + ZV + 8);
    if (WITH_Q) { R.q0 = *(const u32x4*)(zr + ZQ); R.q1 = *(const u32x4*)(zr + ZQ + 8); R.ga = *(const u32x4*)(zr + ZG); R.gb = *(const u32x4*)(zr + ZG + 8); }
    const bf16_t* lp = Z + (size_t)(row0 + ((tid & 127) >> 1)) * INWP + ZLR + (tid & 1) * 8;
    R.l0 = *(const u32x4*)lp; R.l1 = *(const u32x4*)(lp + 16);
}
template <bool WITH_Q>
__device__ __forceinline__ void gla_store_raw(LAS unsigned char* lds, const GlaRaw& R, int tid) {
    const int t = tid >> 3, dg = (tid & 7) * 16;
    *(LAS u32x4*)(lds + GL_RK + t * 256 + dg * 2) = R.k0; *(LAS u32x4*)(lds + GL_RK + t * 256 + dg * 2 + 16) = R.k1;
    *(LAS u32x4*)(lds + GL_RV + t * 256 + dg * 2) = R.v0; *(LAS u32x4*)(lds + GL_RV + t * 256 + dg * 2 + 16) = R.v1;
    if (WITH_Q) { *(LAS u32x4*)(lds + GL_RQ + t * 256 + dg * 2) = R.q0; *(LAS u32x4*)(lds + GL_RQ + t * 256 + dg * 2 + 16) = R.q1; }
    if (tid < 128) { LAS float* LR = (LAS float*)(lds + GL_LR) + (tid >> 1) * 16 + (tid & 1) * 8; const u32x4 l0 = R.l0, l1 = R.l1;
        LR[0] = bflo(l0.x); LR[1] = bfhi(l0.x); LR[2] = bflo(l0.y); LR[3] = bfhi(l0.y); LR[4] = bflo(l0.z); LR[5] = bfhi(l0.z); LR[6] = bflo(l0.w); LR[7] = bfhi(l0.w);
        LAS float* L1 = LR + 1024;
        L1[0] = bflo(l1.x); L1[1] = bfhi(l1.x); L1[2] = bflo(l1.y); L1[3] = bfhi(l1.y); L1[4] = bflo(l1.z); L1[5] = bfhi(l1.z); L1[6] = bflo(l1.w); L1[7] = bfhi(l1.w); }
}
struct GlaFg { float w[16]; float b; };
__device__ __forceinline__ void gla_load_fg(GlaFg& F, const float* fgup  , const float* fgb  , int h, int tid) {
    const int d = tid & 127;
#pragma unroll
    for (int r = 0; r < 16; ++r) F.w[r] = fgup[r * 512 + h * 128 + d];
    F.b = fgb[h * 128 + d];
}
__device__ __forceinline__ void gla_decay_local(LAS unsigned char* lds, const GlaFg& F, int dir, int tid, float (&p)[16]) {
    const int d = tid & 127, seg = tid >> 7;
    const float (&fg)[16] = F.w; const float fb = F.b;
    const LAS float* LR = (const LAS float*)(lds + GL_LR) + dir * 1024 + seg * 256;
#pragma unroll
    for (int i = 0; i < 16; ++i) { float x = fb;
#pragma unroll
        for (int r4 = 0; r4 < 4; ++r4) { const f32x4 l = *(const LAS f32x4*)(LR + i * 16 + r4 * 4); x += l[0] * fg[r4 * 4] + l[1] * fg[r4 * 4 + 1] + l[2] * fg[r4 * 4 + 2] + l[3] * fg[r4 * 4 + 3]; }
        p[i] = (fminf(x, 0.f) - __logf(1.0f + __expf(-fabsf(x)))) * (1.0f / 16.0f); }
    if (dir == 0) {
#pragma unroll
        for (int i = 1; i < 16; ++i) p[i] += p[i - 1];
        ((LAS float*)(lds + GL_TOT))[seg * 128 + d] = p[15];
    } else {
#pragma unroll
        for (int i = 14; i >= 0; --i) p[i] += p[i + 1];
        ((LAS float*)(lds + GL_TOT))[seg * 128 + d] = p[0];
    }
}
__device__ __forceinline__ float gla_offsets(const LAS unsigned char* lds, int dir, int tid, float (&p)[16]) {
    const int d = tid & 127, seg = tid >> 7;
    const LAS float* T = (const LAS float*)(lds + GL_TOT) + d;
    const float t0 = T[0], t1 = T[128], t2 = T[256], t3 = T[384];
    float off;
    if (dir == 0) off = (seg > 0 ? t0 : 0.f) + (seg > 1 ? t1 : 0.f) + (seg > 2 ? t2 : 0.f);
    else off = (seg < 3 ? t3 : 0.f) + (seg < 2 ? t2 : 0.f) + (seg < 1 ? t1 : 0.f);
#pragma unroll
    for (int i = 0; i < 16; ++i) p[i] += off;
    return (t0 + t1) + (t2 + t3);
}
__device__ __forceinline__ void gla_build_vT(LAS unsigned char* lds, int tid) {
    const int e = tid & 127, seg = tid >> 7;
    const LAS bf16_t* RV = (const LAS bf16_t*)(lds + GL_RV) + (16 * seg) * 128 + e;
    unsigned w[8];
#pragma unroll
    for (int i = 0; i < 8; ++i) w[i] = (unsigned)RV[(2 * i) * 128] | ((unsigned)RV[(2 * i + 1) * 128] << 16);
    LAS u32x4* dst = (LAS u32x4*)(lds + GL_VT + e * 144 + seg * 32);
    dst[0] = (u32x4){w[0], w[1], w[2], w[3]}; dst[1] = (u32x4){w[4], w[5], w[6], w[7]};
}
__device__ __forceinline__ void gla_item_decode(int item, int& b, int& h, int& id) { const int bh = item & 7; id = item >> 3; b = bh >> 2; h = bh & 3; }
__device__ __forceinline__ void gla_g1_loop(LAS unsigned char* lds, const Params& P, int layer, int first, int nitems, int G, int tid, int lane, int wave) {
    if (first >= nitems) return;
    const bf16_t* Z = (const bf16_t*)(P.ws + WS_Z);
    LAS bf16_t* KH = (LAS bf16_t*)(lds + GL_QT);
    const LAS bf16_t* VT = (const LAS bf16_t*)(lds + GL_VT);
    const int d = tid & 127, seg = tid >> 7;
    int b, h, id; gla_item_decode(first, b, h, id);
    GlaRaw R; gla_load_raw<false>(R, Z, gla_row0(b, id), h, tid);
    GlaFg F0, F1; int fh = -1;
    for (int it = first; it < nitems; it += G) {
        gla_item_decode(it, b, h, id);
        if (h != fh) { fh = h; gla_load_fg(F0, P.fg_up + ((size_t)layer * 2 + 0) * 16 * 512, P.fg_b + ((size_t)layer * 2 + 0) * 512, h, tid); gla_load_fg(F1, P.fg_up + ((size_t)layer * 2 + 1) * 16 * 512, P.fg_b + ((size_t)layer * 2 + 1) * 512, h, tid); }
        gla_store_raw<false>(lds, R, tid);
        __syncthreads();
        if (it + G < nitems) { int b2, h2, id2; gla_item_decode(it + G, b2, h2, id2); gla_load_raw<false>(R, Z, gla_row0(b2, id2), h2, tid); }
#pragma unroll
        for (int dir = 0; dir < 2; ++dir) {
            const int seq = (b * 4 + h) * 2 + dir;
            float p[16];
            gla_decay_local(lds, dir == 0 ? F0 : F1, dir, tid, p);
            __syncthreads();
            const float blast = gla_offsets(lds, dir, tid, p);
            {
                const LAS bf16_t* RK = (const LAS bf16_t*)(lds + GL_RK) + (16 * seg) * 128 + d;
                unsigned w[8];
#pragma unroll
                for (int i = 0; i < 8; ++i) w[i] = cvt_pk_bf16(bf2f(RK[(2 * i) * 128]) * __expf(blast - p[2 * i]), bf2f(RK[(2 * i + 1) * 128]) * __expf(blast - p[2 * i + 1]));
                LAS u32x4* dst = (LAS u32x4*)(lds + GL_QT + d * 144 + seg * 32);
                dst[0] = (u32x4){w[0], w[1], w[2], w[3]}; dst[1] = (u32x4){w[4], w[5], w[6], w[7]};
                if (dir == 0) gla_build_vT(lds, tid);
                if (seg == 0) ((float*)(P.ws + WS_GD))[((size_t)seq * NCH + id) * 128 + d] = __expf(blast);
            }
            __syncthreads();
            {
                const int eb = wave >> 1, r32 = lane & 31, hi = lane >> 5;
                float* U = (float*)(P.ws + WS_GU) + ((size_t)seq * NCH + id) * 16384;
#pragma unroll
                for (int q = 0; q < 2; ++q) { const int db = 2 * (wave & 1) + q; f32x16 acc = {};
#pragma unroll
                    for (int kk = 0; kk < 4; ++kk) { const bf16x8 av = *(const LAS bf16x8*)(VT + (32 * eb + r32) * 72 + 16 * kk + 8 * hi), bv = *(const LAS bf16x8*)(KH + (32 * db + r32) * 72 + 16 * kk + 8 * hi);
                        acc = __builtin_amdgcn_mfma_f32_32x32x16_bf16(av, bv, acc, 0, 0, 0); }
#pragma unroll
                    for (int r = 0; r < 16; ++r) { const int e = 32 * eb + (r & 3) + 8 * (r >> 2) + 4 * hi; U[e * 128 + 32 * db + r32] = acc[r]; } }
            }
            __syncthreads();
        }
    }
}
__device__ __forceinline__ void gla_g2(const Params& P, int tid, int G, int bid) {
    const float* U = (const float*)(P.ws + WS_GU); const float* Dv = (const float*)(P.ws + WS_GD); bf16_t* S = (bf16_t*)(P.ws + WS_GS);
    for (int slot = bid * 512 + tid; slot < 16 * 8192; slot += G * 512) {
        const int seq = slot >> 13, el = (slot & 8191) * 2, d = el & 127, dir = seq & 1;
        float s0 = 0.f, s1 = 0.f;
#pragma unroll 4
        for (int p = 0; p < NCH; ++p) {
            const int id = dir == 0 ? p : (p < 4 ? 3 - p : 71 - p);
            const size_t base = ((size_t)seq * NCH + id);
            *(unsigned*)(S + base * 16384 + el) = cvt_pk_bf16(s0, s1);
            const f32x2 u = *(const f32x2*)(U + base * 16384 + el), dd = *(const f32x2*)(Dv + base * 128 + d);
            s0 = dd.x * s0 + u.x; s1 = dd.y * s1 + u.y;
        }
    }
}
__device__ __forceinline__ void gla_g3_loop(LAS unsigned char* lds, const Params& P, int layer, int first, int nitems, int G, int tid, int lane, int wave) {
    if (first >= nitems) return;
    const bf16_t* Z = (const bf16_t*)(P.ws + WS_Z);
    const int r32 = lane & 31, hi = lane >> 5, rb = wave >> 2, cb = wave & 3;
    const int d = tid & 127, seg = tid >> 7;
    LAS bf16_t* QT = (LAS bf16_t*)(lds + GL_QT); LAS bf16_t* KT = (LAS bf16_t*)(lds + GL_KT); LAS bf16_t* PP = (LAS bf16_t*)(lds + GL_PP);
    const LAS bf16_t* VT = (const LAS bf16_t*)(lds + GL_VT);
    int b, h, id; gla_item_decode(first, b, h, id);
    GlaRaw R; gla_load_raw<true>(R, Z, gla_row0(b, id), h, tid);
    GlaFg F0, F1; int fh = -1;
    for (int it = first; it < nitems; it += G) {
        gla_item_decode(it, b, h, id);
        const int row0 = gla_row0(b, id);
        if (h != fh) { fh = h; gla_load_fg(F0, P.fg_up + ((size_t)layer * 2 + 0) * 16 * 512, P.fg_b + ((size_t)layer * 2 + 0) * 512, h, tid); gla_load_fg(F1, P.fg_up + ((size_t)layer * 2 + 1) * 16 * 512, P.fg_b + ((size_t)layer * 2 + 1) * 512, h, tid); }
        const u32x4 ga = R.ga, gb = R.gb;
        gla_store_raw<true>(lds, R, tid);
        bf16x8 sf0[8], sf1[8];
        { const bf16_t* Sg = (const bf16_t*)(P.ws + WS_GS) + ((size_t)((b * 4 + h) * 2) * NCH + id) * 16384 + (size_t)(32 * cb + r32) * 128 + 8 * hi;
#pragma unroll
          for (int kk = 0; kk < 8; ++kk) { sf0[kk] = *(const bf16x8*)(Sg + 16 * kk); sf1[kk] = *(const bf16x8*)(Sg + (size_t)NCH * 16384 + 16 * kk); } }
        __syncthreads();
        if (it + G < nitems) { int b2, h2, id2; gla_item_decode(it + G, b2, h2, id2); gla_load_raw<true>(R, Z, gla_row0(b2, id2), h2, tid); }
        f32x16 o = {};
#pragma unroll
        for (int dir = 0; dir < 2; ++dir) {
            float p[16];
            gla_decay_local(lds, dir == 0 ? F0 : F1, dir, tid, p);
            __syncthreads();
            (void)gla_offsets(lds, dir, tid, p);
            {
                const LAS bf16_t* RQ = (const LAS bf16_t*)(lds + GL_RQ) + (16 * seg) * 128 + d; const LAS bf16_t* RK = (const LAS bf16_t*)(lds + GL_RK) + (16 * seg) * 128 + d;
#pragma unroll
                for (int i = 0; i < 16; ++i) { const int t = 16 * seg + i;
                    QT[t * 136 + d] = f2bf(bf2f(RQ[i * 128]) * (0.08838834764831845f * __expf(p[i])));
                    KT[t * 136 + d] = f2bf(bf2f(RK[i * 128]) * __expf(fminf(-p[i], 80.f))); }
                if (dir == 0) gla_build_vT(lds, tid);
            }
            __syncthreads();
            {
                const int bi = wave >> 1, fr = lane & 15, fq = lane >> 4;
#pragma unroll
                for (int q = 0; q < 2; ++q) { const int bj = 2 * (wave & 1) + q; f32x4 acc = {0.f, 0.f, 0.f, 0.f};
#pragma unroll
                    for (int kk = 0; kk < 4; ++kk) { const bf16x8 av = *(const LAS bf16x8*)(QT + (16 * bi + fr) * 136 + 32 * kk + 8 * fq), bv = *(const LAS bf16x8*)(KT + (16 * bj + fr) * 136 + 32 * kk + 8 * fq);
                        acc = __builtin_amdgcn_mfma_f32_16x16x32_bf16(av, bv, acc, 0, 0, 0); }
                    const int jt = 16 * bj + fr;
#pragma unroll
                    for (int r = 0; r < 4; ++r) { const int itk = 16 * bi + 4 * fq + r; const bool keep = dir == 0 ? (jt <= itk) : (jt >= itk); PP[itk * 72 + jt] = f2bf(keep ? acc[r] : 0.f); } }
            }
            __syncthreads();
            {
#pragma unroll
                for (int kk = 0; kk < 4; ++kk) { const bf16x8 av = *(const LAS bf16x8*)(PP + (32 * rb + r32) * 72 + 16 * kk + 8 * hi), bv = *(const LAS bf16x8*)(VT + (32 * cb + r32) * 72 + 16 * kk + 8 * hi);
                    o = __builtin_amdgcn_mfma_f32_32x32x16_bf16(av, bv, o, 0, 0, 0); }
#pragma unroll
                for (int kk = 0; kk < 8; ++kk) { const bf16x8 av = *(const LAS bf16x8*)(QT + (32 * rb + r32) * 136 + 16 * kk + 8 * hi);
                    o = __builtin_amdgcn_mfma_f32_32x32x16_bf16(av, dir == 0 ? sf0[kk] : sf1[kk], o, 0, 0, 0); }
            }
            __syncthreads();
        }
        LAS float* OS = (LAS float*)(lds + GL_RQ);
#pragma unroll
        for (int r = 0; r < 16; ++r) { const int t = 32 * rb + (r & 3) + 8 * (r >> 2) + 4 * hi; OS[t * 132 + 32 * cb + r32] = o[r]; }
        __syncthreads();
        {
            const int t = tid >> 3, eg = (tid & 7) * 16;
            f32x4 v[4]; float ss = 0.f;
#pragma unroll
            for (int q = 0; q < 4; ++q) { v[q] = *(const LAS f32x4*)(OS + t * 132 + eg + 4 * q); ss += dot4(v[q]); }
            ss += __shfl_xor(ss, 1); ss += __shfl_xor(ss, 2); ss += __shfl_xor(ss, 4);
            const float rstd = rsqrtf(ss * (1.0f / 128.0f) + EPS);
            const unsigned gw[8] = {ga.x, ga.y, ga.z, ga.w, gb.x, gb.y, gb.z, gb.w};
            const float* og = P.onorm_g + layer * 128 + eg;
            unsigned ow[8];
#pragma unroll
            for (int i = 0; i < 8; ++i) { const float g0 = bflo(gw[i]), g1 = bfhi(gw[i]);
                const float o0 = v[i >> 1][(i & 1) * 2] * rstd * og[2 * i] * siluf_(g0), o1 = v[i >> 1][(i & 1) * 2 + 1] * rstd * og[2 * i + 1] * siluf_(g1);
                ow[i] = cvt_pk_bf16(o0, o1); }
            bf16_t* mp = (bf16_t*)(P.ws + WS_MIX) + (size_t)(row0 + t) * DM + h * 128 + eg;
            *(u32x4*)(mp) = (u32x4){ow[0], ow[1], ow[2], ow[3]}; *(u32x4*)(mp + 8) = (u32x4){ow[4], ow[5], ow[6], ow[7]};
        }
        __syncthreads();
    }
}

struct ConfRaw { u32x4 a[6], g[6]; };
__device__ __forceinline__ void conf_load(ConfRaw& R, const bf16_t* Z, int item, int tid) {
    const int r0 = item * 16;
    const int s0 = r0 < ML ? (r0 & ~(SEQ - 1)) : ML + ((r0 - ML) & ~(CTX - 1)), s1 = s0 + (r0 < ML ? SEQ : CTX);
#pragma unroll
    for (int i = 0; i < 6; ++i) { const int pc = tid + 512 * i, rr = pc >> 6, ch = pc & 63, row = r0 - 15 + rr;
        const bool ok = (pc < 46 * 64) && row >= s0 && row < s1; const bf16_t* zp = Z + (size_t)(ok ? row : s0) * INWP + ch * 8;
        R.a[i] = *(const u32x4*)(zp + ZCA); R.g[i] = *(const u32x4*)(zp + ZCG);
        if (!ok) R.a[i] = (u32x4){0u, 0u, 0u, 0u}; }
}
__device__ __forceinline__ void conf_loop(LAS unsigned char* lds, const Params& P, int layer, int first, int nitems, int G, int tid, int lane, int wave) {
    if (first >= nitems) return;
    const bf16_t* Z = (const bf16_t*)(P.ws + WS_Z);
    LAS float* UB = (LAS float*)lds;
    LAS float* YB = (LAS float*)(lds + 46 * 512 * 4);
    const int c = tid;
    ConfRaw R; conf_load(R, Z, first, tid);
    float w[31];
#pragma unroll
    for (int j = 0; j < 31; ++j) w[j] = P.conf_dw[((size_t)layer * 31 + j) * 512 + c];
    const float bias = P.conf_dw_b[layer * 512 + c];
    const float* lg = P.conf_ln_g + layer * 512 + 8 * lane; const float* lb = P.conf_ln_b + layer * 512 + 8 * lane;
    const f32x4 g0 = *(const f32x4*)lg, g1 = *(const f32x4*)(lg + 4), b0 = *(const f32x4*)lb, b1 = *(const f32x4*)(lb + 4);
    for (int it = first; it < nitems; it += G) {
        const int r0 = it * 16;
#pragma unroll
        for (int i = 0; i < 6; ++i) { const int pc = tid + 512 * i, rr = pc >> 6, ch = pc & 63;
            if (pc < 46 * 64) { const unsigned aw[4] = {R.a[i].x, R.a[i].y, R.a[i].z, R.a[i].w}, gw[4] = {R.g[i].x, R.g[i].y, R.g[i].z, R.g[i].w};
                f32x4 u0, u1;
                u0[0] = bflo(aw[0]) * sigmoidf_(bflo(gw[0])); u0[1] = bfhi(aw[0]) * sigmoidf_(bfhi(gw[0])); u0[2] = bflo(aw[1]) * sigmoidf_(bflo(gw[1])); u0[3] = bfhi(aw[1]) * sigmoidf_(bfhi(gw[1]));
                u1[0] = bflo(aw[2]) * sigmoidf_(bflo(gw[2])); u1[1] = bfhi(aw[2]) * sigmoidf_(bfhi(gw[2])); u1[2] = bflo(aw[3]) * sigmoidf_(bflo(gw[3])); u1[3] = bfhi(aw[3]) * sigmoidf_(bfhi(gw[3]));
                *(LAS f32x4*)(UB + rr * 512 + ch * 8) = u0; *(LAS f32x4*)(UB + rr * 512 + ch * 8 + 4) = u1; } }
        __syncthreads();
        if (it + G < nitems) conf_load(R, Z, it + G, tid);
#pragma unroll
        for (int g8 = 0; g8 < 2; ++g8) {
            float win[38];
#pragma unroll
            for (int i = 0; i < 38; ++i) win[i] = UB[(g8 * 8 + i) * 512 + c];
#pragma unroll
            for (int r = 0; r < 8; ++r) { float y = bias;
#pragma unroll
                for (int j = 0; j < 31; ++j) y += w[j] * win[r + j];
                YB[(g8 * 8 + r) * 512 + c] = y; }
        }
        __syncthreads();
#pragma unroll
        for (int q = 0; q < 2; ++q) { const int t = 2 * wave + q;
            f32x4 y0 = *(const LAS f32x4*)(YB + t * 512 + 8 * lane), y1 = *(const LAS f32x4*)(YB + t * 512 + 8 * lane + 4);
            const float mean = wave_sum((y0[0] + y0[1]) + (y0[2] + y0[3]) + (y1[0] + y1[1]) + (y1[2] + y1[3])) * (1.0f / 512.0f);
            y0 = y0 - mean; y1 = y1 - mean;
            const float rstd = rsqrtf(wave_sum(dot4(y0) + dot4(y1)) * (1.0f / 512.0f) + EPS);
            y0 = y0 * rstd * g0 + b0; y1 = y1 * rstd * g1 + b1;
            u32x4 o; o.x = cvt_pk_bf16(siluf_(y0[0]), siluf_(y0[1])); o.y = cvt_pk_bf16(siluf_(y0[2]), siluf_(y0[3])); o.z = cvt_pk_bf16(siluf_(y1[0]), siluf_(y1[1])); o.w = cvt_pk_bf16(siluf_(y1[2]), siluf_(y1[3]));
            *(u32x4*)((bf16_t*)(P.ws + WS_MIX) + (size_t)(r0 + t) * DM + 512 + 8 * lane) = o; }
        __syncthreads();
    }
}
__device__ __forceinline__ void sconv_item(const Params& P, int layer, int item, int tid) {
    const bf16_t* Z = (const bf16_t*)(P.ws + WS_Z);
    const int row = item * 16 + (tid >> 5);
    const int s0 = row < ML ? (row & ~(SEQ - 1)) : ML + ((row - ML) & ~(CTX - 1)), s1 = s0 + (row < ML ? SEQ : CTX);
#pragma unroll
    for (int q = 0; q < 2; ++q) {
        const int c0 = ((tid & 31) + 32 * q) * 8;
        float acc[8];
#pragma unroll
        for (int i = 0; i < 8; ++i) acc[i] = 0.f;
#pragma unroll
        for (int j = 0; j < 3; ++j) { const int rr = row + j - 1;
            if (rr >= s0 && rr < s1) { const u32x4 cg = *(const u32x4*)(Z + (size_t)rr * INWP + ZSC + c0), hh = *(const u32x4*)(Z + (size_t)rr * INWP + ZSH + c0);
                const float* wp = P.sc_dw + ((size_t)layer * 3 + j) * 512 + c0; const f32x4 w0 = *(const f32x4*)wp, w1 = *(const f32x4*)(wp + 4);
                const unsigned cw[4] = {cg.x, cg.y, cg.z, cg.w}, hw[4] = {hh.x, hh.y, hh.z, hh.w};
#pragma unroll
                for (int i = 0; i < 4; ++i) { const float wa = i < 2 ? w0[2 * i] : w1[2 * i - 4], wb = i < 2 ? w0[2 * i + 1] : w1[2 * i - 3];
                    acc[2 * i] += wa * bflo(cw[i]) * bflo(hw[i]); acc[2 * i + 1] += wb * bfhi(cw[i]) * bfhi(hw[i]); } } }
        const u32x4 bg = *(const u32x4*)(Z + (size_t)row * INWP + ZSB + c0); const unsigned bw[4] = {bg.x, bg.y, bg.z, bg.w};
        u32x4 o; unsigned ow[4];
#pragma unroll
        for (int i = 0; i < 4; ++i) ow[i] = cvt_pk_bf16(bflo(bw[i]) * acc[2 * i], bfhi(bw[i]) * acc[2 * i + 1]);
        o.x = ow[0]; o.y = ow[1]; o.z = ow[2]; o.w = ow[3];
        *(u32x4*)((bf16_t*)(P.ws + WS_MIX) + (size_t)row * DM + 1024 + c0) = o;
    }
}

namespace att {
constexpr int NW = 8, QBLK = 32, KVBLK = 64;
constexpr float SCALE = 0.07216878364870322f;
constexpr float THR = 8.f;
constexpr int SHM_V = KVBLK * 128 * 2, SHM_K = KVBLK * 192 * 2;
constexpr int OFF_K = 2 * SHM_V, OFF_WS = OFF_K + 2 * SHM_K, OFF_QR = OFF_WS + 2048;
#define KSWZ(row, colB) ((row) * 384 + ((colB) ^ ((((row) >> 1) & 7) << 4)))
#define SBAR() __builtin_amdgcn_sched_barrier(0)
__device__ __forceinline__ int crow(int r, int hi) { return (r & 3) + 8 * (r >> 2) + 4 * hi; }
__device__ __forceinline__ void partialSM(f32x16& p0, f32x16& p1, float& m_reg, float& mn, float& alpha) {
    constexpr float C = SCALE * 1.4426950408889634f;
    float pmax = p0[0];
#pragma unroll
    for (int r = 1; r < 16; ++r) pmax = fmaxf(pmax, p0[r]);
#pragma unroll
    for (int r = 0; r < 16; ++r) pmax = fmaxf(pmax, p1[r]);
    { auto rr = __builtin_amdgcn_permlane32_swap(__float_as_uint(pmax), __float_as_uint(pmax), false, false);
      pmax = fmaxf(__uint_as_float(rr[0]), __uint_as_float(rr[1])); }
    if (__builtin_expect(__all(pmax - m_reg <= THR / SCALE), 1)) { mn = m_reg; alpha = 1.f; }
    else { mn = fmaxf(m_reg, pmax); alpha = __builtin_amdgcn_exp2f((m_reg - mn) * C); m_reg = mn; }
    const float mnC = -mn * C;
#pragma unroll
    for (int r = 0; r < 16; ++r) p0[r] = fmaf(p0[r], C, mnC);
#pragma unroll
    for (int r = 0; r < 16; ++r) p1[r] = fmaf(p1[r], C, mnC);
#pragma unroll
    for (int r = 0; r < 16; ++r) p0[r] = __builtin_amdgcn_exp2f(p0[r]);
}
__device__ __forceinline__ void finishSM(f32x16& p0, f32x16& p1, float alpha, float& l_reg, bf16x8& pa0, bf16x8& pa1, bf16x8& pa2, bf16x8& pa3) {
#pragma unroll
    for (int r = 0; r < 16; ++r) p1[r] = __builtin_amdgcn_exp2f(p1[r]);
    float ps = 0;
#pragma unroll
    for (int r = 0; r < 16; ++r) ps += p0[r];
#pragma unroll
    for (int r = 0; r < 16; ++r) ps += p1[r];
    { auto rr = __builtin_amdgcn_permlane32_swap(__float_as_uint(ps), __float_as_uint(ps), false, false);
      ps = __uint_as_float(rr[0]) + __uint_as_float(rr[1]); }
    l_reg = l_reg * alpha + ps;
#define PK4(Pv, BASE, OUT) do { unsigned a0 = cvt_pk_bf16(Pv[BASE + 0], Pv[BASE + 1]), a1 = cvt_pk_bf16(Pv[BASE + 2], Pv[BASE + 3]);   \
    unsigned b0 = cvt_pk_bf16(Pv[BASE + 4], Pv[BASE + 5]), b1 = cvt_pk_bf16(Pv[BASE + 6], Pv[BASE + 7]);                              \
    auto r0 = __builtin_amdgcn_permlane32_swap(a0, b0, false, false); auto r1 = __builtin_amdgcn_permlane32_swap(a1, b1, false, false); \
    u32x4 w = {r0[0], r1[0], r0[1], r1[1]}; OUT = *reinterpret_cast<bf16x8*>(&w); } while (0)
    PK4(p0, 0, pa0); PK4(p0, 8, pa1); PK4(p1, 0, pa2); PK4(p1, 8, pa3);
#undef PK4
}
__device__ __forceinline__ void qkt(f32x16& p0, f32x16& p1, const LAS unsigned char* Ks, const bf16x8* qr, const LAS unsigned char* qrp, int qsw, const int (&kq)[4], int hi) {
    p0 = f32x16{}; p1 = f32x16{};
#pragma unroll
    for (int d0 = 0; d0 < 12; ++d0) {
        const bf16x8 b0 = *(const LAS bf16x8*)(Ks + kq[d0 & 3] + 128 * (d0 >> 2));
        const bf16x8 b1 = *(const LAS bf16x8*)(Ks + kq[d0 & 3] + 128 * (d0 >> 2) + 32 * 384);
        bf16x8 qv; if (d0 < 8) qv = qr[d0]; else qv = *(const LAS bf16x8*)(qrp + (((2 * (d0 - 8) + hi) ^ qsw) << 4));
        p0 = __builtin_amdgcn_mfma_f32_32x32x16_bf16(b0, qv, p0, 0, 0, 0);
        p1 = __builtin_amdgcn_mfma_f32_32x32x16_bf16(b1, qv, p1, 0, 0, 0); }
}
__device__ __forceinline__ int v_st(int k, int c) { const int kk = (k & ~0xC) | ((k & 4) << 1) | ((k & 8) >> 1); return ((kk >> 3) * 4 + (c >> 5)) * 512 + ((kk & 7) * 32 + (c & 31)) * 2; }
__device__ __forceinline__ int v_rd_base(int lane) { return ((lane & 3) << 3) | (((lane >> 2) & 3) << 6) | (((lane >> 4) & 1) << 5) | (((lane >> 5) & 1) << 8); }
constexpr int v_rd_off(int d0, int ks, int half) { return d0 * 512 + ks * 4096 + half * 2048; }
template <int OFF> __device__ __forceinline__ s16x4 tr_read(int vb) {
    s16x4 r; asm volatile("ds_read_b64_tr_b16 %0, %1 offset:%2" : "=&v"(r) : "v"(vb), "i"(OFF) : "memory"); return r;
}
template <int D0> __device__ __forceinline__ void pv_one(f32x16& od, int vb, bf16x8 pa0, bf16x8 pa1, bf16x8 pa2, bf16x8 pa3) {
    const s16x4 l0 = tr_read<v_rd_off(D0, 0, 0)>(vb), h0 = tr_read<v_rd_off(D0, 0, 1)>(vb), l1 = tr_read<v_rd_off(D0, 1, 0)>(vb), h1 = tr_read<v_rd_off(D0, 1, 1)>(vb);
    const s16x4 l2 = tr_read<v_rd_off(D0, 2, 0)>(vb), h2 = tr_read<v_rd_off(D0, 2, 1)>(vb), l3 = tr_read<v_rd_off(D0, 3, 0)>(vb), h3 = tr_read<v_rd_off(D0, 3, 1)>(vb);
    asm volatile("s_waitcnt lgkmcnt(0)" ::: "memory"); SBAR();
#define PK(Lo, Hi) (bf16x8){Lo[0], Lo[1], Lo[2], Lo[3], Hi[0], Hi[1], Hi[2], Hi[3]}
    od = __builtin_amdgcn_mfma_f32_32x32x16_bf16(pa0, PK(l0, h0), od, 0, 0, 0);
    od = __builtin_amdgcn_mfma_f32_32x32x16_bf16(pa1, PK(l1, h1), od, 0, 0, 0);
    od = __builtin_amdgcn_mfma_f32_32x32x16_bf16(pa2, PK(l2, h2), od, 0, 0, 0);
    od = __builtin_amdgcn_mfma_f32_32x32x16_bf16(pa3, PK(l3, h3), od, 0, 0, 0);
#undef PK
}
__device__ __forceinline__ void pv_d0(f32x16* o, int vb, bf16x8 pa0, bf16x8 pa1, bf16x8 pa2, bf16x8 pa3) {
    pv_one<0>(o[0], vb, pa0, pa1, pa2, pa3); pv_one<1>(o[1], vb, pa0, pa1, pa2, pa3); pv_one<2>(o[2], vb, pa0, pa1, pa2, pa3); pv_one<3>(o[3], vb, pa0, pa1, pa2, pa3);
}
template <bool DIRECT>
__device__ __forceinline__ void attn_unit(LAS unsigned char* lds, const bf16_t* QKV, const bf16_t* Z, int qrow0, int h, int crow0, int lrow0, int t0, int NT,
                                          float* Opart, float* Lse, bf16_t* MIX, const int tid) {
    const int wid = tid >> 6, lane = tid & 63, r32 = lane & 31, hi = lane >> 5;
    LAS unsigned char* V_lds = lds; LAS unsigned char* K_lds = lds + OFF_K;
    LAS float* ws = (LAS float*)(lds + OFF_WS) + wid * 64; LAS float* li_l = ws; LAS float* al_l = ws + 32;
    float m_reg = -1e30f, l_reg = 0; f32x16 o[4] = {}; bf16x8 qr[8];
    const bf16_t* Qw = QKV + (size_t)(qrow0 + wid * QBLK + r32) * NUP + h * 192 + hi * 8;
#pragma unroll
    for (int d0 = 0; d0 < 8; ++d0) qr[d0] = *(const bf16x8*)(Qw + d0 * 16);
    LAS unsigned char* qrp = lds + OFF_QR + wid * 4096 + r32 * 128; const int qsw = (r32 >> 1) & 7;
    int kq[4];
#pragma unroll
    for (int q = 0; q < 4; ++q) kq[q] = 384 * r32 + (((2 * q + hi) ^ qsw) << 4);
#pragma unroll
    for (int d0 = 8; d0 < 12; ++d0) *(LAS bf16x8*)(qrp + (((2 * (d0 - 8) + hi) ^ qsw) << 4)) = *(const bf16x8*)(Qw + d0 * 16);
    const int sr = tid >> 4, sc = (tid & 15) * 8;
    const int vst0 = v_st(sr, sc);
    const int kst0 = KSWZ(sr, sc * 2);
    const int krst = KSWZ(tid >> 3, 256 + (tid & 7) * 16);
    const unsigned voffV = (unsigned)(sr * NUP + sc) * 2u, voffR = (unsigned)((tid >> 3) * INWP + (tid & 7) * 8) * 2u;
    const char* Vb = (const char*)(QKV + 768 + h * 256 + 128); const char* Kb = (const char*)(QKV + 768 + h * 256); const char* Rb = (const char*)(Z + ZKR);
    const int vb0 = (int)(uintptr_t)V_lds + v_rd_base(lane);
    bf16x8 vs0, vs1, ks0, ks1, ks2;
#define ROW0(kt) (((t0) + (kt)) < 4 ? crow0 + 64 * ((t0) + (kt)) : lrow0 + 64 * ((t0) + (kt) - 4))
#define SLOADV(kt) do { const size_t _r0 = (size_t)__builtin_amdgcn_readfirstlane(ROW0(kt)); const char* _v = Vb + _r0 * (NUP * 2) + voffV; \
    vs0 = *(const bf16x8*)(_v); vs1 = *(const bf16x8*)(_v + 32 * NUP * 2); } while (0)
#define SLOADK(kt) do { const size_t _r0 = (size_t)__builtin_amdgcn_readfirstlane(ROW0(kt)); const char* _k = Kb + _r0 * (NUP * 2) + voffV; \
    ks0 = *(const bf16x8*)(_k); ks1 = *(const bf16x8*)(_k + 32 * NUP * 2); ks2 = *(const bf16x8*)(Rb + _r0 * (INWP * 2) + voffR); } while (0)
#define SLOAD(kt) do { SLOADV(kt); SLOADK(kt); } while (0)
#define SWRITE(b) do { *(LAS bf16x8*)(V_lds + (b) * SHM_V + vst0) = vs0; *(LAS bf16x8*)(V_lds + (b) * SHM_V + vst0 + 8192) = vs1; \
    *(LAS bf16x8*)(K_lds + (b) * SHM_K + kst0) = ks0; *(LAS bf16x8*)(K_lds + (b) * SHM_K + kst0 + 32 * 384) = ks1; *(LAS bf16x8*)(K_lds + (b) * SHM_K + krst) = ks2; } while (0)
#define SWAIT() asm volatile("s_waitcnt vmcnt(0)" ::: "memory")
#define RESC(a) do { if (__any((a) < 1.f)) { if (hi == 0) al_l[r32] = (a); asm volatile("s_waitcnt lgkmcnt(0)" ::: "memory"); \
    _Pragma("unroll") for (int d = 0; d < 4; ++d) _Pragma("unroll") for (int r = 0; r < 16; ++r) o[d][r] *= al_l[crow(r, hi)]; } } while (0)
    f32x16 pA0, pA1, pB0, pB1; float mnA, mnB, alA, alB; bf16x8 pa0, pa1, pa2, pa3;
    SLOAD(0); SWAIT(); SWRITE(0); __syncthreads();
    qkt(pA0, pA1, K_lds, qr, qrp, qsw, kq, hi); partialSM(pA0, pA1, m_reg, mnA, alA);
    SLOAD(1);
    SWAIT(); SWRITE(1); __syncthreads();
    for (int j = 1; j + 1 < NT; j += 2) {
        SBAR(); qkt(pB0, pB1, K_lds + SHM_K, qr, qrp, qsw, kq, hi);
        finishSM(pA0, pA1, alA, l_reg, pa0, pa1, pa2, pa3); SBAR();
        SLOADV(j + 1); SBAR();
        pv_d0(o, vb0, pa0, pa1, pa2, pa3); SBAR(); SLOADK(j + 1); SBAR(); partialSM(pB0, pB1, m_reg, mnB, alB);
        __syncthreads(); SWAIT(); SWRITE(0);
        RESC(alB); __syncthreads();
        SBAR(); qkt(pA0, pA1, K_lds, qr, qrp, qsw, kq, hi);
        finishSM(pB0, pB1, alB, l_reg, pa0, pa1, pa2, pa3); SBAR();
        SLOADV(j + 2); SBAR();
        pv_d0(o, vb0 + SHM_V, pa0, pa1, pa2, pa3); SBAR(); SLOADK(j + 2); SBAR(); partialSM(pA0, pA1, m_reg, mnA, alA);
        __syncthreads(); SWAIT(); SWRITE(1);
        RESC(alA); __syncthreads();
    }
    SBAR(); qkt(pB0, pB1, K_lds + SHM_K, qr, qrp, qsw, kq, hi);
    finishSM(pA0, pA1, alA, l_reg, pa0, pa1, pa2, pa3); SBAR();
    pv_d0(o, vb0, pa0, pa1, pa2, pa3); partialSM(pB0, pB1, m_reg, mnB, alB);
    __syncthreads(); RESC(alB);
    finishSM(pB0, pB1, alB, l_reg, pa0, pa1, pa2, pa3); SBAR();
    pv_d0(o, vb0 + SHM_V, pa0, pa1, pa2, pa3);
    if (hi == 0) li_l[r32] = l_reg; asm volatile("s_waitcnt lgkmcnt(0)" ::: "memory");
    float rli[16];
#pragma unroll
    for (int r = 0; r < 16; ++r) rli[r] = __builtin_amdgcn_rcpf(li_l[crow(r, hi)]);
    const int qw0 = qrow0 + wid * QBLK;
    if constexpr (DIRECT) {
#pragma unroll
        for (int r = 0; r < 16; ++r) { const int orow = crow(r, hi);
#pragma unroll
            for (int d0 = 0; d0 < 4; ++d0) MIX[(size_t)(qw0 + orow) * DM + 1536 + h * 128 + d0 * 32 + r32] = f2bf(o[d0][r] * rli[r]); }
    } else {
#pragma unroll
        for (int r = 0; r < 16; ++r) { const int orow = crow(r, hi);
#pragma unroll
            for (int d0 = 0; d0 < 4; ++d0) Opart[(size_t)(qw0 + orow) * 512 + h * 128 + d0 * 32 + r32] = o[d0][r] * rli[r]; }
        if (hi == 0) Lse[(size_t)(qw0 + r32) * 4 + h] = m_reg * (SCALE * 1.4426950408889634f) + __builtin_amdgcn_logf(l_reg);
    }
    __syncthreads();
#undef ROW0
#undef SLOAD
#undef SWRITE
#undef SWAIT
#undef RESC
}
#undef KSWZ
#undef SBAR
}

__device__ __forceinline__ void attn_combine(const Params& P, int tid, int G, int bid) {
    const float* OP = (const float*)(P.ws + WS_OP); const float* LS = (const float*)(P.ws + WS_LSE); bf16_t* MIX = (bf16_t*)(P.ws + WS_MIX);
    for (int i = bid * 512 + tid; i < ML * 64; i += G * 512) {
        const int row = i >> 6, rem = i & 63, h = rem >> 4, cg = (rem & 15) * 8;
        const float l1 = LS[(size_t)row * 4 + h], l2 = LS[((size_t)ML + row) * 4 + h], m = fmaxf(l1, l2);
        float w1 = __builtin_amdgcn_exp2f(l1 - m), w2 = __builtin_amdgcn_exp2f(l2 - m); const float inv = 1.0f / (w1 + w2); w1 *= inv; w2 *= inv;
        const float* a = OP + (size_t)row * 512 + h * 128 + cg; const float* b = OP + ((size_t)ML + row) * 512 + h * 128 + cg;
        const f32x4 a0 = *(const f32x4*)a, a1 = *(const f32x4*)(a + 4), b0 = *(const f32x4*)b, b1 = *(const f32x4*)(b + 4);
        const f32x4 o0 = a0 * w1 + b0 * w2, o1 = a1 * w1 + b1 * w2;
        u32x4 w; w.x = cvt_pk_bf16(o0[0], o0[1]); w.y = cvt_pk_bf16(o0[2], o0[3]); w.z = cvt_pk_bf16(o1[0], o1[1]); w.w = cvt_pk_bf16(o1[2], o1[3]);
        *(u32x4*)(MIX + (size_t)row * DM + 1536 + h * 128 + cg) = w;
    }
}

constexpr int PH_PER_LAYER = 9, N_PHASES = 2 + DEPTH * PH_PER_LAYER + 1;
typedef const __attribute__((address_space(4))) Params* KParams;
__global__ void __launch_bounds__(512, 2) mk_fwd(Params Pk) {
    extern __shared__ __attribute__((aligned(16))) unsigned char lds_raw[];
    LAS unsigned char* lds = (LAS unsigned char*)lds_raw;
    const int G = gridDim.x, bid = blockIdx.x;
    KParams kp0 = (KParams)__builtin_amdgcn_kernarg_segment_ptr();
    const int wave0 = __builtin_amdgcn_readfirstlane(threadIdx.x >> 6);
#define OPQ int tid; asm volatile("v_mbcnt_lo_u32_b32 %0, -1, 0\n\tv_mbcnt_hi_u32_b32 %0, -1, %0" : "=v"(tid)); tid |= wave0 << 6; const int lane = tid & 63, wave = __builtin_amdgcn_readfirstlane(tid >> 6); (void)lane; (void)wave; \
    KParams kp = kp0; asm volatile("" : "+s"(kp)); Params P; {   \
      const GAS float* const __attribute__((address_space(4)))* _q = (const GAS float* const __attribute__((address_space(4)))*)kp; const float** _d = (const float**)&P; \
      _Pragma("unroll") for (int _i = 0; _i < 28; ++_i) _d[_i] = (const float*)_q[_i]; P.ph_lo = kp->ph_lo; P.ph_hi = kp->ph_hi; } \
    unsigned char* const ws = P.ws; (void)ws;
    volatile LAS unsigned* MISC = (volatile LAS unsigned*)(lds + LDS_MISC);
    for (int u = threadIdx.x; u < 256; u += 512) ((LAS unsigned*)(lds + LDS_MISC))[u] = 0u;
    __syncthreads();
    const int lo = kp0->ph_lo, hi = kp0->ph_hi;
    XcdBarrier bar; bar.bar = (unsigned*)(kp0->ws + WS_CTL) + 1024; bar.x = 0; bar.st = nullptr;
    if (hi - lo > 1) bar = xcd_barrier_post((unsigned*)(kp0->ws + WS_CTL) + 1024, MISC + 8);
#define IN(k) (lo <= (k) && (k) < hi)
#define SEAM(k) do { if (IN(k) && IN((k) + 1)) { xcd_barrier(bar); if (PROBE_ID == 21) xcd_barrier(bar); } } while (0)
#define XRES ((float*)(ws + WS_XRES))
#define MODL ((const float*)(ws + WS_MODV) + (size_t)layer * 3 * 6 * DM)
#define RSTAT ((float*)(ws + WS_RSTAT) + (size_t)layer * MT * 2)
#define ROPE ((const f32x2*)(ws + WS_ROPE))
#define HB ((bf16_t*)(ws + WS_H))
#define ZB ((bf16_t*)(ws + WS_Z))
#define QKVB ((bf16_t*)(ws + WS_QKV))
#define MIXB ((bf16_t*)(ws + WS_MIX))
#define UB_ ((bf16_t*)(ws + WS_U))
#define SLAB ((float*)(ws + WS_GU))

    for (int rp = 0; rp < PREP(1); ++rp) { if (PHM(0) && IN(0)) { OPQ phase_p0a(P, lds, tid, lane, wave, G, bid); } if (rp + 1 < PREP(1)) { __syncthreads(); } } SEAM(0);
    if (PHM(1) && IN(1)) { OPQ phase_p0b(P, tid, G, bid); } SEAM(1);

    for (int layer = 0; layer < DEPTH; ++layer) {
        const int pb = 2 + layer * PH_PER_LAYER;
        const bool need_ctx = layer < DEPTH - 1;
        const int mrows = need_ctx ? MT : ML;

        for (int rp = 0; rp < PREP(3); ++rp) if (PHM(2) && IN(pb + 0)) { OPQ
            const float* xl = layer == 0 ? P.x : XRES; const float* xc = layer == 0 ? P.ctx : XRES + (size_t)ML * DM;
            phase_norm(lds, xl, xc, MODL, 1, 0, HB, true, SLAB, layer == 0 ? 0 : 11, MODL - (size_t)3 * 6 * DM + ((size_t)2 * 6 + 5) * DM, XRES + (size_t)ML * DM, tid, lane, wave, G, bid); } SEAM(pb + 0);
        for (int rp = 0; rp < PREP(5); ++rp) if (PHM(3) && IN(pb + 1)) { OPQ
            pg8::Gemm g{HB, (const bf16_t*)(ws + WS_WIN) + (size_t)layer * INWP * DM, MT, INWP, DM, DM, DM}; pg8::StaticOrder S; S.init(MT, INWP, G, bid);
            pg8::EpiIn E{ZB, rp == 0 ? RSTAT : (float*)(ws + WS_OP), ROPE};
            pg8::gemm_phase<pg8::EpiIn, pg8::StaticOrder>(lds, g, S, E, tid);
        } SEAM(pb + 1);
        for (int rp = 0; rp < PREP(2); ++rp) {
        for (int rq = 0; rq < PREP(8); ++rq) if (IN(pb + 2)) {
            { OPQ
            for (int r2 = 0; r2 < PREP(16); ++r2) if (PHM(4)) {
                pg8::Gemm g{ZB + ZCQ, (const bf16_t*)(ws + WS_WUP) + (size_t)layer * NUP * KUP, MT, NUP, KUP, INWP, KUP}; pg8::StaticOrder S; S.init(MT, NUP, G, bid);
                pg8::EpiUp E{QKVB, RSTAT, ROPE};
                pg8::gemm_phase<pg8::EpiUp, pg8::StaticOrder>(lds, g, S, E, tid);
            }
            constexpr int N_G1 = 2 * 4 * NCH, N_CF = MT / 16, N_SC = MT / 16;
            const int nup_units = (MT / 256) * (NUP / 256);
            int start = bid - (nup_units % G); if (start < 0) start += G;
#define FIRST_OF(base) ((base) + ((((start) - (base)) % G) + G) % G)
            for (int r2 = 0; r2 < PREP(11); ++r2) if (PHM(5)) gla_g1_loop(lds, P, layer, FIRST_OF(0), N_G1, G, tid, lane, wave);
            }
            { OPQ
            const int nup_units = (MT / 256) * (NUP / 256); constexpr int N_G1 = 2 * 4 * NCH, N_CF = MT / 16;
            int start = bid - (nup_units % G); if (start < 0) start += G;
            for (int r2 = 0; r2 < PREP(12); ++r2) if (PHM(6)) conf_loop(lds, P, layer, FIRST_OF(N_G1) - N_G1, N_CF, G, tid, lane, wave);
            }
            { OPQ
            const int nup_units = (MT / 256) * (NUP / 256); constexpr int N_G1 = 2 * 4 * NCH, N_CF = MT / 16, N_SC = MT / 16;
            int start = bid - (nup_units % G); if (start < 0) start += G;
            for (int r2 = 0; r2 < PREP(17); ++r2) if (PHM(7)) for (int it = FIRST_OF(N_G1 + N_CF); it < N_G1 + N_CF + N_SC; it += G) sconv_item(P, layer, it - N_G1 - N_CF, tid);
#undef FIRST_OF
            }
        } SEAM(pb + 2);
        for (int rq = 0; rq < PREP(9); ++rq) if (IN(pb + 3)) { OPQ
            for (int r2 = 0; r2 < PREP(14); ++r2) if (PHM(8)) gla_g2(P, tid, G, bid);
            for (int r2 = 0; r2 < PREP(13); ++r2) if (PHM(9)) for (int u = bid; u < 256; u += G) {
                const int bh = u & 7, sub = u >> 3, b = bh >> 2, h = bh & 3, qb = sub >> 1, half = sub & 1;
                att::attn_unit<false>(lds, QKVB, ZB, b * SEQ + qb * 256, h, ML + b * CTX, b * SEQ, half * 34, 34,
                                      (float*)(ws + WS_OP) + (size_t)half * ML * 512, (float*)(ws + WS_LSE) + (size_t)half * ML * 4, MIXB, tid);
            }
        } SEAM(pb + 3);
        for (int rq = 0; rq < PREP(10); ++rq) if (IN(pb + 4)) { OPQ
            for (int r2 = 0; r2 < PREP(15); ++r2) if (PHM(10)) gla_g3_loop(lds, P, layer, bid, 2 * 4 * NCH, G, tid, lane, wave);
            for (int r2 = 0; r2 < PREP(18); ++r2) if (PHM(11)) attn_combine(P, tid, G, bid);
            if (PHM(12) && need_ctx) {
                int start = bid - ((2 * 4 * NCH) % G); if (start < 0) start += G;
                for (int u = start; u < 8; u += G) { const int b = u >> 2, h = u & 3;
                    att::attn_unit<true>(lds, QKVB, ZB, ML + b * CTX, h, ML + b * CTX, 0, 0, 4, nullptr, nullptr, MIXB, tid); }
            }
        } SEAM(pb + 4);
        }
        for (int rp = 0; rp < PREP(6); ++rp) if (PHM(13) && IN(pb + 5)) { OPQ
            const float* xl = layer == 0 ? P.x : XRES; const float* xc = layer == 0 ? P.ctx : XRES + (size_t)ML * DM;
            pg8::Gemm g{MIXB, (const bf16_t*)(ws + WS_WOUT) + (size_t)layer * DM * DM, ML, DM, DM, DM, DM}; pg8::StaticOrder S; S.init(ML, DM, G, bid);
            pg8::EpiRes E{xl, xc, rp == 0 ? XRES : (float*)(ws + WS_OP), MODL + 2 * DM};
            pg8::gemm_phase<pg8::EpiRes, pg8::StaticOrder>(lds, g, S, E, tid);
            if (need_ctx) {
                pg8::Gemm g2{MIXB + (size_t)ML * DM, (const bf16_t*)(ws + WS_WOUT) + (size_t)layer * DM * DM, MC, DM, 256, DM, DM}; pg8::SplitKOrder S2; S2.init(8, G, bid);
                pg8::EpiSlab E2{SLAB};
                pg8::gemm_phase<pg8::EpiSlab, pg8::SplitKOrder>(lds, g2, S2, E2, tid);
            }
        } SEAM(pb + 5);
        for (int rp = 0; rp < PREP(3); ++rp) if (PHM(2) && IN(pb + 6)) { OPQ
            const float* xc = layer == 0 ? P.ctx : XRES + (size_t)ML * DM;
            phase_norm(lds, XRES, xc, MODL, 4, 3, HB, need_ctx, SLAB, 8, MODL + ((size_t)2 * 6 + 2) * DM, XRES + (size_t)ML * DM, tid, lane, wave, G, bid); } SEAM(pb + 6);
        for (int rp = 0; rp < PREP(4); ++rp) if (PHM(14) && IN(pb + 7)) { OPQ
            pg8::Gemm g{HB, (const bf16_t*)(ws + WS_W13) + (size_t)layer * 2 * DFF * DM, mrows, 2 * DFF, DM, DM, DM}; pg8::StaticOrder S; S.init(mrows, 2 * DFF, G, bid);
            pg8::EpiSwiglu E{UB_};
            pg8::gemm_phase<pg8::EpiSwiglu, pg8::StaticOrder>(lds, g, S, E, tid);
        } SEAM(pb + 7);
        for (int rp = 0; rp < PREP(7); ++rp) if (PHM(15) && IN(pb + 8)) { OPQ
            pg8::Gemm g{UB_, (const bf16_t*)(ws + WS_W2) + (size_t)layer * DM * DFF, ML, DM, DFF, DFF, DFF}; pg8::StaticOrder S; S.init(ML, DM, G, bid);
            pg8::EpiRes E{XRES, XRES + (size_t)ML * DM, rp == 0 ? XRES : (float*)(ws + WS_OP), MODL + 5 * DM};
            pg8::gemm_phase<pg8::EpiRes, pg8::StaticOrder>(lds, g, S, E, tid);
            if (need_ctx) {
                pg8::Gemm g2{UB_ + (size_t)ML * DFF, (const bf16_t*)(ws + WS_W2) + (size_t)layer * DM * DFF, MC, DM, 512, DFF, DFF}; pg8::SplitKOrder S2; S2.init(11, G, bid);
                pg8::EpiSlab E2{SLAB};
                pg8::gemm_phase<pg8::EpiSlab, pg8::SplitKOrder>(lds, g2, S2, E2, tid);
            }
        } SEAM(pb + 8);
    }
    if (PHM(16) && IN(N_PHASES - 1)) { OPQ phase_final(XRES, P.final_g, P.out, lane, wave, G, bid); }
#undef IN
#undef SEAM
}

extern "C" void kernel_launch(void* const* d_in, const int* in_sizes, int n_in, void* d_out, int out_size, void* d_ws, size_t ws_size, hipStream_t stream) {
    static int grid = 0;
    if (grid == 0) {
        if (n_in != 26 || in_sizes[0] != ML * DM || out_size != ML * DM || ws_size < WS_END) {
            fprintf(stderr, "kernel_launch: shape mismatch: n_in %d in0 %d out %d ws %zu (need %zu); nothing launched\n", n_in, n_in > 0 ? in_sizes[0] : -1, out_size, ws_size, (size_t)WS_END); grid = -1; return; }
        int dev = 0, cus = 0, per_cu = 0;
        if (hipGetDevice(&dev) != hipSuccess || hipDeviceGetAttribute(&cus, hipDeviceAttributeMultiprocessorCount, dev) != hipSuccess) { fprintf(stderr, "kernel_launch: device query failed\n"); grid = -1; return; }
        if (hipFuncSetAttribute((const void*)mk_fwd, hipFuncAttributeMaxDynamicSharedMemorySize, LDS_BYTES) != hipSuccess) { fprintf(stderr, "kernel_launch: hipFuncSetAttribute failed\n"); grid = -1; return; }
        if (hipOccupancyMaxActiveBlocksPerMultiprocessor(&per_cu, (const void*)mk_fwd, 512, LDS_BYTES) != hipSuccess || per_cu < 1)
            fprintf(stderr, "kernel_launch: note: occupancy query reports %d workgroups per CU\n", per_cu);
        (void)hipGetLastError();
        grid = cus;
    }
    if (grid < 0) return;
    if (hipMemsetAsync((char*)d_ws + WS_CTL, 0, CTL_BYTES, stream) != hipSuccess) { fprintf(stderr, "kernel_launch: memset failed\n"); return; }
    Params p{};
    const float** pp = (const float**)&p;
    for (int i = 0; i < 26; ++i) pp[i] = (const float*)d_in[i];
    p.out = (float*)d_out; p.ws = (unsigned char*)d_ws;
#if MK_MULTI
    for (int ph = 0; ph < N_PHASES; ++ph) { p.ph_lo = ph; p.ph_hi = ph + 1; hipLaunchKernelGGL(mk_fwd, dim3(grid), dim3(512), LDS_BYTES, stream, p); }
#else
    p.ph_lo = 0; p.ph_hi = N_PHASES;
    hipLaunchKernelGGL(mk_fwd, dim3(grid), dim3(512), LDS_BYTES, stream, p);
#endif
    const hipError_t le = hipPeekAtLastError();
    if (le != hipSuccess) fprintf(stderr, "kernel_launch: launch failed: %s\n", hipGetErrorName(le));
}
```

```cpp
#include <hip/hip_runtime.h>
#include <cstdio>
#include <cstdint>

#ifndef MK_MULTI
#define MK_MULTI 0
#endif

#ifndef PH_MASK
#define PH_MASK 0xFFFFFFFFu
#endif
#define PHM(b) ((PH_MASK >> (b)) & 1u)
#ifndef PROBE_ID
#define PROBE_ID 0
#endif
#define PREP(id) (PROBE_ID == (id) ? 2 : 1)
#define LAS __attribute__((address_space(3)))
#define GAS __attribute__((address_space(1)))
typedef unsigned short bf16_t;
typedef short bf16x8 __attribute__((ext_vector_type(8)));
typedef short s16x4 __attribute__((ext_vector_type(4)));
typedef float f32x4 __attribute__((ext_vector_type(4)));
typedef float f32x2 __attribute__((ext_vector_type(2)));
typedef float f32x16 __attribute__((ext_vector_type(16)));
typedef unsigned u32x4 __attribute__((ext_vector_type(4)));
typedef unsigned u32x2 __attribute__((ext_vector_type(2)));

constexpr int DM = 2048, NB = 2, SEQ = 4096, CTX = 256, DEPTH = 4, DFF = 5632;
constexpr int ML = NB * SEQ, MC = NB * CTX, MT = ML + MC;
constexpr int INW = 5216, INWP = 5376;
constexpr int ZQ = 0, ZK = 512, ZV = 1024, ZG = 1536, ZLR = 2048, ZCA = 2080, ZCG = 2592, ZSB = 3104, ZSC = 3616, ZSH = 4128, ZCQ = 4640, ZCKV = 5024, ZKR = 5152;
constexpr int NUP = 1792, KUP = 512;
constexpr int NCH = 68;
constexpr float EPS = 1e-6f;

constexpr size_t al256(size_t x) { return (x + 255) / 256 * 256; }
constexpr size_t WS_CTL = 0, CTL_BYTES = 1u << 20;
constexpr size_t WS_ROPE = WS_CTL + CTL_BYTES;
constexpr size_t WS_MODP = WS_ROPE + 8192;
constexpr size_t WS_MODV = WS_MODP + al256((size_t)8 * 4 * 3 * 12288 * 4);
constexpr size_t WS_RSTAT = WS_MODV + al256((size_t)4 * 3 * 6 * 2048 * 4);
constexpr size_t WS_WIN = WS_RSTAT + al256((size_t)4 * MT * 2 * 4);
constexpr size_t WS_WOUT = WS_WIN + (size_t)4 * INWP * DM * 2;
constexpr size_t WS_W13 = WS_WOUT + (size_t)4 * DM * DM * 2;
constexpr size_t WS_W2 = WS_W13 + (size_t)4 * 2 * DFF * DM * 2;
constexpr size_t WS_WUP = WS_W2 + (size_t)4 * DM * DFF * 2;
constexpr size_t WS_XRES = WS_WUP + (size_t)4 * NUP * KUP * 2;
constexpr size_t WS_H = WS_XRES + (size_t)MT * DM * 4;
constexpr size_t WS_Z = WS_H + (size_t)MT * DM * 2;
constexpr size_t WS_QKV = WS_Z + (size_t)MT * INWP * 2;
constexpr size_t WS_MIX = WS_QKV + (size_t)MT * NUP * 2;
constexpr size_t WS_U = WS_MIX + (size_t)MT * DM * 2;
constexpr size_t WS_GU = WS_U + (size_t)MT * DFF * 2;
constexpr size_t WS_GD = WS_GU + (size_t)16 * NCH * 16384 * 4;
constexpr size_t WS_GS = WS_GD + (size_t)16 * NCH * 128 * 4;
constexpr size_t WS_OP = WS_GS + (size_t)16 * NCH * 16384 * 2;
constexpr size_t WS_LSE = WS_OP + (size_t)2 * ML * 512 * 4;
constexpr size_t WS_END = WS_LSE + (size_t)2 * ML * 4 * 4;

constexpr int LDS_MAIN = 131072, LDS_MISC = LDS_MAIN, LDS_BYTES = LDS_MAIN + 1024;

__device__ __forceinline__ unsigned cvt_pk_bf16(float lo, float hi) { unsigned r; asm volatile("v_cvt_pk_bf16_f32 %0, %1, %2" : "=v"(r) : "v"(lo), "v"(hi)); return r; }
__device__ __forceinline__ float bf2f(unsigned short b) { return __uint_as_float(((unsigned)b) << 16); }
__device__ __forceinline__ float bflo(unsigned w) { return __uint_as_float(w << 16); }
__device__ __forceinline__ float bfhi(unsigned w) { return __uint_as_float(w & 0xffff0000u); }
__device__ __forceinline__ unsigned short f2bf(float f) { return (unsigned short)(cvt_pk_bf16(f, 0.f) & 0xffffu); }
__device__ __forceinline__ float wave_sum(float v) {
#pragma unroll
    for (int o = 1; o < 64; o <<= 1) v += __shfl_xor(v, o);
    return v;
}
__device__ __forceinline__ float sigmoidf_(float x) { return __builtin_amdgcn_rcpf(1.0f + __builtin_amdgcn_exp2f(-1.4426950408889634f * x)); }
__device__ __forceinline__ float siluf_(float x) { return x * __builtin_amdgcn_rcpf(1.0f + __builtin_amdgcn_exp2f(-1.4426950408889634f * x)); }
__device__ __forceinline__ float dot4(const f32x4& v) { return (v[0] * v[0] + v[1] * v[1]) + (v[2] * v[2] + v[3] * v[3]); }
#define LDS_WAIT() asm volatile("s_waitcnt lgkmcnt(0)" ::: "memory")
#define VM_WAIT() asm volatile("s_waitcnt vmcnt(0)" ::: "memory")

namespace pg8 {
#define PG8_LAS __attribute__((address_space(3)))
constexpr int BM = 256, BK = 64, HALF = 128, HTB = HALF * BK * 2, STAGE_BYTES = 8 * HTB, NXCD = 8, WGM = 8;
__host__ __device__ __forceinline__ int lds_byte(int r, int c) { const int st = (r >> 4) * 2 + (c >> 5), rr = r & 15, cc = c & 31, ob = rr * 64 + cc * 2; return st * 1024 + (ob ^ (((ob >> 9) & 1) << 5)); }
__host__ __device__ __forceinline__ void stage_rc(int b, int& R, int& C) { const int st = b / 1024, sb = b % 1024, swz = sb ^ (((sb >> 9) & 1) << 5); R = (st >> 1) * 16 + swz / 64; C = (st & 1) * 32 + (swz % 64) / 2; }
__host__ __device__ __forceinline__ int perm32(int rho) { const int n = rho >> 4, i = rho & 15; return 8 * (i >> 2) + 4 * n + (i & 3); }
struct Unit { int pm, pn, ks; };
struct Gemm { const bf16_t* A; const bf16_t* Bt; int M, N, K, lda, ldb; };
struct StaticOrder {
    int nM, nN, nwg, G, c;
    __host__ __device__ void init(int M, int N, int G_, int c_) { nM = M / BM; nN = N / BM; nwg = nM * nN; G = G_; c = c_; }
    __host__ __device__ bool next(int i, Unit& u) const {
        const long L = (long)i * G + c; if (L >= nwg) return false;
        int wgid = (int)L; { const int q = nwg / NXCD, r = nwg % NXCD, xcd = wgid % NXCD, off = wgid / NXCD; wgid = (xcd < r ? xcd * (q + 1) : r * (q + 1) + (xcd - r) * q) + off; }
        const int nig = WGM * nN, gid = wgid / nig, fm = gid * WGM, gsz = (nM - fm) < WGM ? (nM - fm) : WGM;
        u.pm = fm + ((wgid % nig) % gsz); u.pn = (wgid % nig) / gsz; u.ks = 0; return true;
    }
    __device__ __forceinline__ void a_ready(const Unit&) const {}
    __device__ __forceinline__ void done(const Unit&) const {}
};
template <class Epi, class Sched, bool ALIGN_EPI = true, bool SP2 = true>
__device__ __forceinline__ void gemm_phase(PG8_LAS unsigned char* lds, const Gemm g, const Sched& S, const Epi& E, const int tid) {
    const int wid = __builtin_amdgcn_readfirstlane(tid >> 6), lane = tid & 63, wr = wid >> 2, wc = wid & 3, fr = lane & 15, fq = lane >> 4;
    const int K = g.K, nt = K / BK;
    unsigned voffA[2], voffB[2];
#pragma unroll
    for (int i = 0; i < 2; ++i) { int R, C; stage_rc(tid * 16 + i * 8192, R, C); const int Rb = Epi::PERM ? ((R & ~31) + perm32(R & 31)) : R;
        voffA[i] = (unsigned)(R * g.lda + C) * 2u; voffB[i] = (unsigned)(Rb * g.ldb + C) * 2u; }
    const size_t kstep = (size_t)(BK * 2);
    const size_t hstepA = (size_t)HALF * g.lda * 2, hstepB = (size_t)HALF * g.ldb * 2;
    const size_t tstepA = 2 * hstepA, tstepB = 2 * hstepB;
    const unsigned ldsw = (unsigned)wid * 1024u;
    const int aoff = lds_byte(wr * 64 + fr, fq * 8), boff = lds_byte(wc * 32 + fr, fq * 8);
#define PG8_SA(b, h) (((b) * 2 + (h)) * HTB)
#define PG8_SB(b, h) ((4 + (b) * 2 + (h)) * HTB)
#define PG8_STAGE(bufoff, gbase, voff) do { _Pragma("unroll") for (int _i = 0; _i < 2; ++_i) \
        __builtin_amdgcn_global_load_lds((const unsigned*)((const char*)(gbase) + (voff)[_i]), (PG8_LAS unsigned*)(lds + (bufoff) + ldsw + _i * 8192), 16, 0, 0); } while (0)
#define PG8_LDA(dst, b, h) do { _Pragma("unroll") for (int m = 0; m < 4; ++m) _Pragma("unroll") for (int k = 0; k < 2; ++k) dst[m][k] = *(const PG8_LAS bf16x8*)(lds + PG8_SA(b, h) + aoff + m * 2048 + k * 1024); } while (0)
#define PG8_LDB(dst, b, h) do { _Pragma("unroll") for (int n = 0; n < 2; ++n) _Pragma("unroll") for (int k = 0; k < 2; ++k) dst[n][k] = *(const PG8_LAS bf16x8*)(lds + PG8_SB(b, h) + boff + n * 2048 + k * 1024); } while (0)
#define PG8_MMA(ai, bj, At, Bt) do { __builtin_amdgcn_s_setprio(1); _Pragma("unroll") for (int m = 0; m < 4; ++m) _Pragma("unroll") for (int n = 0; n < 2; ++n) _Pragma("unroll") for (int k = 0; k < 2; ++k) \
        acc[ai][bj][m][n] = __builtin_amdgcn_mfma_f32_16x16x32_bf16(Bt[n][k], At[m][k], acc[ai][bj][m][n], 0, 0, 0); __builtin_amdgcn_s_setprio(0); } while (0)
#define PG8_WAIT_V(n) asm volatile("s_waitcnt vmcnt(" #n ")" ::: "memory")
#define PG8_WAIT_L(n) asm volatile("s_waitcnt lgkmcnt(" #n ")" ::: "memory")
#define PG8_BAR __builtin_amdgcn_s_barrier()
#define PG8_SCHED __builtin_amdgcn_sched_barrier(0)
    Unit cur, nxt; int ui = 0;
    if (!S.next(0, cur)) return;
    f32x4 acc[2][2][4][2];
#pragma unroll
    for (int a = 0; a < 2; ++a)
#pragma unroll
        for (int b = 0; b < 2; ++b)
#pragma unroll
            for (int m = 0; m < 4; ++m)
#pragma unroll
                for (int n = 0; n < 2; ++n) acc[a][b][m][n] = (f32x4){0.f, 0.f, 0.f, 0.f};
    bf16x8 At[4][2], B0[2][2], B1[2][2];
    const size_t kspan = (size_t)K * 2;
    const char* cA = (const char*)g.A + (size_t)cur.pm * tstepA + (size_t)cur.ks * kspan; const char* cB = (const char*)g.Bt + (size_t)cur.pn * tstepB + (size_t)cur.ks * kspan;
    S.a_ready(cur);
    if constexpr (SP2) {
        PG8_STAGE(PG8_SB(0, 0), cB, voffB); PG8_STAGE(PG8_SB(0, 1), cB + hstepB, voffB); PG8_STAGE(PG8_SA(0, 0), cA, voffA); PG8_STAGE(PG8_SA(0, 1), cA + hstepA, voffA);
        if (wr == 1) PG8_BAR;
        PG8_WAIT_V(2); PG8_BAR;
        PG8_STAGE(PG8_SB(1, 0), cB + kstep, voffB); PG8_STAGE(PG8_SA(1, 0), cA + kstep, voffA); PG8_STAGE(PG8_SB(1, 1), cB + hstepB + kstep, voffB);
        PG8_WAIT_V(6); PG8_BAR;
    } else {
        PG8_STAGE(PG8_SB(0, 0), cB, voffB); PG8_STAGE(PG8_SA(0, 0), cA, voffA); PG8_STAGE(PG8_SB(0, 1), cB + hstepB, voffB); PG8_STAGE(PG8_SA(0, 1), cA + hstepA, voffA);
        if (wr == 1) PG8_BAR;
        PG8_WAIT_V(4); PG8_BAR;
        PG8_STAGE(PG8_SB(1, 0), cB + kstep, voffB); PG8_STAGE(PG8_SA(1, 0), cA + kstep, voffA); PG8_STAGE(PG8_SB(1, 1), cB + hstepB + kstep, voffB);
        PG8_WAIT_V(6); PG8_BAR;
    }
    for (;;) {
        const bool has_next = S.next(ui + 1, nxt);
        const char* nA = has_next ? (const char*)g.A + (size_t)nxt.pm * tstepA + (size_t)nxt.ks * kspan : cA; const char* nB = has_next ? (const char*)g.Bt + (size_t)nxt.pn * tstepB + (size_t)nxt.ks * kspan : cB;
        for (int t = 0; t < nt; t += 2) {
            const bool last = (t == nt - 2);
            const char* a1 = cA + (size_t)(t + 1) * kstep;
            const char* a2 = last ? nA : cA + (size_t)(t + 2) * kstep; const char* b2 = last ? nB : cB + (size_t)(t + 2) * kstep;
            const char* a3 = a2 + kstep; const char* b3 = b2 + kstep;
            if (last && has_next) S.a_ready(nxt);
            if constexpr (SP2) {
            PG8_LDB(B0, 0, 0); PG8_LDB(B1, 0, 1); PG8_SCHED; PG8_LDA(At, 0, 0); PG8_STAGE(PG8_SA(1, 1), a1 + hstepA, voffA);
            PG8_WAIT_V(8); PG8_WAIT_L(0); PG8_BAR; PG8_MMA(0, 0, At, B0); PG8_MMA(0, 1, At, B1); PG8_BAR; PG8_SCHED;
            PG8_LDA(At, 0, 1); PG8_STAGE(PG8_SB(0, 0), b2, voffB); PG8_STAGE(PG8_SB(0, 1), b2 + hstepB, voffB); PG8_STAGE(PG8_SA(0, 0), a2, voffA);
            PG8_WAIT_V(8); PG8_WAIT_L(0); PG8_BAR; PG8_MMA(1, 0, At, B0); PG8_MMA(1, 1, At, B1); PG8_BAR; PG8_SCHED;
            PG8_LDB(B0, 1, 0); PG8_LDB(B1, 1, 1); PG8_SCHED; PG8_LDA(At, 1, 0); PG8_STAGE(PG8_SA(0, 1), a2 + hstepA, voffA);
            PG8_WAIT_V(8); PG8_WAIT_L(0); PG8_BAR; PG8_MMA(0, 0, At, B0); PG8_MMA(0, 1, At, B1); PG8_BAR; PG8_SCHED;
            PG8_LDA(At, 1, 1); PG8_STAGE(PG8_SB(1, 0), b3, voffB); PG8_STAGE(PG8_SB(1, 1), b3 + hstepB, voffB); PG8_STAGE(PG8_SA(1, 0), a3, voffA);
            PG8_WAIT_V(8); PG8_WAIT_L(0); PG8_BAR; PG8_MMA(1, 0, At, B0); PG8_MMA(1, 1, At, B1); PG8_BAR; PG8_SCHED;
            } else {
            PG8_LDB(B0, 0, 0); PG8_SCHED; PG8_LDA(At, 0, 0); PG8_STAGE(PG8_SA(1, 1), a1 + hstepA, voffA);
            PG8_WAIT_L(8); PG8_BAR; PG8_WAIT_L(0); PG8_MMA(0, 0, At, B0); PG8_BAR; PG8_SCHED;
            PG8_LDB(B1, 0, 1); PG8_STAGE(PG8_SB(0, 0), b2, voffB);
            PG8_BAR; PG8_WAIT_L(0); PG8_MMA(0, 1, At, B1); PG8_BAR;
            PG8_LDA(At, 0, 1); PG8_STAGE(PG8_SA(0, 0), a2, voffA);
            PG8_BAR; PG8_WAIT_L(0); PG8_MMA(1, 0, At, B0); PG8_BAR; PG8_SCHED;
            PG8_STAGE(PG8_SB(0, 1), b2 + hstepB, voffB);
            PG8_WAIT_V(6); PG8_BAR; PG8_MMA(1, 1, At, B1); PG8_BAR;
            PG8_LDB(B0, 1, 0); PG8_SCHED; PG8_LDA(At, 1, 0); PG8_STAGE(PG8_SA(0, 1), a2 + hstepA, voffA);
            PG8_WAIT_L(8); PG8_BAR; PG8_WAIT_L(0); PG8_MMA(0, 0, At, B0); PG8_BAR; PG8_SCHED;
            PG8_LDB(B1, 1, 1); PG8_STAGE(PG8_SB(1, 0), b3, voffB);
            PG8_BAR; PG8_WAIT_L(0); PG8_MMA(0, 1, At, B1); PG8_BAR;
            PG8_LDA(At, 1, 1); PG8_STAGE(PG8_SA(1, 0), a3, voffA);
            PG8_BAR; PG8_WAIT_L(0); PG8_MMA(1, 0, At, B0); PG8_BAR; PG8_SCHED;
            PG8_STAGE(PG8_SB(1, 1), b3 + hstepB, voffB);
            PG8_WAIT_V(6); PG8_BAR; PG8_MMA(1, 1, At, B1); PG8_BAR;
            }
        }
        if constexpr (ALIGN_EPI) { if (wr == 0) PG8_BAR; }
        E(acc, cur, wr, wc, fr, fq);
        if (!has_next) break;
#pragma unroll
        for (int a = 0; a < 2; ++a)
#pragma unroll
            for (int b = 0; b < 2; ++b)
#pragma unroll
                for (int m = 0; m < 4; ++m)
#pragma unroll
                    for (int n = 0; n < 2; ++n) acc[a][b][m][n] = (f32x4){0.f, 0.f, 0.f, 0.f};
        cur = nxt; cA = nA; cB = nB; ++ui;
        if constexpr (ALIGN_EPI) { if (wr == 1) PG8_BAR; }
    }
    PG8_WAIT_V(0);
    if constexpr (!ALIGN_EPI) { if (wr == 0) PG8_BAR; }
    PG8_BAR;
#undef PG8_SA
#undef PG8_SB
#undef PG8_STAGE
#undef PG8_LDA
#undef PG8_LDB
#undef PG8_MMA
#undef PG8_WAIT_V
#undef PG8_WAIT_L
#undef PG8_BAR
#undef PG8_SCHED
}

struct SplitKOrder {
    int nunits, G, c;
    __host__ __device__ void init(int nsplit, int G_, int c_) { nunits = 16 * nsplit; G = G_; c = c_; }
    __host__ __device__ bool next(int i, Unit& u) const { const int L = i * G + c; if (L >= nunits) return false; u.pm = L & 1; const int rest = L >> 1; u.pn = rest & 7; u.ks = rest >> 3; return true; }
    __device__ __forceinline__ void a_ready(const Unit&) const {}
    __device__ __forceinline__ void done(const Unit&) const {}
};
__device__ __forceinline__ void rope8(f32x4& v0, f32x4& v1, const f32x2* cs) {
    const f32x2 c0 = cs[0], c1 = cs[1], c2 = cs[2], c3 = cs[3];
    float a, b;
    a = v0[0]; b = v0[1]; v0[0] = a * c0.x - b * c0.y; v0[1] = b * c0.x + a * c0.y;
    a = v0[2]; b = v0[3]; v0[2] = a * c1.x - b * c1.y; v0[3] = b * c1.x + a * c1.y;
    a = v1[0]; b = v1[1]; v1[0] = a * c2.x - b * c2.y; v1[1] = b * c2.x + a * c2.y;
    a = v1[2]; b = v1[3]; v1[2] = a * c3.x - b * c3.y; v1[3] = b * c3.x + a * c3.y;
}

struct EpiIn {
    static constexpr bool PERM = true;
    bf16_t* Z; float* rstat; const f32x2* rope;
    __device__ __forceinline__ void operator()(const f32x4 (&acc)[2][2][4][2], const Unit& u, int wr, int wc, int fr, int fq) const {
        const int row0 = u.pm * BM + wr * 64 + fr; const int colw0 = u.pn * BM + wc * 32;
        const bool special = (u.pn >= 18);
#pragma unroll
        for (int ai = 0; ai < 2; ++ai)
#pragma unroll
            for (int m = 0; m < 4; ++m) {
                const int row = row0 + ai * HALF + m * 16;
                bf16_t* rowp = Z + (size_t)row * INWP + colw0 + 8 * fq;
                float sq = 0.f, skv = 0.f;
#pragma unroll
                for (int bj = 0; bj < 2; ++bj) {
                    f32x4 v0 = acc[ai][bj][m][0], v1 = acc[ai][bj][m][1];
                    if (special) {
                        const int colw = colw0 + bj * HALF;
                        if (colw >= ZCQ && colw < ZCKV) sq += dot4(v0) + dot4(v1);
                        else if (colw >= ZCKV && colw < ZKR) skv += dot4(v0) + dot4(v1);
                        else if (colw >= ZKR && colw < INW && u.pm < 32) {
                            const int axis = (colw - ZKR) >> 5, t = row & (SEQ - 1), pos = axis ? (t & 63) : (t >> 6);
                            rope8(v0, v1, rope + pos * 16 + 4 * fq);
                        }
                    }
                    u32x4 w; w.x = cvt_pk_bf16(v0[0], v0[1]); w.y = cvt_pk_bf16(v0[2], v0[3]); w.z = cvt_pk_bf16(v1[0], v1[1]); w.w = cvt_pk_bf16(v1[2], v1[3]);
                    *(u32x4*)(rowp + bj * HALF) = w;
                }
                if (special) {
                    sq += __shfl_xor(sq, 16); sq += __shfl_xor(sq, 32); skv += __shfl_xor(skv, 16); skv += __shfl_xor(skv, 32);
                    if (fq == 0) { if (sq != 0.f) atomicAdd(rstat + (size_t)row * 2, sq); if (skv != 0.f) atomicAdd(rstat + (size_t)row * 2 + 1, skv); }
                }
            }
    }
};
struct EpiUp {
    static constexpr bool PERM = true;
    bf16_t* O; const float* rstat; const f32x2* rope;
    __device__ __forceinline__ void operator()(const f32x4 (&acc)[2][2][4][2], const Unit& u, int wr, int wc, int fr, int fq) const {
        const int row0 = u.pm * BM + wr * 64 + fr; const int colw0 = u.pn * BM + wc * 32;
#pragma unroll
        for (int ai = 0; ai < 2; ++ai)
#pragma unroll
            for (int m = 0; m < 4; ++m) {
                const int row = row0 + ai * HALF + m * 16;
                const f32x2 ss = *(const f32x2*)(rstat + (size_t)row * 2);
                const float rq = rsqrtf(ss.x * (1.0f / 384.0f) + EPS), rkv = rsqrtf(ss.y * (1.0f / 128.0f) + EPS);
                bf16_t* rowp = O + (size_t)row * NUP + colw0 + 8 * fq;
#pragma unroll
                for (int bj = 0; bj < 2; ++bj) {
                    const int colw = colw0 + bj * HALF;
                    const float sc = colw < 768 ? rq : rkv;
                    f32x4 v0 = acc[ai][bj][m][0] * sc, v1 = acc[ai][bj][m][1] * sc;
                    if (colw < 768 && u.pm < 32) {
                        const int within = colw % 192;
                        if (within >= 128) { const int axis = (within - 128) >> 5, t = row & (SEQ - 1), pos = axis ? (t & 63) : (t >> 6); rope8(v0, v1, rope + pos * 16 + 4 * fq); }
                    }
                    u32x4 w; w.x = cvt_pk_bf16(v0[0], v0[1]); w.y = cvt_pk_bf16(v0[2], v0[3]); w.z = cvt_pk_bf16(v1[0], v1[1]); w.w = cvt_pk_bf16(v1[2], v1[3]);
                    *(u32x4*)(rowp + bj * HALF) = w;
                }
            }
    }
};
struct EpiRes {
    static constexpr bool PERM = false;
    const float* base_lat; const float* base_ctx; float* out; const float* gate;
    __device__ __forceinline__ void operator()(const f32x4 (&acc)[2][2][4][2], const Unit& u, int wr, int wc, int fr, int fq) const {
        const int row0 = u.pm * BM + wr * 64 + fr, col0 = u.pn * BM + wc * 32 + 4 * fq;
        const int r = u.pm < 16 ? 0 : (u.pm < 32 ? 1 : 2);
        const float* gp = gate + (size_t)r * 6 * DM + col0;
        f32x4 gv[2][2];
#pragma unroll
        for (int bj = 0; bj < 2; ++bj)
#pragma unroll
            for (int n = 0; n < 2; ++n) gv[bj][n] = *(const f32x4*)(gp + bj * HALF + n * 16);
#pragma unroll
        for (int ai = 0; ai < 2; ++ai)
#pragma unroll
            for (int m = 0; m < 4; ++m) {
                const int row = row0 + ai * HALF + m * 16;
                const float* bp = (u.pm < 32 ? base_lat + (size_t)row * DM : base_ctx + (size_t)(row - ML) * DM) + col0;
                float* op = out + (size_t)row * DM + col0;
#pragma unroll
                for (int bj = 0; bj < 2; ++bj)
#pragma unroll
                    for (int n = 0; n < 2; ++n) { const f32x4 b = *(const f32x4*)(bp + bj * HALF + n * 16); *(f32x4*)(op + bj * HALF + n * 16) = b + gv[bj][n] * acc[ai][bj][m][n]; }
            }
    }
};
struct EpiSlab {
    static constexpr bool PERM = false;
    float* slab;
    __device__ __forceinline__ void operator()(const f32x4 (&acc)[2][2][4][2], const Unit& u, int wr, int wc, int fr, int fq) const {
        const int row0 = u.pm * BM + wr * 64 + fr, col0 = u.pn * BM + wc * 32 + 4 * fq;
#pragma unroll
        for (int ai = 0; ai < 2; ++ai)
#pragma unroll
            for (int m = 0; m < 4; ++m) { float* op = slab + ((size_t)u.ks * MC + row0 + ai * HALF + m * 16) * DM + col0;
#pragma unroll
                for (int bj = 0; bj < 2; ++bj)
#pragma unroll
                    for (int n = 0; n < 2; ++n) *(f32x4*)(op + bj * HALF + n * 16) = acc[ai][bj][m][n]; }
    }
};
struct EpiSwiglu {
    static constexpr bool PERM = true;
    bf16_t* U;
    __device__ __forceinline__ void operator()(const f32x4 (&acc)[2][2][4][2], const Unit& u, int wr, int wc, int fr, int fq) const {
        const int row0 = u.pm * BM + wr * 64 + fr, oc = u.pn * HALF + wc * 32 + 8 * fq;
#pragma unroll
        for (int ai = 0; ai < 2; ++ai)
#pragma unroll
            for (int m = 0; m < 4; ++m) {
                const int row = row0 + ai * HALF + m * 16;
                float o[8];
#pragma unroll
                for (int n = 0; n < 2; ++n)
#pragma unroll
                    for (int j = 0; j < 4; ++j) { const float a = acc[ai][0][m][n][j], b = acc[ai][1][m][n][j]; o[n * 4 + j] = a * b * __builtin_amdgcn_rcpf(1.0f + __builtin_amdgcn_exp2f(-1.4426950408889634f * a)); }
                u32x4 w; w.x = cvt_pk_bf16(o[0], o[1]); w.y = cvt_pk_bf16(o[2], o[3]); w.z = cvt_pk_bf16(o[4], o[5]); w.w = cvt_pk_bf16(o[6], o[7]);
                *(u32x4*)(U + (size_t)row * DFF + oc) = w;
            }
    }
};
}

#define XB_TMO      128
#define XB_XCNT(j)  (256  + 64 * (j))
#define XB_XSUB(j)  (1280 + 64 * (j))
#define XB_XGEN(j)  (2304 + 64 * (j))
#define XB_TOP      3328
#define XB_TOPGEN   3392
#define XCD_BAR_WORDS 3456
#define XB_SPIN_CAP (1u << 18)
__device__ __forceinline__ unsigned xb_ld(unsigned* p)              { return __hip_atomic_load(p, __ATOMIC_RELAXED, __HIP_MEMORY_SCOPE_AGENT); }
__device__ __forceinline__ unsigned xb_add(unsigned* p, unsigned v) { return __hip_atomic_fetch_add(p, v, __ATOMIC_RELAXED, __HIP_MEMORY_SCOPE_AGENT); }
__device__ __forceinline__ unsigned xb_xcc_id() { return (unsigned)__builtin_amdgcn_s_getreg((3 << 11) | 20) & 0xFu; }
#define XB_SPIN(cond, bar) do { unsigned _sp = 0; while (cond) { __builtin_amdgcn_s_sleep(1); \
    if ((++_sp & 255u) == 0u) { if (xb_ld(&(bar)[XB_TMO])) break; if (_sp > XB_SPIN_CAP) { atomicAdd(&(bar)[XB_TMO], 1u); break; } } } } while (0)
struct XcdBarrier { unsigned* bar; unsigned x; volatile LAS unsigned* st; };
__device__ __forceinline__ XcdBarrier xcd_barrier_post(unsigned* bar, volatile LAS unsigned* st) {
    XcdBarrier b; b.bar = bar; b.x = xb_xcc_id(); b.st = st;
    if (threadIdx.x == 0) (void)xb_add(&bar[XB_XCNT(b.x)], 1u);
    return b;
}
__device__ __forceinline__ void xcd_barrier_complete(unsigned* bar, unsigned x, unsigned& nloc, unsigned& nx) {
    const unsigned G = gridDim.x * gridDim.y * gridDim.z;
    unsigned sum, cnt, mine, sp = 0u;
    for (;;) {
        sum = 0u; cnt = 0u; mine = 0u;
#pragma unroll
        for (unsigned j = 0; j < 16; ++j) { const unsigned c = xb_ld(&bar[XB_XCNT(j)]); sum += c; cnt += (c > 0u) ? 1u : 0u; mine = (j == x) ? c : mine; }
        if (sum == G) break;
        __builtin_amdgcn_s_sleep(1);
        if ((++sp & 255u) == 0u) { if (xb_ld(&bar[XB_TMO])) break; if (sp > XB_SPIN_CAP) { atomicAdd(&bar[XB_TMO], 1u); break; } }
    }
    nloc = mine > 0u ? mine : 1u; nx = cnt > 0u ? cnt : 1u;
}
__device__ __forceinline__ void xcd_barrier(const XcdBarrier& b) {
    asm volatile("s_waitcnt vmcnt(0)" ::: "memory");
    __syncthreads();
    if (threadIdx.x == 0) {
        unsigned* bar = b.bar;
        __builtin_amdgcn_s_waitcnt(0);
        unsigned nloc = b.st[0], nx = b.st[1];
        if (nloc == 0u) { xcd_barrier_complete(bar, b.x, nloc, nx); b.st[0] = nloc; b.st[1] = nx; }
        const unsigned old = xb_add(&bar[XB_XSUB(b.x)], 1u);
        const unsigned gen = old / nloc;
        if (old + 1u == (gen + 1u) * nloc) {
            __builtin_amdgcn_fence(__ATOMIC_RELEASE, "agent");
            asm volatile("s_waitcnt vmcnt(0)" ::: "memory");
            const unsigned og = xb_add(&bar[XB_TOP], 1u);
            const unsigned tg = og / nx;
            if (og + 1u == (tg + 1u) * nx) xb_add(&bar[XB_TOPGEN], 1u);
            else XB_SPIN(xb_ld(&bar[XB_TOPGEN]) == tg, bar);
            __builtin_amdgcn_fence(__ATOMIC_ACQUIRE, "agent");
            xb_add(&bar[XB_XGEN(b.x)], 1u);
            asm volatile("s_waitcnt vmcnt(0)" ::: "memory");
        } else {
            XB_SPIN(xb_ld(&bar[XB_XGEN(b.x)]) == gen, bar);
            __builtin_amdgcn_fence(__ATOMIC_ACQUIRE, "agent");
            asm volatile("s_waitcnt vmcnt(0)" ::: "memory");
        }
    }
    __syncthreads();
}

struct Params {
    const float *x, *c, *ctx, *c_ctx, *norm1_g, *w_mod, *b_mod, *w_in, *fg_up, *fg_b, *onorm_g, *conf_dw, *conf_dw_b, *conf_ln_g, *conf_ln_b, *sc_dw,
                *qn_g, *kvn_g, *w_uq, *w_ukv, *w_out, *norm2_g, *w1, *w3, *w2, *final_g;
    float* out; unsigned char* ws; int ph_lo, ph_hi;
};

template <class RowMap>
__device__ __forceinline__ void transpose_item64(const float* W, int N, bf16_t* WT, int ldk, int kofs, const RowMap& rm, const float* gain, LAS unsigned* scr, int item, int lane) {
    const int nblk = (N + 63) >> 6, kb = item / nblk, nb = item % nblk, k0 = 64 * kb, n0 = 64 * nb;
    const bool nvalid = (n0 + lane) < N;
    const float* src = W + (size_t)k0 * N + n0 + (nvalid ? lane : 0);
    float v[64];
#pragma unroll
    for (int kk = 0; kk < 64; ++kk) v[kk] = src[(size_t)kk * N];
    if (gain) {
#pragma unroll
        for (int kk = 0; kk < 64; ++kk) v[kk] *= gain[k0 + kk];
    }
#pragma unroll
    for (int j = 0; j < 32; ++j) scr[lane * 33 + j] = cvt_pk_bf16(v[2 * j], v[2 * j + 1]);
    LDS_WAIT(); asm volatile("" ::: "memory");
    const int c = lane & 7;
#pragma unroll
    for (int j = 0; j < 8; ++j) { const int n = (lane >> 3) + 8 * j;
        if (n0 + n < N) { const LAS unsigned* q = scr + n * 33 + 4 * c; u32x4 o; o.x = q[0]; o.y = q[1]; o.z = q[2]; o.w = q[3];
            *(u32x4*)(WT + (size_t)rm(n0 + n) * ldk + kofs + k0 + 8 * c) = o; } }
    LDS_WAIT(); asm volatile("" ::: "memory");
}
struct RmId { __device__ __forceinline__ int operator()(int n) const { return n; } };
struct RmIn { __device__ __forceinline__ int operator()(int n) const { if (n < ZKR) return n; const int rc = n - ZKR, a = rc >> 5, hf = (rc >> 4) & 1, i = rc & 15; return ZKR + a * 32 + 2 * i + hf; } };
struct RmUq { __device__ __forceinline__ int operator()(int n) const { const int hd = n / 192, within = n % 192; if (within < 128) return n; const int rc = within - 128, a = rc >> 5, hf = (rc >> 4) & 1, i = rc & 15; return hd * 192 + 128 + a * 32 + 2 * i + hf; } };
struct RmOff { int off; __device__ __forceinline__ int operator()(int n) const { return off + n; } };
struct RmFf { int off; __device__ __forceinline__ int operator()(int n) const { return (n >> 7) * 256 + off + (n & 127); } };

struct Frame {
    LAS unsigned char* lds; int tid, lane, wave, G, bid; unsigned char* ws; const Params* p;
};

__device__ __forceinline__ void phase_p0a(const Params& P, LAS unsigned char* lds, int tid, int lane, int wave, int G, int bid) {
    unsigned char* ws = P.ws;
    const int gw = bid * 8 + wave, NGW = G * 8;
    const int gt = bid * 512 + tid, NGT = G * 512;
    LAS float* act = (LAS float*)(lds + 8 * 8448);
    for (int i = tid; i < 3 * DM; i += 512) { const int r = i / DM, k = i % DM; const float v = r < 2 ? P.c[r * DM + k] : P.c_ctx[k]; act[i] = v / (1.0f + expf(-v)); }
    __syncthreads();
    {
        float* modp = (float*)(ws + WS_MODP);
        for (int it = gw; it < 4 * 48 * 8; it += NGW) {
            const int layer = it / 384, rem = it % 384, cb = rem / 8, ks = rem % 8;
            const int col0 = cb * 256 + lane * 4;
            const float* Wp = P.w_mod + ((size_t)layer * DM + (size_t)ks * 256) * 12288 + col0;
            const LAS float* a0 = act + ks * 256;
            f32x4 s0 = {0.f, 0.f, 0.f, 0.f}, s1 = s0, s2 = s0;
#pragma unroll 16
            for (int k = 0; k < 256; ++k) { const f32x4 w = *(const f32x4*)(Wp + (size_t)k * 12288); s0 += w * a0[k]; s1 += w * a0[DM + k]; s2 += w * a0[2 * DM + k]; }
            float* o = modp + (((size_t)ks * 4 + layer) * 3) * 12288 + col0;
            *(f32x4*)(o) = s0; *(f32x4*)(o + 12288) = s1; *(f32x4*)(o + 2 * 12288) = s2;
        }
    }
    {
        LAS unsigned* scr = (LAS unsigned*)(lds + wave * 8448);
        constexpr int I_IN = (DM / 64) * ((INW + 63) / 64), I_OUT = (DM / 64) * (DM / 64), I_FF = (DM / 64) * (DFF / 64), I_W2 = (DFF / 64) * (DM / 64), I_UQ = (384 / 64) * (768 / 64), I_UKV = (128 / 64) * (1024 / 64);
        constexpr int PER_LAYER = I_IN + I_OUT + 2 * I_FF + I_W2 + I_UQ + I_UKV;
        for (int it = gw; it < 4 * PER_LAYER; it += NGW) {
            const int layer = it / PER_LAYER; int r = it % PER_LAYER;
            if (r < I_IN) { transpose_item64(P.w_in + (size_t)layer * DM * INW, INW, (bf16_t*)(ws + WS_WIN) + (size_t)layer * INWP * DM, DM, 0, RmIn{}, nullptr, scr, r, lane); continue; } r -= I_IN;
            if (r < I_OUT) { transpose_item64(P.w_out + (size_t)layer * DM * DM, DM, (bf16_t*)(ws + WS_WOUT) + (size_t)layer * DM * DM, DM, 0, RmId{}, nullptr, scr, r, lane); continue; } r -= I_OUT;
            if (r < I_FF) { transpose_item64(P.w1 + (size_t)layer * DM * DFF, DFF, (bf16_t*)(ws + WS_W13) + (size_t)layer * 2 * DFF * DM, DM, 0, RmFf{0}, nullptr, scr, r, lane); continue; } r -= I_FF;
            if (r < I_FF) { transpose_item64(P.w3 + (size_t)layer * DM * DFF, DFF, (bf16_t*)(ws + WS_W13) + (size_t)layer * 2 * DFF * DM, DM, 0, RmFf{128}, nullptr, scr, r, lane); continue; } r -= I_FF;
            if (r < I_W2) { transpose_item64(P.w2 + (size_t)layer * DFF * DM, DM, (bf16_t*)(ws + WS_W2) + (size_t)layer * DM * DFF, DFF, 0, RmId{}, nullptr, scr, r, lane); continue; } r -= I_W2;
            if (r < I_UQ) { transpose_item64(P.w_uq + (size_t)layer * 384 * 768, 768, (bf16_t*)(ws + WS_WUP) + (size_t)layer * NUP * KUP, KUP, 0, RmUq{}, P.qn_g + layer * 384, scr, r, lane); continue; } r -= I_UQ;
            transpose_item64(P.w_ukv + (size_t)layer * 128 * 1024, 1024, (bf16_t*)(ws + WS_WUP) + (size_t)layer * NUP * KUP, KUP, 384, RmOff{768}, P.kvn_g + layer * 128, scr, r, lane);
        }
    }
    {
        constexpr int PADW = (INWP - INW) * DM / 8;
        for (int i = gt; i < 4 * PADW; i += NGT) { const int layer = i / PADW, j = i % PADW;
            *(u32x4*)((bf16_t*)(ws + WS_WIN) + ((size_t)layer * INWP + INW) * DM + (size_t)j * 8) = (u32x4){0u, 0u, 0u, 0u}; }
        constexpr int ZQ_ = 768 * 16, ZKV_ = 1024 * 48;
        for (int i = gt; i < 4 * (ZQ_ + ZKV_); i += NGT) { const int layer = i / (ZQ_ + ZKV_), j = i % (ZQ_ + ZKV_);
            bf16_t* WU = (bf16_t*)(ws + WS_WUP) + (size_t)layer * NUP * KUP;
            if (j < ZQ_) *(u32x4*)(WU + (size_t)(j >> 4) * KUP + 384 + (j & 15) * 8) = (u32x4){0u, 0u, 0u, 0u};
            else { const int jj = j - ZQ_; *(u32x4*)(WU + (size_t)(768 + jj / 48) * KUP + (jj % 48) * 8) = (u32x4){0u, 0u, 0u, 0u}; } }
    }
    {
        f32x2* rope = (f32x2*)(ws + WS_ROPE);
        for (int i = gt; i < 1024; i += NGT) { const int pos = i >> 4, f = i & 15; const float inv = powf(10000.0f, -(float)f * 2.0f / 32.0f); const float ang = (float)pos * inv; rope[i] = (f32x2){cosf(ang), sinf(ang)}; }
        float* rs = (float*)(ws + WS_RSTAT);
        for (int i = gt; i < 4 * MT * 2; i += NGT) rs[i] = 0.f;
    }
}
__device__ __forceinline__ void phase_p0b(const Params& P, int tid, int G, int bid) {
    const float* modp = (const float*)(P.ws + WS_MODP); float* modv = (float*)(P.ws + WS_MODV);
    for (int i = bid * 512 + tid; i < 4 * 3 * 12288; i += G * 512) {
        const int layer = i / (3 * 12288), rem = i % (3 * 12288), r = rem / 12288, c12 = rem % 12288, j = c12 / DM, col = c12 % DM;
        float s = P.b_mod[layer * 12288 + c12];
#pragma unroll
        for (int ks = 0; ks < 8; ++ks) s += modp[(((size_t)ks * 4 + layer) * 3 + r) * 12288 + c12];
        if (j == 1) s = P.norm1_g[layer * DM + col] * (1.0f + s);
        if (j == 4) s = P.norm2_g[layer * DM + col] * (1.0f + s);
        modv[(((size_t)layer * 3 + r) * 6 + j) * DM + col] = s;
    }
}

__device__ __forceinline__ void phase_norm(LAS unsigned char* lds, const float* xlat, const float* xctx, const float* modl  , int jg, int jsh, bf16_t* H, bool with_ctx,
                                           const float* slab, int nslab, const float* sgate, float* xctx_out, int tid, int lane, int wave, int G, int bid) {
    if (with_ctx) {
        LAS float* red = (LAS float*)lds;
        const float* gp = modl + ((size_t)2 * 6 + jg) * DM; const float* sp = modl + ((size_t)2 * 6 + jsh) * DM;
        for (int r0 = bid * 2; r0 < MC; r0 += G * 2) {
            const int col = wave * 256 + lane * 4;
            f32x4 v[2]; float ss[2];
#pragma unroll
            for (int q = 0; q < 2; ++q) { const int row = r0 + q;
                v[q] = *(const f32x4*)(xctx + (size_t)row * DM + col);
                if (nslab > 0) { f32x4 a = {0.f, 0.f, 0.f, 0.f};
                    for (int sI = 0; sI < nslab; ++sI) a += *(const f32x4*)(slab + ((size_t)sI * MC + row) * DM + col);
                    v[q] += *(const f32x4*)(sgate + col) * a;
                    *(f32x4*)(xctx_out + (size_t)row * DM + col) = v[q]; }
                ss[q] = wave_sum(dot4(v[q])); }
            if (lane == 0) { red[wave * 2] = ss[0]; red[wave * 2 + 1] = ss[1]; }
            __syncthreads();
            const f32x4 gs = *(const f32x4*)(gp + col), sh = *(const f32x4*)(sp + col);
#pragma unroll
            for (int q = 0; q < 2; ++q) { float t = 0.f;
#pragma unroll
                for (int w = 0; w < 8; ++w) t += red[w * 2 + q];
                const float rstd = rsqrtf(t * (1.0f / DM) + EPS);
                const f32x4 o = v[q] * rstd * gs + sh; u32x2 w2; w2.x = cvt_pk_bf16(o[0], o[1]); w2.y = cvt_pk_bf16(o[2], o[3]);
                *(u32x2*)(H + (size_t)(ML + r0 + q) * DM + col) = w2; }
            __syncthreads();
        }
    }
    const int rpw = (ML + G - 1) / G;
    int cur = -1; f32x4 gsv[8], shv[8];
    for (int k = wave; k < rpw; k += 8) {
        const int row = bid * rpw + k; if (row >= ML) break;
        const int r = row < SEQ ? 0 : 1;
        if (r != cur) { cur = r; const float* gp = modl + ((size_t)r * 6 + jg) * DM; const float* sp = modl + ((size_t)r * 6 + jsh) * DM;
#pragma unroll
            for (int j = 0; j < 8; ++j) { gsv[j] = *(const f32x4*)(gp + (lane + 64 * j) * 4); shv[j] = *(const f32x4*)(sp + (lane + 64 * j) * 4); } }
        const float* xr = xlat + (size_t)row * DM;
        f32x4 v[8]; float ss = 0.f;
#pragma unroll
        for (int j = 0; j < 8; ++j) { v[j] = *(const f32x4*)(xr + (lane + 64 * j) * 4); ss += dot4(v[j]); }
        const float rstd = rsqrtf(wave_sum(ss) * (1.0f / DM) + EPS);
        bf16_t* hr = H + (size_t)row * DM;
#pragma unroll
        for (int j = 0; j < 8; ++j) { const f32x4 o = v[j] * rstd * gsv[j] + shv[j]; u32x2 w; w.x = cvt_pk_bf16(o[0], o[1]); w.y = cvt_pk_bf16(o[2], o[3]); *(u32x2*)(hr + (lane + 64 * j) * 4) = w; }
    }
}
__device__ __forceinline__ void phase_final(const float* X, const float* g, float* out, int lane, int wave, int G, int bid) {
    for (int row = bid * 8 + wave; row < ML; row += G * 8) {
        const float* xr = X + (size_t)row * DM; f32x4 v[8]; float ss = 0.f;
#pragma unroll
        for (int j = 0; j < 8; ++j) { v[j] = *(const f32x4*)(xr + (lane + 64 * j) * 4); ss += dot4(v[j]); }
        const float rstd = rsqrtf(wave_sum(ss) * (1.0f / DM) + EPS);
#pragma unroll
        for (int j = 0; j < 8; ++j) { const f32x4 gg = *(const f32x4*)(g + (lane + 64 * j) * 4); *(f32x4*)(out + (size_t)row * DM + (lane + 64 * j) * 4) = v[j] * rstd * gg; }
    }
}

constexpr int GL_RQ = 0;
constexpr int GL_RK = 16384;
constexpr int GL_RV = 32768;
constexpr int GL_QT = 49152;
constexpr int GL_KT = 66560;
constexpr int GL_PP = 83968;
constexpr int GL_VT = 93184;
constexpr int GL_LR = 111616;
constexpr int GL_TOT = 119808;
__device__ __forceinline__ int gla_row0(int b, int id) { return id < 4 ? ML + b * CTX + id * 64 : b * SEQ + (id - 4) * 64; }
struct GlaRaw { u32x4 q0, q1, k0, k1, v0, v1, l0, l1, ga, gb; };
template <bool WITH_Q>
__device__ __forceinline__ void gla_load_raw(GlaRaw& R, const bf16_t* Z, int row0, int h, int tid) {
    const int t = tid >> 3, dg = (tid & 7) * 16;
    const bf16_t* zr = Z + (size_t)(row0 + t) * INWP + h * 128 + dg;
    R.k0 = *(const u32x4*)(zr + ZK); R.k1 = *(const u32x4*)(zr + ZK + 8); R.v0 = *(const u32x4*)(zr + ZV); R.v1 = *(const u32x4*)(zr + ZV + 8);
    if (WITH_Q) { R.q0 = *(const u32x4*)(zr + ZQ); R.q1 = *(const u32x4*)(zr + ZQ + 8); R.ga = *(const u32x4*)(zr + ZG); R.gb = *(const u32x4*)(zr + ZG + 8); }
    const bf16_t* lp = Z + (size_t)(row0 + ((tid & 127) >> 1)) * INWP + ZLR + (tid & 1) * 8;
    R.l0 = *(const u32x4*)lp; R.l1 = *(const u32x4*)(lp + 16);
}
template <bool WITH_Q>
__device__ __forceinline__ void gla_store_raw(LAS unsigned char* lds, const GlaRaw& R, int tid) {
    const int t = tid >> 3, dg = (tid & 7) * 16;
    *(LAS u32x4*)(lds + GL_RK + t * 256 + dg * 2) = R.k0; *(LAS u32x4*)(lds + GL_RK + t * 256 + dg * 2 + 16) = R.k1;
    *(LAS u32x4*)(lds + GL_RV + t * 256 + dg * 2) = R.v0; *(LAS u32x4*)(lds + GL_RV + t * 256 + dg * 2 + 16) = R.v1;
    if (WITH_Q) { *(LAS u32x4*)(lds + GL_RQ + t * 256 + dg * 2) = R.q0; *(LAS u32x4*)(lds + GL_RQ + t * 256 + dg * 2 + 16) = R.q1; }
    if (tid < 128) { LAS float* LR = (LAS float*)(lds + GL_LR) + (tid >> 1) * 16 + (tid & 1) * 8; const u32x4 l0 = R.l0, l1 = R.l1;
        LR[0] = bflo(l0.x); LR[1] = bfhi(l0.x); LR[2] = bflo(l0.y); LR[3] = bfhi(l0.y); LR[4] = bflo(l0.z); LR[5] = bfhi(l0.z); LR[6] = bflo(l0.w); LR[7] = bfhi(l0.w);
        LAS float* L1 = LR + 1024;
        L1[0] = bflo(l1.x); L1[1] = bfhi(l1.x); L1[2] = bflo(l1.y); L1[3] = bfhi(l1.y); L1[4] = bflo(l1.z); L1[5] = bfhi(l1.z); L1[6] = bflo(l1.w); L1[7] = bfhi(l1.w); }
}
struct GlaFg { float w[16]; float b; };
__device__ __forceinline__ void gla_load_fg(GlaFg& F, const float* fgup  , const float* fgb  , int h, int tid) {
    const int d = tid & 127;
#pragma unroll
    for (int r = 0; r < 16; ++r) F.w[r] = fgup[r * 512 + h * 128 + d];
    F.b = fgb[h * 128 + d];
}
__device__ __forceinline__ void gla_decay_local(LAS unsigned char* lds, const GlaFg& F, int dir, int tid, float (&p)[16]) {
    const int d = tid & 127, seg = tid >> 7;
    const float (&fg)[16] = F.w; const float fb = F.b;
    const LAS float* LR = (const LAS float*)(lds + GL_LR) + dir * 1024 + seg * 256;
#pragma unroll
    for (int i = 0; i < 16; ++i) { float x = fb;
#pragma unroll
        for (int r4 = 0; r4 < 4; ++r4) { const f32x4 l = *(const LAS f32x4*)(LR + i * 16 + r4 * 4); x += l[0] * fg[r4 * 4] + l[1] * fg[r4 * 4 + 1] + l[2] * fg[r4 * 4 + 2] + l[3] * fg[r4 * 4 + 3]; }
        p[i] = (fminf(x, 0.f) - __logf(1.0f + __expf(-fabsf(x)))) * (1.0f / 16.0f); }
    if (dir == 0) {
#pragma unroll
        for (int i = 1; i < 16; ++i) p[i] += p[i - 1];
        ((LAS float*)(lds + GL_TOT))[seg * 128 + d] = p[15];
    } else {
#pragma unroll
        for (int i = 14; i >= 0; --i) p[i] += p[i + 1];
        ((LAS float*)(lds + GL_TOT))[seg * 128 + d] = p[0];
    }
}
__device__ __forceinline__ float gla_offsets(const LAS unsigned char* lds, int dir, int tid, float (&p)[16]) {
    const int d = tid & 127, seg = tid >> 7;
    const LAS float* T = (const LAS float*)(lds + GL_TOT) + d;
    const float t0 = T[0], t1 = T[128], t2 = T[256], t3 = T[384];
    float off;
    if (dir == 0) off = (seg > 0 ? t0 : 0.f) + (seg > 1 ? t1 : 0.f) + (seg > 2 ? t2 : 0.f);
    else off = (seg < 3 ? t3 : 0.f) + (seg < 2 ? t2 : 0.f) + (seg < 1 ? t1 : 0.f);
#pragma unroll
    for (int i = 0; i < 16; ++i) p[i] += off;
    return (t0 + t1) + (t2 + t3);
}
__device__ __forceinline__ void gla_build_vT(LAS unsigned char* lds, int tid) {
    const int e = tid & 127, seg = tid >> 7;
    const LAS bf16_t* RV = (const LAS bf16_t*)(lds + GL_RV) + (16 * seg) * 128 + e;
    unsigned w[8];
#pragma unroll
    for (int i = 0; i < 8; ++i) w[i] = (unsigned)RV[(2 * i) * 128] | ((unsigned)RV[(2 * i + 1) * 128] << 16);
    LAS u32x4* dst = (LAS u32x4*)(lds + GL_VT + e * 144 + seg * 32);
    dst[0] = (u32x4){w[0], w[1], w[2], w[3]}; dst[1] = (u32x4){w[4], w[5], w[6], w[7]};
}
__device__ __forceinline__ void gla_item_decode(int item, int& b, int& h, int& id) { const int bh = item & 7; id = item >> 3; b = bh >> 2; h = bh & 3; }
__device__ __forceinline__ void gla_g1_loop(LAS unsigned char* lds, const Params& P, int layer, int first, int nitems, int G, int tid, int lane, int wave) {
    if (first >= nitems) return;
    const bf16_t* Z = (const bf16_t*)(P.ws + WS_Z);
    LAS bf16_t* KH = (LAS bf16_t*)(lds + GL_QT);
    const LAS bf16_t* VT = (const LAS bf16_t*)(lds + GL_VT);
    const int d = tid & 127, seg = tid >> 7;
    int b, h, id; gla_item_decode(first, b, h, id);
    GlaRaw R; gla_load_raw<false>(R, Z, gla_row0(b, id), h, tid);
    GlaFg F0, F1; int fh = -1;
    for (int it = first; it < nitems; it += G) {
        gla_item_decode(it, b, h, id);
        if (h != fh) { fh = h; gla_load_fg(F0, P.fg_up + ((size_t)layer * 2 + 0) * 16 * 512, P.fg_b + ((size_t)layer * 2 + 0) * 512, h, tid); gla_load_fg(F1, P.fg_up + ((size_t)layer * 2 + 1) * 16 * 512, P.fg_b + ((size_t)layer * 2 + 1) * 512, h, tid); }
        gla_store_raw<false>(lds, R, tid);
        __syncthreads();
        if (it + G < nitems) { int b2, h2, id2; gla_item_decode(it + G, b2, h2, id2); gla_load_raw<false>(R, Z, gla_row0(b2, id2), h2, tid); }
#pragma unroll
        for (int dir = 0; dir < 2; ++dir) {
            const int seq = (b * 4 + h) * 2 + dir;
            float p[16];
            gla_decay_local(lds, dir == 0 ? F0 : F1, dir, tid, p);
            __syncthreads();
            const float blast = gla_offsets(lds, dir, tid, p);
            {
                const LAS bf16_t* RK = (const LAS bf16_t*)(lds + GL_RK) + (16 * seg) * 128 + d;
                unsigned w[8];
#pragma unroll
                for (int i = 0; i < 8; ++i) w[i] = cvt_pk_bf16(bf2f(RK[(2 * i) * 128]) * __expf(blast - p[2 * i]), bf2f(RK[(2 * i + 1) * 128]) * __expf(blast - p[2 * i + 1]));
                LAS u32x4* dst = (LAS u32x4*)(lds + GL_QT + d * 144 + seg * 32);
                dst[0] = (u32x4){w[0], w[1], w[2], w[3]}; dst[1] = (u32x4){w[4], w[5], w[6], w[7]};
                if (dir == 0) gla_build_vT(lds, tid);
                if (seg == 0) ((float*)(P.ws + WS_GD))[((size_t)seq * NCH + id) * 128 + d] = __expf(blast);
            }
            __syncthreads();
            {
                const int eb = wave >> 1, r32 = lane & 31, hi = lane >> 5;
                float* U = (float*)(P.ws + WS_GU) + ((size_t)seq * NCH + id) * 16384;
#pragma unroll
                for (int q = 0; q < 2; ++q) { const int db = 2 * (wave & 1) + q; f32x16 acc = {};
#pragma unroll
                    for (int kk = 0; kk < 4; ++kk) { const bf16x8 av = *(const LAS bf16x8*)(VT + (32 * eb + r32) * 72 + 16 * kk + 8 * hi), bv = *(const LAS bf16x8*)(KH + (32 * db + r32) * 72 + 16 * kk + 8 * hi);
                        acc = __builtin_amdgcn_mfma_f32_32x32x16_bf16(av, bv, acc, 0, 0, 0); }
#pragma unroll
                    for (int r = 0; r < 16; ++r) { const int e = 32 * eb + (r & 3) + 8 * (r >> 2) + 4 * hi; U[e * 128 + 32 * db + r32] = acc[r]; } }
            }
            __syncthreads();
        }
    }
}
__device__ __forceinline__ void gla_g2(const Params& P, int tid, int G, int bid) {
    const float* U = (const float*)(P.ws + WS_GU); const float* Dv = (const float*)(P.ws + WS_GD); bf16_t* S = (bf16_t*)(P.ws + WS_GS);
    for (int slot = bid * 512 + tid; slot < 16 * 8192; slot += G * 512) {
        const int seq = slot >> 13, el = (slot & 8191) * 2, d = el & 127, dir = seq & 1;
        float s0 = 0.f, s1 = 0.f;
#pragma unroll 4
        for (int p = 0; p < NCH; ++p) {
            const int id = dir == 0 ? p : (p < 4 ? 3 - p : 71 - p);
            const size_t base = ((size_t)seq * NCH + id);
            *(unsigned*)(S + base * 16384 + el) = cvt_pk_bf16(s0, s1);
            const f32x2 u = *(const f32x2*)(U + base * 16384 + el), dd = *(const f32x2*)(Dv + base * 128 + d);
            s0 = dd.x * s0 + u.x; s1 = dd.y * s1 + u.y;
        }
    }
}
__device__ __forceinline__ void gla_g3_loop(LAS unsigned char* lds, const Params& P, int layer, int first, int nitems, int G, int tid, int lane, int wave) {
    if (first >= nitems) return;
    const bf16_t* Z = (const bf16_t*)(P.ws + WS_Z);
    const int r32 = lane & 31, hi = lane >> 5, rb = wave >> 2, cb = wave & 3;
    const int d = tid & 127, seg = tid >> 7;
    LAS bf16_t* QT = (LAS bf16_t*)(lds + GL_QT); LAS bf16_t* KT = (LAS bf16_t*)(lds + GL_KT); LAS bf16_t* PP = (LAS bf16_t*)(lds + GL_PP);
    const LAS bf16_t* VT = (const LAS bf16_t*)(lds + GL_VT);
    int b, h, id; gla_item_decode(first, b, h, id);
    GlaRaw R; gla_load_raw<true>(R, Z, gla_row0(b, id), h, tid);
    GlaFg F0, F1; int fh = -1;
    for (int it = first; it < nitems; it += G) {
        gla_item_decode(it, b, h, id);
        const int row0 = gla_row0(b, id);
        if (h != fh) { fh = h; gla_load_fg(F0, P.fg_up + ((size_t)layer * 2 + 0) * 16 * 512, P.fg_b + ((size_t)layer * 2 + 0) * 512, h, tid); gla_load_fg(F1, P.fg_up + ((size_t)layer * 2 + 1) * 16 * 512, P.fg_b + ((size_t)layer * 2 + 1) * 512, h, tid); }
        const u32x4 ga = R.ga, gb = R.gb;
        gla_store_raw<true>(lds, R, tid);
        bf16x8 sf0[8], sf1[8];
        { const bf16_t* Sg = (const bf16_t*)(P.ws + WS_GS) + ((size_t)((b * 4 + h) * 2) * NCH + id) * 16384 + (size_t)(32 * cb + r32) * 128 + 8 * hi;
#pragma unroll
          for (int kk = 0; kk < 8; ++kk) { sf0[kk] = *(const bf16x8*)(Sg + 16 * kk); sf1[kk] = *(const bf16x8*)(Sg + (size_t)NCH * 16384 + 16 * kk); } }
        __syncthreads();
        if (it + G < nitems) { int b2, h2, id2; gla_item_decode(it + G, b2, h2, id2); gla_load_raw<true>(R, Z, gla_row0(b2, id2), h2, tid); }
        f32x16 o = {};
#pragma unroll
        for (int dir = 0; dir < 2; ++dir) {
            float p[16];
            gla_decay_local(lds, dir == 0 ? F0 : F1, dir, tid, p);
            __syncthreads();
            (void)gla_offsets(lds, dir, tid, p);
            {
                const LAS bf16_t* RQ = (const LAS bf16_t*)(lds + GL_RQ) + (16 * seg) * 128 + d; const LAS bf16_t* RK = (const LAS bf16_t*)(lds + GL_RK) + (16 * seg) * 128 + d;
#pragma unroll
                for (int i = 0; i < 16; ++i) { const int t = 16 * seg + i;
                    QT[t * 136 + d] = f2bf(bf2f(RQ[i * 128]) * (0.08838834764831845f * __expf(p[i])));
                    KT[t * 136 + d] = f2bf(bf2f(RK[i * 128]) * __expf(fminf(-p[i], 80.f))); }
                if (dir == 0) gla_build_vT(lds, tid);
            }
            __syncthreads();
            {
                const int bi = wave >> 1, fr = lane & 15, fq = lane >> 4;
#pragma unroll
                for (int q = 0; q < 2; ++q) { const int bj = 2 * (wave & 1) + q; f32x4 acc = {0.f, 0.f, 0.f, 0.f};
#pragma unroll
                    for (int kk = 0; kk < 4; ++kk) { const bf16x8 av = *(const LAS bf16x8*)(QT + (16 * bi + fr) * 136 + 32 * kk + 8 * fq), bv = *(const LAS bf16x8*)(KT + (16 * bj + fr) * 136 + 32 * kk + 8 * fq);
                        acc = __builtin_amdgcn_mfma_f32_16x16x32_bf16(av, bv, acc, 0, 0, 0); }
                    const int jt = 16 * bj + fr;
#pragma unroll
                    for (int r = 0; r < 4; ++r) { const int itk = 16 * bi + 4 * fq + r; const bool keep = dir == 0 ? (jt <= itk) : (jt >= itk); PP[itk * 72 + jt] = f2bf(keep ? acc[r] : 0.f); } }
            }
            __syncthreads();
            {
#pragma unroll
                for (int kk = 0; kk < 4; ++kk) { const bf16x8 av = *(const LAS bf16x8*)(PP + (32 * rb + r32) * 72 + 16 * kk + 8 * hi), bv = *(const LAS bf16x8*)(VT + (32 * cb + r32) * 72 + 16 * kk + 8 * hi);
                    o = __builtin_amdgcn_mfma_f32_32x32x16_bf16(av, bv, o, 0, 0, 0); }
#pragma unroll
                for (int kk = 0; kk < 8; ++kk) { const bf16x8 av = *(const LAS bf16x8*)(QT + (32 * rb + r32) * 136 + 16 * kk + 8 * hi);
                    o = __builtin_amdgcn_mfma_f32_32x32x16_bf16(av, dir == 0 ? sf0[kk] : sf1[kk], o, 0, 0, 0); }
            }
            __syncthreads();
        }
        LAS float* OS = (LAS float*)(lds + GL_RQ);
#pragma unroll
        for (int r = 0; r < 16; ++r) { const int t = 32 * rb + (r & 3) + 8 * (r >> 2) + 4 * hi; OS[t * 132 + 32 * cb + r32] = o[r]; }
        __syncthreads();
        {
            const int t = tid >> 3, eg = (tid & 7) * 16;
            f32x4 v[4]; float ss = 0.f;
#pragma unroll
            for (int q = 0; q < 4; ++q) { v[q] = *(const LAS f32x4*)(OS + t * 132 + eg + 4 * q); ss += dot4(v[q]); }
            ss += __shfl_xor(ss, 1); ss += __shfl_xor(ss, 2); ss += __shfl_xor(ss, 4);
            const float rstd = rsqrtf(ss * (1.0f / 128.0f) + EPS);
            const unsigned gw[8] = {ga.x, ga.y, ga.z, ga.w, gb.x, gb.y, gb.z, gb.w};
            const float* og = P.onorm_g + layer * 128 + eg;
            unsigned ow[8];
#pragma unroll
            for (int i = 0; i < 8; ++i) { const float g0 = bflo(gw[i]), g1 = bfhi(gw[i]);
                const float o0 = v[i >> 1][(i & 1) * 2] * rstd * og[2 * i] * siluf_(g0), o1 = v[i >> 1][(i & 1) * 2 + 1] * rstd * og[2 * i + 1] * siluf_(g1);
                ow[i] = cvt_pk_bf16(o0, o1); }
            bf16_t* mp = (bf16_t*)(P.ws + WS_MIX) + (size_t)(row0 + t) * DM + h * 128 + eg;
            *(u32x4*)(mp) = (u32x4){ow[0], ow[1], ow[2], ow[3]}; *(u32x4*)(mp + 8) = (u32x4){ow[4], ow[5], ow[6], ow[7]};
        }
        __syncthreads();
    }
}

struct ConfRaw { u32x4 a[6], g[6]; };
__device__ __forceinline__ void conf_load(ConfRaw& R, const bf16_t* Z, int item, int tid) {
    const int r0 = item * 16;
    const int s0 = r0 < ML ? (r0 & ~(SEQ - 1)) : ML + ((r0 - ML) & ~(CTX - 1)), s1 = s0 + (r0 < ML ? SEQ : CTX);
#pragma unroll
    for (int i = 0; i < 6; ++i) { const int pc = tid + 512 * i, rr = pc >> 6, ch = pc & 63, row = r0 - 15 + rr;
        const bool ok = (pc < 46 * 64) && row >= s0 && row < s1; const bf16_t* zp = Z + (size_t)(ok ? row : s0) * INWP + ch * 8;
        R.a[i] = *(const u32x4*)(zp + ZCA); R.g[i] = *(const u32x4*)(zp + ZCG);
        if (!ok) R.a[i] = (u32x4){0u, 0u, 0u, 0u}; }
}
__device__ __forceinline__ void conf_loop(LAS unsigned char* lds, const Params& P, int layer, int first, int nitems, int G, int tid, int lane, int wave) {
    if (first >= nitems) return;
    const bf16_t* Z = (const bf16_t*)(P.ws + WS_Z);
    LAS float* UB = (LAS float*)lds;
    LAS float* YB = (LAS float*)(lds + 46 * 512 * 4);
    const int c = tid;
    ConfRaw R; conf_load(R, Z, first, tid);
    float w[31];
#pragma unroll
    for (int j = 0; j < 31; ++j) w[j] = P.conf_dw[((size_t)layer * 31 + j) * 512 + c];
    const float bias = P.conf_dw_b[layer * 512 + c];
    const float* lg = P.conf_ln_g + layer * 512 + 8 * lane; const float* lb = P.conf_ln_b + layer * 512 + 8 * lane;
    const f32x4 g0 = *(const f32x4*)lg, g1 = *(const f32x4*)(lg + 4), b0 = *(const f32x4*)lb, b1 = *(const f32x4*)(lb + 4);
    for (int it = first; it < nitems; it += G) {
        const int r0 = it * 16;
#pragma unroll
        for (int i = 0; i < 6; ++i) { const int pc = tid + 512 * i, rr = pc >> 6, ch = pc & 63;
            if (pc < 46 * 64) { const unsigned aw[4] = {R.a[i].x, R.a[i].y, R.a[i].z, R.a[i].w}, gw[4] = {R.g[i].x, R.g[i].y, R.g[i].z, R.g[i].w};
                f32x4 u0, u1;
                u0[0] = bflo(aw[0]) * sigmoidf_(bflo(gw[0])); u0[1] = bfhi(aw[0]) * sigmoidf_(bfhi(gw[0])); u0[2] = bflo(aw[1]) * sigmoidf_(bflo(gw[1])); u0[3] = bfhi(aw[1]) * sigmoidf_(bfhi(gw[1]));
                u1[0] = bflo(aw[2]) * sigmoidf_(bflo(gw[2])); u1[1] = bfhi(aw[2]) * sigmoidf_(bfhi(gw[2])); u1[2] = bflo(aw[3]) * sigmoidf_(bflo(gw[3])); u1[3] = bfhi(aw[3]) * sigmoidf_(bfhi(gw[3]));
                *(LAS f32x4*)(UB + rr * 512 + ch * 8) = u0; *(LAS f32x4*)(UB + rr * 512 + ch * 8 + 4) = u1; } }
        __syncthreads();
        if (it + G < nitems) conf_load(R, Z, it + G, tid);
#pragma unroll
        for (int g8 = 0; g8 < 2; ++g8) {
            float win[38];
#pragma unroll
            for (int i = 0; i < 38; ++i) win[i] = UB[(g8 * 8 + i) * 512 + c];
#pragma unroll
            for (int r = 0; r < 8; ++r) { float y = bias;
#pragma unroll
                for (int j = 0; j < 31; ++j) y += w[j] * win[r + j];
                YB[(g8 * 8 + r) * 512 + c] = y; }
        }
        __syncthreads();
#pragma unroll
        for (int q = 0; q < 2; ++q) { const int t = 2 * wave + q;
            f32x4 y0 = *(const LAS f32x4*)(YB + t * 512 + 8 * lane), y1 = *(const LAS f32x4*)(YB + t * 512 + 8 * lane + 4);
            const float mean = wave_sum((y0[0] + y0[1]) + (y0[2] + y0[3]) + (y1[0] + y1[1]) + (y1[2] + y1[3])) * (1.0f / 512.0f);
            y0 = y0 - mean; y1 = y1 - mean;
            const float rstd = rsqrtf(wave_sum(dot4(y0) + dot4(y1)) * (1.0f / 512.0f) + EPS);
            y0 = y0 * rstd * g0 + b0; y1 = y1 * rstd * g1 + b1;
            u32x4 o; o.x = cvt_pk_bf16(siluf_(y0[0]), siluf_(y0[1])); o.y = cvt_pk_bf16(siluf_(y0[2]), siluf_(y0[3])); o.z = cvt_pk_bf16(siluf_(y1[0]), siluf_(y1[1])); o.w = cvt_pk_bf16(siluf_(y1[2]), siluf_(y1[3]));
            *(u32x4*)((bf16_t*)(P.ws + WS_MIX) + (size_t)(r0 + t) * DM + 512 + 8 * lane) = o; }
        __syncthreads();
    }
}
__device__ __forceinline__ void sconv_item(const Params& P, int layer, int item, int tid) {
    const bf16_t* Z = (const bf16_t*)(P.ws + WS_Z);
    const int row = item * 16 + (tid >> 5);
    const int s0 = row < ML ? (row & ~(SEQ - 1)) : ML + ((row - ML) & ~(CTX - 1)), s1 = s0 + (row < ML ? SEQ : CTX);
#pragma unroll
    for (int q = 0; q < 2; ++q) {
        const int c0 = ((tid & 31) + 32 * q) * 8;
        float acc[8];
#pragma unroll
        for (int i = 0; i < 8; ++i) acc[i] = 0.f;
#pragma unroll
        for (int j = 0; j < 3; ++j) { const int rr = row + j - 1;
            if (rr >= s0 && rr < s1) { const u32x4 cg = *(const u32x4*)(Z + (size_t)rr * INWP + ZSC + c0), hh = *(const u32x4*)(Z + (size_t)rr * INWP + ZSH + c0);
                const float* wp = P.sc_dw + ((size_t)layer * 3 + j) * 512 + c0; const f32x4 w0 = *(const f32x4*)wp, w1 = *(const f32x4*)(wp + 4);
                const unsigned cw[4] = {cg.x, cg.y, cg.z, cg.w}, hw[4] = {hh.x, hh.y, hh.z, hh.w};
#pragma unroll
                for (int i = 0; i < 4; ++i) { const float wa = i < 2 ? w0[2 * i] : w1[2 * i - 4], wb = i < 2 ? w0[2 * i + 1] : w1[2 * i - 3];
                    acc[2 * i] += wa * bflo(cw[i]) * bflo(hw[i]); acc[2 * i + 1] += wb * bfhi(cw[i]) * bfhi(hw[i]); } } }
        const u32x4 bg = *(const u32x4*)(Z + (size_t)row * INWP + ZSB + c0); const unsigned bw[4] = {bg.x, bg.y, bg.z, bg.w};
        u32x4 o; unsigned ow[4];
#pragma unroll
        for (int i = 0; i < 4; ++i) ow[i] = cvt_pk_bf16(bflo(bw[i]) * acc[2 * i], bfhi(bw[i]) * acc[2 * i + 1]);
        o.x = ow[0]; o.y = ow[1]; o.z = ow[2]; o.w = ow[3];
        *(u32x4*)((bf16_t*)(P.ws + WS_MIX) + (size_t)row * DM + 1024 + c0) = o;
    }
}

namespace att {
constexpr int NW = 8, QBLK = 32, KVBLK = 64;
constexpr float SCALE = 0.07216878364870322f;
constexpr float THR = 8.f;
constexpr int SHM_V = KVBLK * 128 * 2, SHM_K = KVBLK * 192 * 2;
constexpr int OFF_K = 2 * SHM_V, OFF_WS = OFF_K + 2 * SHM_K, OFF_QR = OFF_WS + 2048;
#define KSWZ(row, colB) ((row) * 384 + ((colB) ^ ((((row) >> 1) & 7) << 4)))
#define SBAR() __builtin_amdgcn_sched_barrier(0)
__device__ __forceinline__ int crow(int r, int hi) { return (r & 3) + 8 * (r >> 2) + 4 * hi; }
__device__ __forceinline__ void partialSM(f32x16& p0, f32x16& p1, float& m_reg, float& mn, float& alpha) {
    constexpr float C = SCALE * 1.4426950408889634f;
    float pmax = p0[0];
#pragma unroll
    for (int r = 1; r < 16; ++r) pmax = fmaxf(pmax, p0[r]);
#pragma unroll
    for (int r = 0; r < 16; ++r) pmax = fmaxf(pmax, p1[r]);
    { auto rr = __builtin_amdgcn_permlane32_swap(__float_as_uint(pmax), __float_as_uint(pmax), false, false);
      pmax = fmaxf(__uint_as_float(rr[0]), __uint_as_float(rr[1])); }
    if (__builtin_expect(__all(pmax - m_reg <= THR / SCALE), 1)) { mn = m_reg; alpha = 1.f; }
    else { mn = fmaxf(m_reg, pmax); alpha = __builtin_amdgcn_exp2f((m_reg - mn) * C); m_reg = mn; }
    const float mnC = -mn * C;
#pragma unroll
    for (int r = 0; r < 16; ++r) p0[r] = fmaf(p0[r], C, mnC);
#pragma unroll
    for (int r = 0; r < 16; ++r) p1[r] = fmaf(p1[r], C, mnC);
#pragma unroll
    for (int r = 0; r < 16; ++r) p0[r] = __builtin_amdgcn_exp2f(p0[r]);
}
__device__ __forceinline__ void finishSM(f32x16& p0, f32x16& p1, float alpha, float& l_reg, bf16x8& pa0, bf16x8& pa1, bf16x8& pa2, bf16x8& pa3) {
#pragma unroll
    for (int r = 0; r < 16; ++r) p1[r] = __builtin_amdgcn_exp2f(p1[r]);
    float ps = 0;
#pragma unroll
    for (int r = 0; r < 16; ++r) ps += p0[r];
#pragma unroll
    for (int r = 0; r < 16; ++r) ps += p1[r];
    { auto rr = __builtin_amdgcn_permlane32_swap(__float_as_uint(ps), __float_as_uint(ps), false, false);
      ps = __uint_as_float(rr[0]) + __uint_as_float(rr[1]); }
    l_reg = l_reg * alpha + ps;
#define PK4(Pv, BASE, OUT) do { unsigned a0 = cvt_pk_bf16(Pv[BASE + 0], Pv[BASE + 1]), a1 = cvt_pk_bf16(Pv[BASE + 2], Pv[BASE + 3]);   \
    unsigned b0 = cvt_pk_bf16(Pv[BASE + 4], Pv[BASE + 5]), b1 = cvt_pk_bf16(Pv[BASE + 6], Pv[BASE + 7]);                              \
    auto r0 = __builtin_amdgcn_permlane32_swap(a0, b0, false, false); auto r1 = __builtin_amdgcn_permlane32_swap(a1, b1, false, false); \
    u32x4 w = {r0[0], r1[0], r0[1], r1[1]}; OUT = *reinterpret_cast<bf16x8*>(&w); } while (0)
    PK4(p0, 0, pa0); PK4(p0, 8, pa1); PK4(p1, 0, pa2); PK4(p1, 8, pa3);
#undef PK4
}
__device__ __forceinline__ void qkt(f32x16& p0, f32x16& p1, const LAS unsigned char* Ks, const bf16x8* qr, const LAS unsigned char* qrp, int qsw, const int (&kq)[4], int hi) {
    p0 = f32x16{}; p1 = f32x16{};
#pragma unroll
    for (int d0 = 0; d0 < 12; ++d0) {
        const bf16x8 b0 = *(const LAS bf16x8*)(Ks + kq[d0 & 3] + 128 * (d0 >> 2));
        const bf16x8 b1 = *(const LAS bf16x8*)(Ks + kq[d0 & 3] + 128 * (d0 >> 2) + 32 * 384);
        bf16x8 qv; if (d0 < 8) qv = qr[d0]; else qv = *(const LAS bf16x8*)(qrp + (((2 * (d0 - 8) + hi) ^ qsw) << 4));
        p0 = __builtin_amdgcn_mfma_f32_32x32x16_bf16(b0, qv, p0, 0, 0, 0);
        p1 = __builtin_amdgcn_mfma_f32_32x32x16_bf16(b1, qv, p1, 0, 0, 0); }
}
__device__ __forceinline__ int v_st(int k, int c) { const int kk = (k & ~0xC) | ((k & 4) << 1) | ((k & 8) >> 1); return ((kk >> 3) * 4 + (c >> 5)) * 512 + ((kk & 7) * 32 + (c & 31)) * 2; }
__device__ __forceinline__ int v_rd_base(int lane) { return ((lane & 3) << 3) | (((lane >> 2) & 3) << 6) | (((lane >> 4) & 1) << 5) | (((lane >> 5) & 1) << 8); }
constexpr int v_rd_off(int d0, int ks, int half) { return d0 * 512 + ks * 4096 + half * 2048; }
template <int OFF> __device__ __forceinline__ s16x4 tr_read(int vb) {
    s16x4 r; asm volatile("ds_read_b64_tr_b16 %0, %1 offset:%2" : "=&v"(r) : "v"(vb), "i"(OFF) : "memory"); return r;
}
template <int D0> __device__ __forceinline__ void pv_one(f32x16& od, int vb, bf16x8 pa0, bf16x8 pa1, bf16x8 pa2, bf16x8 pa3) {
    const s16x4 l0 = tr_read<v_rd_off(D0, 0, 0)>(vb), h0 = tr_read<v_rd_off(D0, 0, 1)>(vb), l1 = tr_read<v_rd_off(D0, 1, 0)>(vb), h1 = tr_read<v_rd_off(D0, 1, 1)>(vb);
    const s16x4 l2 = tr_read<v_rd_off(D0, 2, 0)>(vb), h2 = tr_read<v_rd_off(D0, 2, 1)>(vb), l3 = tr_read<v_rd_off(D0, 3, 0)>(vb), h3 = tr_read<v_rd_off(D0, 3, 1)>(vb);
    asm volatile("s_waitcnt lgkmcnt(0)" ::: "memory"); SBAR();
#define PK(Lo, Hi) (bf16x8){Lo[0], Lo[1], Lo[2], Lo[3], Hi[0], Hi[1], Hi[2], Hi[3]}
    od = __builtin_amdgcn_mfma_f32_32x32x16_bf16(pa0, PK(l0, h0), od, 0, 0, 0);
    od = __builtin_amdgcn_mfma_f32_32x32x16_bf16(pa1, PK(l1, h1), od, 0, 0, 0);
    od = __builtin_amdgcn_mfma_f32_32x32x16_bf16(pa2, PK(l2, h2), od, 0, 0, 0);
    od = __builtin_amdgcn_mfma_f32_32x32x16_bf16(pa3, PK(l3, h3), od, 0, 0, 0);
#undef PK
}
__device__ __forceinline__ void pv_d0(f32x16* o, int vb, bf16x8 pa0, bf16x8 pa1, bf16x8 pa2, bf16x8 pa3) {
    pv_one<0>(o[0], vb, pa0, pa1, pa2, pa3); pv_one<1>(o[1], vb, pa0, pa1, pa2, pa3); pv_one<2>(o[2], vb, pa0, pa1, pa2, pa3); pv_one<3>(o[3], vb, pa0, pa1, pa2, pa3);
}
template <bool DIRECT>
__device__ __forceinline__ void attn_unit(LAS unsigned char* lds, const bf16_t* QKV, const bf16_t* Z, int qrow0, int h, int crow0, int lrow0, int t0, int NT,
                                          float* Opart, float* Lse, bf16_t* MIX, const int tid) {
    const int wid = tid >> 6, lane = tid & 63, r32 = lane & 31, hi = lane >> 5;
    LAS unsigned char* V_lds = lds; LAS unsigned char* K_lds = lds + OFF_K;
    LAS float* ws = (LAS float*)(lds + OFF_WS) + wid * 64; LAS float* li_l = ws; LAS float* al_l = ws + 32;
    float m_reg = -1e30f, l_reg = 0; f32x16 o[4] = {}; bf16x8 qr[8];
    const bf16_t* Qw = QKV + (size_t)(qrow0 + wid * QBLK + r32) * NUP + h * 192 + hi * 8;
#pragma unroll
    for (int d0 = 0; d0 < 8; ++d0) qr[d0] = *(const bf16x8*)(Qw + d0 * 16);
    LAS unsigned char* qrp = lds + OFF_QR + wid * 4096 + r32 * 128; const int qsw = (r32 >> 1) & 7;
    int kq[4];
#pragma unroll
    for (int q = 0; q < 4; ++q) kq[q] = 384 * r32 + (((2 * q + hi) ^ qsw) << 4);
#pragma unroll
    for (int d0 = 8; d0 < 12; ++d0) *(LAS bf16x8*)(qrp + (((2 * (d0 - 8) + hi) ^ qsw) << 4)) = *(const bf16x8*)(Qw + d0 * 16);
    const int sr = tid >> 4, sc = (tid & 15) * 8;
    const int vst0 = v_st(sr, sc);
    const int kst0 = KSWZ(sr, sc * 2);
    const int krst = KSWZ(tid >> 3, 256 + (tid & 7) * 16);
    const unsigned voffV = (unsigned)(sr * NUP + sc) * 2u, voffR = (unsigned)((tid >> 3) * INWP + (tid & 7) * 8) * 2u;
    const char* Vb = (const char*)(QKV + 768 + h * 256 + 128); const char* Kb = (const char*)(QKV + 768 + h * 256); const char* Rb = (const char*)(Z + ZKR);
    const int vb0 = (int)(uintptr_t)V_lds + v_rd_base(lane);
    bf16x8 vs0, vs1, ks0, ks1, ks2;
#define ROW0(kt) (((t0) + (kt)) < 4 ? crow0 + 64 * ((t0) + (kt)) : lrow0 + 64 * ((t0) + (kt) - 4))
#define SLOADV(kt) do { const size_t _r0 = (size_t)__builtin_amdgcn_readfirstlane(ROW0(kt)); const char* _v = Vb + _r0 * (NUP * 2) + voffV; \
    vs0 = *(const bf16x8*)(_v); vs1 = *(const bf16x8*)(_v + 32 * NUP * 2); } while (0)
#define SLOADK(kt) do { const size_t _r0 = (size_t)__builtin_amdgcn_readfirstlane(ROW0(kt)); const char* _k = Kb + _r0 * (NUP * 2) + voffV; \
    ks0 = *(const bf16x8*)(_k); ks1 = *(const bf16x8*)(_k + 32 * NUP * 2); ks2 = *(const bf16x8*)(Rb + _r0 * (INWP * 2) + voffR); } while (0)
#define SLOAD(kt) do { SLOADV(kt); SLOADK(kt); } while (0)
#define SWRITE(b) do { *(LAS bf16x8*)(V_lds + (b) * SHM_V + vst0) = vs0; *(LAS bf16x8*)(V_lds + (b) * SHM_V + vst0 + 8192) = vs1; \
    *(LAS bf16x8*)(K_lds + (b) * SHM_K + kst0) = ks0; *(LAS bf16x8*)(K_lds + (b) * SHM_K + kst0 + 32 * 384) = ks1; *(LAS bf16x8*)(K_lds + (b) * SHM_K + krst) = ks2; } while (0)
#define SWAIT() asm volatile("s_waitcnt vmcnt(0)" ::: "memory")
#define RESC(a) do { if (__any((a) < 1.f)) { if (hi == 0) al_l[r32] = (a); asm volatile("s_waitcnt lgkmcnt(0)" ::: "memory"); \
    _Pragma("unroll") for (int d = 0; d < 4; ++d) _Pragma("unroll") for (int r = 0; r < 16; ++r) o[d][r] *= al_l[crow(r, hi)]; } } while (0)
    f32x16 pA0, pA1, pB0, pB1; float mnA, mnB, alA, alB; bf16x8 pa0, pa1, pa2, pa3;
    SLOAD(0); SWAIT(); SWRITE(0); __syncthreads();
    qkt(pA0, pA1, K_lds, qr, qrp, qsw, kq, hi); partialSM(pA0, pA1, m_reg, mnA, alA);
    SLOAD(1);
    SWAIT(); SWRITE(1); __syncthreads();
    if (2 < NT) SLOAD(2);
    for (int j = 1; j + 1 < NT; j += 2) {
        SBAR(); qkt(pB0, pB1, K_lds + SHM_K, qr, qrp, qsw, kq, hi);
        finishSM(pA0, pA1, alA, l_reg, pa0, pa1, pa2, pa3); SBAR();
        pv_d0(o, vb0, pa0, pa1, pa2, pa3); partialSM(pB0, pB1, m_reg, mnB, alB);
        __syncthreads(); SWAIT(); SWRITE(0); SBAR(); SLOAD(j + 2); SBAR();
        RESC(alB); __syncthreads();
        SBAR(); qkt(pA0, pA1, K_lds, qr, qrp, qsw, kq, hi);
        finishSM(pB0, pB1, alB, l_reg, pa0, pa1, pa2, pa3); SBAR();
        pv_d0(o, vb0 + SHM_V, pa0, pa1, pa2, pa3); partialSM(pA0, pA1, m_reg, mnA, alA);
        __syncthreads(); SWAIT(); SWRITE(1); SBAR(); if (j + 3 < NT) SLOAD(j + 3); SBAR();
        RESC(alA); __syncthreads();
    }
    SBAR(); qkt(pB0, pB1, K_lds + SHM_K, qr, qrp, qsw, kq, hi);
    finishSM(pA0, pA1, alA, l_reg, pa0, pa1, pa2, pa3); SBAR();
    pv_d0(o, vb0, pa0, pa1, pa2, pa3); partialSM(pB0, pB1, m_reg, mnB, alB);
    __syncthreads(); RESC(alB);
    finishSM(pB0, pB1, alB, l_reg, pa0, pa1, pa2, pa3); SBAR();
    pv_d0(o, vb0 + SHM_V, pa0, pa1, pa2, pa3);
    if (hi == 0) li_l[r32] = l_reg; asm volatile("s_waitcnt lgkmcnt(0)" ::: "memory");
    float rli[16];
#pragma unroll
    for (int r = 0; r < 16; ++r) rli[r] = __builtin_amdgcn_rcpf(li_l[crow(r, hi)]);
    const int qw0 = qrow0 + wid * QBLK;
    if constexpr (DIRECT) {
#pragma unroll
        for (int r = 0; r < 16; ++r) { const int orow = crow(r, hi);
#pragma unroll
            for (int d0 = 0; d0 < 4; ++d0) MIX[(size_t)(qw0 + orow) * DM + 1536 + h * 128 + d0 * 32 + r32] = f2bf(o[d0][r] * rli[r]); }
    } else {
#pragma unroll
        for (int r = 0; r < 16; ++r) { const int orow = crow(r, hi);
#pragma unroll
            for (int d0 = 0; d0 < 4; ++d0) Opart[(size_t)(qw0 + orow) * 512 + h * 128 + d0 * 32 + r32] = o[d0][r] * rli[r]; }
        if (hi == 0) Lse[(size_t)(qw0 + r32) * 4 + h] = m_reg * (SCALE * 1.4426950408889634f) + __builtin_amdgcn_logf(l_reg);
    }
    __syncthreads();
#undef ROW0
#undef SLOAD
#undef SWRITE
#undef SWAIT
#undef RESC
}
#undef KSWZ
#undef SBAR
}

__device__ __forceinline__ void attn_combine(const Params& P, int tid, int G, int bid) {
    const float* OP = (const float*)(P.ws + WS_OP); const float* LS = (const float*)(P.ws + WS_LSE); bf16_t* MIX = (bf16_t*)(P.ws + WS_MIX);
    for (int i = bid * 512 + tid; i < ML * 64; i += G * 512) {
        const int row = i >> 6, rem = i & 63, h = rem >> 4, cg = (rem & 15) * 8;
        const float l1 = LS[(size_t)row * 4 + h], l2 = LS[((size_t)ML + row) * 4 + h], m = fmaxf(l1, l2);
        float w1 = __builtin_amdgcn_exp2f(l1 - m), w2 = __builtin_amdgcn_exp2f(l2 - m); const float inv = 1.0f / (w1 + w2); w1 *= inv; w2 *= inv;
        const float* a = OP + (size_t)row * 512 + h * 128 + cg; const float* b = OP + ((size_t)ML + row) * 512 + h * 128 + cg;
        const f32x4 a0 = *(const f32x4*)a, a1 = *(const f32x4*)(a + 4), b0 = *(const f32x4*)b, b1 = *(const f32x4*)(b + 4);
        const f32x4 o0 = a0 * w1 + b0 * w2, o1 = a1 * w1 + b1 * w2;
        u32x4 w; w.x = cvt_pk_bf16(o0[0], o0[1]); w.y = cvt_pk_bf16(o0[2], o0[3]); w.z = cvt_pk_bf16(o1[0], o1[1]); w.w = cvt_pk_bf16(o1[2], o1[3]);
        *(u32x4*)(MIX + (size_t)row * DM + 1536 + h * 128 + cg) = w;
    }
}

constexpr int PH_PER_LAYER = 9, N_PHASES = 2 + DEPTH * PH_PER_LAYER + 1;
typedef const __attribute__((address_space(4))) Params* KParams;
__global__ void __launch_bounds__(512, 2) mk_fwd(Params Pk) {
    extern __shared__ __attribute__((aligned(16))) unsigned char lds_raw[];
    LAS unsigned char* lds = (LAS unsigned char*)lds_raw;
    const int G = gridDim.x, bid = blockIdx.x;
    KParams kp0 = (KParams)__builtin_amdgcn_kernarg_segment_ptr();
    const int wave0 = __builtin_amdgcn_readfirstlane(threadIdx.x >> 6);
#define OPQ int tid; asm volatile("v_mbcnt_lo_u32_b32 %0, -1, 0\n\tv_mbcnt_hi_u32_b32 %0, -1, %0" : "=v"(tid)); tid |= wave0 << 6; const int lane = tid & 63, wave = __builtin_amdgcn_readfirstlane(tid >> 6); (void)lane; (void)wave; \
    KParams kp = kp0; asm volatile("" : "+s"(kp)); Params P; {   \
      const GAS float* const __attribute__((address_space(4)))* _q = (const GAS float* const __attribute__((address_space(4)))*)kp; const float** _d = (const float**)&P; \
      _Pragma("unroll") for (int _i = 0; _i < 28; ++_i) _d[_i] = (const float*)_q[_i]; P.ph_lo = kp->ph_lo; P.ph_hi = kp->ph_hi; } \
    unsigned char* const ws = P.ws; (void)ws;
    volatile LAS unsigned* MISC = (volatile LAS unsigned*)(lds + LDS_MISC);
    for (int u = threadIdx.x; u < 256; u += 512) ((LAS unsigned*)(lds + LDS_MISC))[u] = 0u;
    __syncthreads();
    const int lo = kp0->ph_lo, hi = kp0->ph_hi;
    XcdBarrier bar; bar.bar = (unsigned*)(kp0->ws + WS_CTL) + 1024; bar.x = 0; bar.st = nullptr;
    if (hi - lo > 1) bar = xcd_barrier_post((unsigned*)(kp0->ws + WS_CTL) + 1024, MISC + 8);
#define IN(k) (lo <= (k) && (k) < hi)
#define SEAM(k) do { if (IN(k) && IN((k) + 1)) { xcd_barrier(bar); if (PROBE_ID == 21) xcd_barrier(bar); } } while (0)
#define XRES ((float*)(ws + WS_XRES))
#define MODL ((const float*)(ws + WS_MODV) + (size_t)layer * 3 * 6 * DM)
#define RSTAT ((float*)(ws + WS_RSTAT) + (size_t)layer * MT * 2)
#define ROPE ((const f32x2*)(ws + WS_ROPE))
#define HB ((bf16_t*)(ws + WS_H))
#define ZB ((bf16_t*)(ws + WS_Z))
#define QKVB ((bf16_t*)(ws + WS_QKV))
#define MIXB ((bf16_t*)(ws + WS_MIX))
#define UB_ ((bf16_t*)(ws + WS_U))
#define SLAB ((float*)(ws + WS_GU))

    for (int rp = 0; rp < PREP(1); ++rp) { if (PHM(0) && IN(0)) { OPQ phase_p0a(P, lds, tid, lane, wave, G, bid); } if (rp + 1 < PREP(1)) { __syncthreads(); } } SEAM(0);
    if (PHM(1) && IN(1)) { OPQ phase_p0b(P, tid, G, bid); } SEAM(1);

    for (int layer = 0; layer < DEPTH; ++layer) {
        const int pb = 2 + layer * PH_PER_LAYER;
        const bool need_ctx = layer < DEPTH - 1;
        const int mrows = need_ctx ? MT : ML;

        for (int rp = 0; rp < PREP(3); ++rp) if (PHM(2) && IN(pb + 0)) { OPQ
            const float* xl = layer == 0 ? P.x : XRES; const float* xc = layer == 0 ? P.ctx : XRES + (size_t)ML * DM;
            phase_norm(lds, xl, xc, MODL, 1, 0, HB, true, SLAB, layer == 0 ? 0 : 11, MODL - (size_t)3 * 6 * DM + ((size_t)2 * 6 + 5) * DM, XRES + (size_t)ML * DM, tid, lane, wave, G, bid); } SEAM(pb + 0);
        for (int rp = 0; rp < PREP(5); ++rp) if (PHM(3) && IN(pb + 1)) { OPQ
            pg8::Gemm g{HB, (const bf16_t*)(ws + WS_WIN) + (size_t)layer * INWP * DM, MT, INWP, DM, DM, DM}; pg8::StaticOrder S; S.init(MT, INWP, G, bid);
            pg8::EpiIn E{ZB, rp == 0 ? RSTAT : (float*)(ws + WS_OP), ROPE};
            pg8::gemm_phase<pg8::EpiIn, pg8::StaticOrder>(lds, g, S, E, tid);
        } SEAM(pb + 1);
        for (int rp = 0; rp < PREP(2); ++rp) {
        for (int rq = 0; rq < PREP(8); ++rq) if (IN(pb + 2)) {
            { OPQ
            for (int r2 = 0; r2 < PREP(16); ++r2) if (PHM(4)) {
                pg8::Gemm g{ZB + ZCQ, (const bf16_t*)(ws + WS_WUP) + (size_t)layer * NUP * KUP, MT, NUP, KUP, INWP, KUP}; pg8::StaticOrder S; S.init(MT, NUP, G, bid);
                pg8::EpiUp E{QKVB, RSTAT, ROPE};
                pg8::gemm_phase<pg8::EpiUp, pg8::StaticOrder>(lds, g, S, E, tid);
            }
            constexpr int N_G1 = 2 * 4 * NCH, N_CF = MT / 16, N_SC = MT / 16;
            const int nup_units = (MT / 256) * (NUP / 256);
            int start = bid - (nup_units % G); if (start < 0) start += G;
#define FIRST_OF(base) ((base) + ((((start) - (base)) % G) + G) % G)
            for (int r2 = 0; r2 < PREP(11); ++r2) if (PHM(5)) gla_g1_loop(lds, P, layer, FIRST_OF(0), N_G1, G, tid, lane, wave);
            }
            { OPQ
            const int nup_units = (MT / 256) * (NUP / 256); constexpr int N_G1 = 2 * 4 * NCH, N_CF = MT / 16;
            int start = bid - (nup_units % G); if (start < 0) start += G;
            for (int r2 = 0; r2 < PREP(12); ++r2) if (PHM(6)) conf_loop(lds, P, layer, FIRST_OF(N_G1) - N_G1, N_CF, G, tid, lane, wave);
            }
            { OPQ
            const int nup_units = (MT / 256) * (NUP / 256); constexpr int N_G1 = 2 * 4 * NCH, N_CF = MT / 16, N_SC = MT / 16;
            int start = bid - (nup_units % G); if (start < 0) start += G;
            for (int r2 = 0; r2 < PREP(17); ++r2) if (PHM(7)) for (int it = FIRST_OF(N_G1 + N_CF); it < N_G1 + N_CF + N_SC; it += G) sconv_item(P, layer, it - N_G1 - N_CF, tid);
#undef FIRST_OF
            }
        } SEAM(pb + 2);
        for (int rq = 0; rq < PREP(9); ++rq) if (IN(pb + 3)) { OPQ
            for (int r2 = 0; r2 < PREP(14); ++r2) if (PHM(8)) gla_g2(P, tid, G, bid);
            for (int r2 = 0; r2 < PREP(13); ++r2) if (PHM(9)) for (int u = bid; u < 256; u += G) {
                const int bh = u & 7, sub = u >> 3, b = bh >> 2, h = bh & 3, qb = sub >> 1, half = sub & 1;
                att::attn_unit<false>(lds, QKVB, ZB, b * SEQ + qb * 256, h, ML + b * CTX, b * SEQ, half * 34, 34,
                                      (float*)(ws + WS_OP) + (size_t)half * ML * 512, (float*)(ws + WS_LSE) + (size_t)half * ML * 4, MIXB, tid);
            }
        } SEAM(pb + 3);
        for (int rq = 0; rq < PREP(10); ++rq) if (IN(pb + 4)) { OPQ
            for (int r2 = 0; r2 < PREP(15); ++r2) if (PHM(10)) gla_g3_loop(lds, P, layer, bid, 2 * 4 * NCH, G, tid, lane, wave);
            for (int r2 = 0; r2 < PREP(18); ++r2) if (PHM(11)) attn_combine(P, tid, G, bid);
            if (PHM(12) && need_ctx) {
                int start = bid - ((2 * 4 * NCH) % G); if (start < 0) start += G;
                for (int u = start; u < 8; u += G) { const int b = u >> 2, h = u & 3;
                    att::attn_unit<true>(lds, QKVB, ZB, ML + b * CTX, h, ML + b * CTX, 0, 0, 4, nullptr, nullptr, MIXB, tid); }
            }
        } SEAM(pb + 4);
        }
        for (int rp = 0; rp < PREP(6); ++rp) if (PHM(13) && IN(pb + 5)) { OPQ
            const float* xl = layer == 0 ? P.x : XRES; const float* xc = layer == 0 ? P.ctx : XRES + (size_t)ML * DM;
            pg8::Gemm g{MIXB, (const bf16_t*)(ws + WS_WOUT) + (size_t)layer * DM * DM, ML, DM, DM, DM, DM}; pg8::StaticOrder S; S.init(ML, DM, G, bid);
            pg8::EpiRes E{xl, xc, rp == 0 ? XRES : (float*)(ws + WS_OP), MODL + 2 * DM};
            pg8::gemm_phase<pg8::EpiRes, pg8::StaticOrder>(lds, g, S, E, tid);
            if (need_ctx) {
                pg8::Gemm g2{MIXB + (size_t)ML * DM, (const bf16_t*)(ws + WS_WOUT) + (size_t)layer * DM * DM, MC, DM, 256, DM, DM}; pg8::SplitKOrder S2; S2.init(8, G, bid);
                pg8::EpiSlab E2{SLAB};
                pg8::gemm_phase<pg8::EpiSlab, pg8::SplitKOrder>(lds, g2, S2, E2, tid);
            }
        } SEAM(pb + 5);
        for (int rp = 0; rp < PREP(3); ++rp) if (PHM(2) && IN(pb + 6)) { OPQ
            const float* xc = layer == 0 ? P.ctx : XRES + (size_t)ML * DM;
            phase_norm(lds, XRES, xc, MODL, 4, 3, HB, need_ctx, SLAB, 8, MODL + ((size_t)2 * 6 + 2) * DM, XRES + (size_t)ML * DM, tid, lane, wave, G, bid); } SEAM(pb + 6);
        for (int rp = 0; rp < PREP(4); ++rp) if (PHM(14) && IN(pb + 7)) { OPQ
            pg8::Gemm g{HB, (const bf16_t*)(ws + WS_W13) + (size_t)layer * 2 * DFF * DM, mrows, 2 * DFF, DM, DM, DM}; pg8::StaticOrder S; S.init(mrows, 2 * DFF, G, bid);
            pg8::EpiSwiglu E{UB_};
            pg8::gemm_phase<pg8::EpiSwiglu, pg8::StaticOrder>(lds, g, S, E, tid);
        } SEAM(pb + 7);
        for (int rp = 0; rp < PREP(7); ++rp) if (PHM(15) && IN(pb + 8)) { OPQ
            pg8::Gemm g{UB_, (const bf16_t*)(ws + WS_W2) + (size_t)layer * DM * DFF, ML, DM, DFF, DFF, DFF}; pg8::StaticOrder S; S.init(ML, DM, G, bid);
            pg8::EpiRes E{XRES, XRES + (size_t)ML * DM, rp == 0 ? XRES : (float*)(ws + WS_OP), MODL + 5 * DM};
            pg8::gemm_phase<pg8::EpiRes, pg8::StaticOrder>(lds, g, S, E, tid);
            if (need_ctx) {
                pg8::Gemm g2{UB_ + (size_t)ML * DFF, (const bf16_t*)(ws + WS_W2) + (size_t)layer * DM * DFF, MC, DM, 512, DFF, DFF}; pg8::SplitKOrder S2; S2.init(11, G, bid);
                pg8::EpiSlab E2{SLAB};
                pg8::gemm_phase<pg8::EpiSlab, pg8::SplitKOrder>(lds, g2, S2, E2, tid);
            }
        } SEAM(pb + 8);
    }
    if (PHM(16) && IN(N_PHASES - 1)) { OPQ phase_final(XRES, P.final_g, P.out, lane, wave, G, bid); }
#undef IN
#undef SEAM
}

extern "C" void kernel_launch(void* const* d_in, const int* in_sizes, int n_in, void* d_out, int out_size, void* d_ws, size_t ws_size, hipStream_t stream) {
    static int grid = 0;
    if (grid == 0) {
        if (n_in != 26 || in_sizes[0] != ML * DM || out_size != ML * DM || ws_size < WS_END) {
            fprintf(stderr, "kernel_launch: shape mismatch: n_in %d in0 %d out %d ws %zu (need %zu); nothing launched\n", n_in, n_in > 0 ? in_sizes[0] : -1, out_size, ws_size, (size_t)WS_END); grid = -1; return; }
        int dev = 0, cus = 0, per_cu = 0;
        if (hipGetDevice(&dev) != hipSuccess || hipDeviceGetAttribute(&cus, hipDeviceAttributeMultiprocessorCount, dev) != hipSuccess) { fprintf(stderr, "kernel_launch: device query failed\n"); grid = -1; return; }
        if (hipFuncSetAttribute((const void*)mk_fwd, hipFuncAttributeMaxDynamicSharedMemorySize, LDS_BYTES) != hipSuccess) { fprintf(stderr, "kernel_launch: hipFuncSetAttribute failed\n"); grid = -1; return; }
        if (hipOccupancyMaxActiveBlocksPerMultiprocessor(&per_cu, (const void*)mk_fwd, 512, LDS_BYTES) != hipSuccess || per_cu < 1)
            fprintf(stderr, "kernel_launch: note: occupancy query reports %d workgroups per CU\n", per_cu);
        (void)hipGetLastError();
        grid = cus;
    }
    if (grid < 0) return;
    if (hipMemsetAsync((char*)d_ws + WS_CTL, 0, CTL_BYTES, stream) != hipSuccess) { fprintf(stderr, "kernel_launch: memset failed\n"); return; }
    Params p{};
    const float** pp = (const float**)&p;
    for (int i = 0; i < 26; ++i) pp[i] = (const float*)d_in[i];
    p.out = (float*)d_out; p.ws = (unsigned char*)d_ws;
#if MK_MULTI
    for (int ph = 0; ph < N_PHASES; ++ph) { p.ph_lo = ph; p.ph_hi = ph + 1; hipLaunchKernelGGL(mk_fwd, dim3(grid), dim3(512), LDS_BYTES, stream, p); }
#else
    p.ph_lo = 0; p.ph_hi = N_PHASES;
    hipLaunchKernelGGL(mk_fwd, dim3(grid), dim3(512), LDS_BYTES, stream, p);
#endif
    const hipError_t le = hipPeekAtLastError();
    if (le != hipSuccess) fprintf(stderr, "kernel_launch: launch failed: %s\n", hipGetErrorName(le));
}
```

```cpp
#include <hip/hip_runtime.h>
#include <cstdio>
#include <cstdint>

#ifndef MK_MULTI
#define MK_MULTI 0
#endif

#ifndef PH_MASK
#define PH_MASK 0xFFFFFFFFu
#endif
#define PHM(b) ((PH_MASK >> (b)) & 1u)
#ifndef PROBE_ID
#define PROBE_ID 0
#endif
#define PREP(id) (PROBE_ID == (id) ? 2 : 1)
#define LAS __attribute__((address_space(3)))
#define GAS __attribute__((address_space(1)))
typedef unsigned short bf16_t;
typedef short bf16x8 __attribute__((ext_vector_type(8)));
typedef short s16x4 __attribute__((ext_vector_type(4)));
typedef float f32x4 __attribute__((ext_vector_type(4)));
typedef float f32x2 __attribute__((ext_vector_type(2)));
typedef float f32x16 __attribute__((ext_vector_type(16)));
typedef unsigned u32x4 __attribute__((ext_vector_type(4)));
typedef unsigned u32x2 __attribute__((ext_vector_type(2)));

constexpr int DM = 2048, NB = 2, SEQ = 4096, CTX = 256, DEPTH = 4, DFF = 5632;
constexpr int ML = NB * SEQ, MC = NB * CTX, MT = ML + MC;
constexpr int INW = 5216, INWP = 5376;
constexpr int ZQ = 0, ZK = 512, ZV = 1024, ZG = 1536, ZLR = 2048, ZCA = 2080, ZCG = 2592, ZSB = 3104, ZSC = 3616, ZSH = 4128, ZCQ = 4640, ZCKV = 5024, ZKR = 5152;
constexpr int NUP = 1792, KUP = 512;
constexpr int NCH = 68;
constexpr float EPS = 1e-6f;

constexpr size_t al256(size_t x) { return (x + 255) / 256 * 256; }
constexpr size_t WS_CTL = 0, CTL_BYTES = 1u << 20;
constexpr size_t WS_ROPE = WS_CTL + CTL_BYTES;
constexpr size_t WS_MODP = WS_ROPE + 8192;
constexpr size_t WS_MODV = WS_MODP + al256((size_t)8 * 4 * 3 * 12288 * 4);
constexpr size_t WS_RSTAT = WS_MODV + al256((size_t)4 * 3 * 6 * 2048 * 4);
constexpr size_t WS_WIN = WS_RSTAT + al256((size_t)4 * MT * 2 * 4);
constexpr size_t WS_WOUT = WS_WIN + (size_t)4 * INWP * DM * 2;
constexpr size_t WS_W13 = WS_WOUT + (size_t)4 * DM * DM * 2;
constexpr size_t WS_W2 = WS_W13 + (size_t)4 * 2 * DFF * DM * 2;
constexpr size_t WS_WUP = WS_W2 + (size_t)4 * DM * DFF * 2;
constexpr size_t WS_XRES = WS_WUP + (size_t)4 * NUP * KUP * 2;
constexpr size_t WS_H = WS_XRES + (size_t)MT * DM * 4;
constexpr size_t WS_Z = WS_H + (size_t)MT * DM * 2;
constexpr size_t WS_QKV = WS_Z + (size_t)MT * INWP * 2;
constexpr size_t WS_MIX = WS_QKV + (size_t)MT * NUP * 2;
constexpr size_t WS_U = WS_MIX + (size_t)MT * DM * 2;
constexpr size_t WS_GU = WS_U + (size_t)MT * DFF * 2;
constexpr size_t WS_GD = WS_GU + (size_t)16 * NCH * 16384 * 4;
constexpr size_t WS_GS = WS_GD + (size_t)16 * NCH * 128 * 4;
constexpr size_t WS_OP = WS_GS + (size_t)16 * NCH * 16384 * 2;
constexpr size_t WS_LSE = WS_OP + (size_t)2 * ML * 512 * 4;
constexpr size_t WS_END = WS_LSE + (size_t)2 * ML * 4 * 4;

constexpr int LDS_MAIN = 131072, LDS_MISC = LDS_MAIN, LDS_BYTES = LDS_MAIN + 1024;

__device__ __forceinline__ unsigned cvt_pk_bf16(float lo, float hi) { unsigned r; asm volatile("v_cvt_pk_bf16_f32 %0, %1, %2" : "=v"(r) : "v"(lo), "v"(hi)); return r; }
__device__ __forceinline__ float bf2f(unsigned short b) { return __uint_as_float(((unsigned)b) << 16); }
__device__ __forceinline__ float bflo(unsigned w) { return __uint_as_float(w << 16); }
__device__ __forceinline__ float bfhi(unsigned w) { return __uint_as_float(w & 0xffff0000u); }
__device__ __forceinline__ unsigned short f2bf(float f) { return (unsigned short)(cvt_pk_bf16(f, 0.f) & 0xffffu); }
__device__ __forceinline__ float wave_sum(float v) {
#pragma unroll
    for (int o = 1; o < 64; o <<= 1) v += __shfl_xor(v, o);
    return v;
}
__device__ __forceinline__ float sigmoidf_(float x) { return __builtin_amdgcn_rcpf(1.0f + __builtin_amdgcn_exp2f(-1.4426950408889634f * x)); }
__device__ __forceinline__ float siluf_(float x) { return x * __builtin_amdgcn_rcpf(1.0f + __builtin_amdgcn_exp2f(-1.4426950408889634f * x)); }
__device__ __forceinline__ float dot4(const f32x4& v) { return (v[0] * v[0] + v[1] * v[1]) + (v[2] * v[2] + v[3] * v[3]); }
#define LDS_WAIT() asm volatile("s_waitcnt lgkmcnt(0)" ::: "memory")
#define VM_WAIT() asm volatile("s_waitcnt vmcnt(0)" ::: "memory")

namespace pg8 {
#define PG8_LAS __attribute__((address_space(3)))
constexpr int BM = 256, BK = 64, HALF = 128, HTB = HALF * BK * 2, STAGE_BYTES = 8 * HTB, NXCD = 8, WGM = 8;
__host__ __device__ __forceinline__ int lds_byte(int r, int c) { const int st = (r >> 4) * 2 + (c >> 5), rr = r & 15, cc = c & 31, ob = rr * 64 + cc * 2; return st * 1024 + (ob ^ (((ob >> 9) & 1) << 5)); }
__host__ __device__ __forceinline__ void stage_rc(int b, int& R, int& C) { const int st = b / 1024, sb = b % 1024, swz = sb ^ (((sb >> 9) & 1) << 5); R = (st >> 1) * 16 + swz / 64; C = (st & 1) * 32 + (swz % 64) / 2; }
__host__ __device__ __forceinline__ int perm32(int rho) { const int n = rho >> 4, i = rho & 15; return 8 * (i >> 2) + 4 * n + (i & 3); }
struct Unit { int pm, pn, ks, nt; };
struct Gemm { const bf16_t* A; const bf16_t* Bt; int M, N, K, lda, ldb; };
struct StaticOrder {
    int nM, nN, nwg, G, c, nt;
    __host__ __device__ void init(int M, int N, int K, int G_, int c_) { nM = M / BM; nN = N / BM; nwg = nM * nN; G = G_; c = c_; nt = K / BK; }
    __host__ __device__ bool next(int i, Unit& u) const {
        const long L = (long)i * G + c; if (L >= nwg) return false;
        int wgid = (int)L; { const int q = nwg / NXCD, r = nwg % NXCD, xcd = wgid % NXCD, off = wgid / NXCD; wgid = (xcd < r ? xcd * (q + 1) : r * (q + 1) + (xcd - r) * q) + off; }
        const int nig = WGM * nN, gid = wgid / nig, fm = gid * WGM, gsz = (nM - fm) < WGM ? (nM - fm) : WGM;
        u.pm = fm + ((wgid % nig) % gsz); u.pn = (wgid % nig) / gsz; u.ks = 0; u.nt = nt; return true;
    }
    __device__ __forceinline__ void a_ready(const Unit&) const {}
    __device__ __forceinline__ void done(const Unit&) const {}
};
template <class Epi, class Sched, bool ALIGN_EPI = true, bool SP2 = true>
__device__ __forceinline__ void gemm_phase(PG8_LAS unsigned char* lds, const Gemm g, const Sched& S, const Epi& E, const int tid) {
    const int wid = __builtin_amdgcn_readfirstlane(tid >> 6), lane = tid & 63, wr = wid >> 2, wc = wid & 3, fr = lane & 15, fq = lane >> 4;
    unsigned voffA[2], voffB[2];
#pragma unroll
    for (int i = 0; i < 2; ++i) { int R, C; stage_rc(tid * 16 + i * 8192, R, C); const int Rb = Epi::PERM ? ((R & ~31) + perm32(R & 31)) : R;
        voffA[i] = (unsigned)(R * g.lda + C) * 2u; voffB[i] = (unsigned)(Rb * g.ldb + C) * 2u; }
    const size_t kstep = (size_t)(BK * 2);
    const size_t hstepA = (size_t)HALF * g.lda * 2, hstepB = (size_t)HALF * g.ldb * 2;
    const size_t tstepA = 2 * hstepA, tstepB = 2 * hstepB;
    const unsigned ldsw = (unsigned)wid * 1024u;
    const int aoff = lds_byte(wr * 64 + fr, fq * 8), boff = lds_byte(wc * 32 + fr, fq * 8);
#define PG8_SA(b, h) (((b) * 2 + (h)) * HTB)
#define PG8_SB(b, h) ((4 + (b) * 2 + (h)) * HTB)
#define PG8_STAGE(bufoff, gbase, voff) do { _Pragma("unroll") for (int _i = 0; _i < 2; ++_i) \
        __builtin_amdgcn_global_load_lds((const unsigned*)((const char*)(gbase) + (voff)[_i]), (PG8_LAS unsigned*)(lds + (bufoff) + ldsw + _i * 8192), 16, 0, 0); } while (0)
#define PG8_LDA(dst, b, h) do { _Pragma("unroll") for (int m = 0; m < 4; ++m) _Pragma("unroll") for (int k = 0; k < 2; ++k) dst[m][k] = *(const PG8_LAS bf16x8*)(lds + PG8_SA(b, h) + aoff + m * 2048 + k * 1024); } while (0)
#define PG8_LDB(dst, b, h) do { _Pragma("unroll") for (int n = 0; n < 2; ++n) _Pragma("unroll") for (int k = 0; k < 2; ++k) dst[n][k] = *(const PG8_LAS bf16x8*)(lds + PG8_SB(b, h) + boff + n * 2048 + k * 1024); } while (0)
#define PG8_MMA(ai, bj, At, Bt) do { __builtin_amdgcn_s_setprio(1); _Pragma("unroll") for (int m = 0; m < 4; ++m) _Pragma("unroll") for (int n = 0; n < 2; ++n) _Pragma("unroll") for (int k = 0; k < 2; ++k) \
        acc[ai][bj][m][n] = __builtin_amdgcn_mfma_f32_16x16x32_bf16(Bt[n][k], At[m][k], acc[ai][bj][m][n], 0, 0, 0); __builtin_amdgcn_s_setprio(0); } while (0)
#define PG8_WAIT_V(n) asm volatile("s_waitcnt vmcnt(" #n ")" ::: "memory")
#define PG8_WAIT_L(n) asm volatile("s_waitcnt lgkmcnt(" #n ")" ::: "memory")
#define PG8_BAR __builtin_amdgcn_s_barrier()
#define PG8_SCHED __builtin_amdgcn_sched_barrier(0)
    Unit cur, nxt; int ui = 0;
    if (!S.next(0, cur)) return;
    f32x4 acc[2][2][4][2];
#pragma unroll
    for (int a = 0; a < 2; ++a)
#pragma unroll
        for (int b = 0; b < 2; ++b)
#pragma unroll
            for (int m = 0; m < 4; ++m)
#pragma unroll
                for (int n = 0; n < 2; ++n) acc[a][b][m][n] = (f32x4){0.f, 0.f, 0.f, 0.f};
    bf16x8 At[4][2], B0[2][2], B1[2][2];
    const char* cA = (const char*)g.A + (size_t)cur.pm * tstepA + (size_t)(cur.ks * cur.nt) * kstep; const char* cB = (const char*)g.Bt + (size_t)cur.pn * tstepB + (size_t)(cur.ks * cur.nt) * kstep;
    S.a_ready(cur);
    if constexpr (SP2) {
        PG8_STAGE(PG8_SB(0, 0), cB, voffB); PG8_STAGE(PG8_SB(0, 1), cB + hstepB, voffB); PG8_STAGE(PG8_SA(0, 0), cA, voffA); PG8_STAGE(PG8_SA(0, 1), cA + hstepA, voffA);
        if (wr == 1) PG8_BAR;
        PG8_WAIT_V(2); PG8_BAR;
        PG8_STAGE(PG8_SB(1, 0), cB + kstep, voffB); PG8_STAGE(PG8_SA(1, 0), cA + kstep, voffA); PG8_STAGE(PG8_SB(1, 1), cB + hstepB + kstep, voffB);
        PG8_WAIT_V(6); PG8_BAR;
    } else {
        PG8_STAGE(PG8_SB(0, 0), cB, voffB); PG8_STAGE(PG8_SA(0, 0), cA, voffA); PG8_STAGE(PG8_SB(0, 1), cB + hstepB, voffB); PG8_STAGE(PG8_SA(0, 1), cA + hstepA, voffA);
        if (wr == 1) PG8_BAR;
        PG8_WAIT_V(4); PG8_BAR;
        PG8_STAGE(PG8_SB(1, 0), cB + kstep, voffB); PG8_STAGE(PG8_SA(1, 0), cA + kstep, voffA); PG8_STAGE(PG8_SB(1, 1), cB + hstepB + kstep, voffB);
        PG8_WAIT_V(6); PG8_BAR;
    }
    for (;;) {
        const bool has_next = S.next(ui + 1, nxt);
        const char* nA = has_next ? (const char*)g.A + (size_t)nxt.pm * tstepA + (size_t)(nxt.ks * nxt.nt) * kstep : cA; const char* nB = has_next ? (const char*)g.Bt + (size_t)nxt.pn * tstepB + (size_t)(nxt.ks * nxt.nt) * kstep : cB;
        const int nt = cur.nt;
        for (int t = 0; t < nt; t += 2) {
            const bool last = (t == nt - 2);
            const char* a1 = cA + (size_t)(t + 1) * kstep;
            const char* a2 = last ? nA : cA + (size_t)(t + 2) * kstep; const char* b2 = last ? nB : cB + (size_t)(t + 2) * kstep;
            const char* a3 = a2 + kstep; const char* b3 = b2 + kstep;
            if (last && has_next) S.a_ready(nxt);
            if constexpr (SP2) {
            PG8_LDB(B0, 0, 0); PG8_LDB(B1, 0, 1); PG8_SCHED; PG8_LDA(At, 0, 0); PG8_STAGE(PG8_SA(1, 1), a1 + hstepA, voffA);
            PG8_WAIT_V(8); PG8_WAIT_L(0); PG8_BAR; PG8_MMA(0, 0, At, B0); PG8_MMA(0, 1, At, B1); PG8_BAR; PG8_SCHED;
            PG8_LDA(At, 0, 1); PG8_STAGE(PG8_SB(0, 0), b2, voffB); PG8_STAGE(PG8_SB(0, 1), b2 + hstepB, voffB); PG8_STAGE(PG8_SA(0, 0), a2, voffA);
            PG8_WAIT_V(8); PG8_WAIT_L(0); PG8_BAR; PG8_MMA(1, 0, At, B0); PG8_MMA(1, 1, At, B1); PG8_BAR; PG8_SCHED;
            PG8_LDB(B0, 1, 0); PG8_LDB(B1, 1, 1); PG8_SCHED; PG8_LDA(At, 1, 0); PG8_STAGE(PG8_SA(0, 1), a2 + hstepA, voffA);
            PG8_WAIT_V(8); PG8_WAIT_L(0); PG8_BAR; PG8_MMA(0, 0, At, B0); PG8_MMA(0, 1, At, B1); PG8_BAR; PG8_SCHED;
            PG8_LDA(At, 1, 1); PG8_STAGE(PG8_SB(1, 0), b3, voffB); PG8_STAGE(PG8_SB(1, 1), b3 + hstepB, voffB); PG8_STAGE(PG8_SA(1, 0), a3, voffA);
            PG8_WAIT_V(8); PG8_WAIT_L(0); PG8_BAR; PG8_MMA(1, 0, At, B0); PG8_MMA(1, 1, At, B1); PG8_BAR; PG8_SCHED;
            } else {
            PG8_LDB(B0, 0, 0); PG8_SCHED; PG8_LDA(At, 0, 0); PG8_STAGE(PG8_SA(1, 1), a1 + hstepA, voffA);
            PG8_WAIT_L(8); PG8_BAR; PG8_WAIT_L(0); PG8_MMA(0, 0, At, B0); PG8_BAR; PG8_SCHED;
            PG8_LDB(B1, 0, 1); PG8_STAGE(PG8_SB(0, 0), b2, voffB);
            PG8_BAR; PG8_WAIT_L(0); PG8_MMA(0, 1, At, B1); PG8_BAR;
            PG8_LDA(At, 0, 1); PG8_STAGE(PG8_SA(0, 0), a2, voffA);
            PG8_BAR; PG8_WAIT_L(0); PG8_MMA(1, 0, At, B0); PG8_BAR; PG8_SCHED;
            PG8_STAGE(PG8_SB(0, 1), b2 + hstepB, voffB);
            PG8_WAIT_V(6); PG8_BAR; PG8_MMA(1, 1, At, B1); PG8_BAR;
            PG8_LDB(B0, 1, 0); PG8_SCHED; PG8_LDA(At, 1, 0); PG8_STAGE(PG8_SA(0, 1), a2 + hstepA, voffA);
            PG8_WAIT_L(8); PG8_BAR; PG8_WAIT_L(0); PG8_MMA(0, 0, At, B0); PG8_BAR; PG8_SCHED;
            PG8_LDB(B1, 1, 1); PG8_STAGE(PG8_SB(1, 0), b3, voffB);
            PG8_BAR; PG8_WAIT_L(0); PG8_MMA(0, 1, At, B1); PG8_BAR;
            PG8_LDA(At, 1, 1); PG8_STAGE(PG8_SA(1, 0), a3, voffA);
            PG8_BAR; PG8_WAIT_L(0); PG8_MMA(1, 0, At, B0); PG8_BAR; PG8_SCHED;
            PG8_STAGE(PG8_SB(1, 1), b3 + hstepB, voffB);
            PG8_WAIT_V(6); PG8_BAR; PG8_MMA(1, 1, At, B1); PG8_BAR;
            }
        }
        if constexpr (ALIGN_EPI) { if (wr == 0) PG8_BAR; }
        E(acc, cur, wr, wc, fr, fq);
        if (!has_next) break;
#pragma unroll
        for (int a = 0; a < 2; ++a)
#pragma unroll
            for (int b = 0; b < 2; ++b)
#pragma unroll
                for (int m = 0; m < 4; ++m)
#pragma unroll
                    for (int n = 0; n < 2; ++n) acc[a][b][m][n] = (f32x4){0.f, 0.f, 0.f, 0.f};
        cur = nxt; cA = nA; cB = nB; ++ui;
        if constexpr (ALIGN_EPI) { if (wr == 1) PG8_BAR; }
    }
    PG8_WAIT_V(0);
    if constexpr (!ALIGN_EPI) { if (wr == 0) PG8_BAR; }
    PG8_BAR;
#undef PG8_SA
#undef PG8_SB
#undef PG8_STAGE
#undef PG8_LDA
#undef PG8_LDB
#undef PG8_MMA
#undef PG8_WAIT_V
#undef PG8_WAIT_L
#undef PG8_BAR
#undef PG8_SCHED
}

struct ResOrder {
    StaticOrder main; int nmine, nctx, ntc;
    __host__ __device__ void init(int K, int nsplit, int G_, int c_) { main.init(8192, 2048, K, G_, c_); nmine = c_ < main.nwg ? (main.nwg - c_ + G_ - 1) / G_ : 0; nctx = 16 * nsplit; ntc = nsplit ? (K / BK) / nsplit : 0; }
    __host__ __device__ bool next(int i, Unit& u) const {
        if (i < nmine) return main.next(i, u);
        const int L = (i - nmine) * main.G + main.c; if (L >= nctx) return false;
        u.pm = 32 + (L & 1); const int rest = L >> 1; u.pn = rest & 7; u.ks = rest >> 3; u.nt = ntc; return true;
    }
    __device__ __forceinline__ void a_ready(const Unit&) const {}
    __device__ __forceinline__ void done(const Unit&) const {}
};
__device__ __forceinline__ void rope8(f32x4& v0, f32x4& v1, const f32x2* cs) {
    const f32x2 c0 = cs[0], c1 = cs[1], c2 = cs[2], c3 = cs[3];
    float a, b;
    a = v0[0]; b = v0[1]; v0[0] = a * c0.x - b * c0.y; v0[1] = b * c0.x + a * c0.y;
    a = v0[2]; b = v0[3]; v0[2] = a * c1.x - b * c1.y; v0[3] = b * c1.x + a * c1.y;
    a = v1[0]; b = v1[1]; v1[0] = a * c2.x - b * c2.y; v1[1] = b * c2.x + a * c2.y;
    a = v1[2]; b = v1[3]; v1[2] = a * c3.x - b * c3.y; v1[3] = b * c3.x + a * c3.y;
}

struct EpiIn {
    static constexpr bool PERM = true;
    bf16_t* Z; float* rstat; const f32x2* rope;
    __device__ __forceinline__ void operator()(const f32x4 (&acc)[2][2][4][2], const Unit& u, int wr, int wc, int fr, int fq) const {
        const int row0 = u.pm * BM + wr * 64 + fr; const int colw0 = u.pn * BM + wc * 32;
        const bool special = (u.pn >= 18);
#pragma unroll
        for (int ai = 0; ai < 2; ++ai)
#pragma unroll
            for (int m = 0; m < 4; ++m) {
                const int row = row0 + ai * HALF + m * 16;
                bf16_t* rowp = Z + (size_t)row * INWP + colw0 + 8 * fq;
                float sq = 0.f, skv = 0.f;
#pragma unroll
                for (int bj = 0; bj < 2; ++bj) {
                    f32x4 v0 = acc[ai][bj][m][0], v1 = acc[ai][bj][m][1];
                    if (special) {
                        const int colw = colw0 + bj * HALF;
                        if (colw >= ZCQ && colw < ZCKV) sq += dot4(v0) + dot4(v1);
                        else if (colw >= ZCKV && colw < ZKR) skv += dot4(v0) + dot4(v1);
                        else if (colw >= ZKR && colw < INW && u.pm < 32) {
                            const int axis = (colw - ZKR) >> 5, t = row & (SEQ - 1), pos = axis ? (t & 63) : (t >> 6);
                            rope8(v0, v1, rope + pos * 16 + 4 * fq);
                        }
                    }
                    u32x4 w; w.x = cvt_pk_bf16(v0[0], v0[1]); w.y = cvt_pk_bf16(v0[2], v0[3]); w.z = cvt_pk_bf16(v1[0], v1[1]); w.w = cvt_pk_bf16(v1[2], v1[3]);
                    *(u32x4*)(rowp + bj * HALF) = w;
                }
                if (special) {
                    sq += __shfl_xor(sq, 16); sq += __shfl_xor(sq, 32); skv += __shfl_xor(skv, 16); skv += __shfl_xor(skv, 32);
                    if (fq == 0) { if (sq != 0.f) atomicAdd(rstat + (size_t)row * 2, sq); if (skv != 0.f) atomicAdd(rstat + (size_t)row * 2 + 1, skv); }
                }
            }
    }
};
struct EpiUp {
    static constexpr bool PERM = true;
    bf16_t* O; const float* rstat; const f32x2* rope;
    __device__ __forceinline__ void operator()(const f32x4 (&acc)[2][2][4][2], const Unit& u, int wr, int wc, int fr, int fq) const {
        const int row0 = u.pm * BM + wr * 64 + fr; const int colw0 = u.pn * BM + wc * 32;
#pragma unroll
        for (int ai = 0; ai < 2; ++ai)
#pragma unroll
            for (int m = 0; m < 4; ++m) {
                const int row = row0 + ai * HALF + m * 16;
                const f32x2 ss = *(const f32x2*)(rstat + (size_t)row * 2);
                const float rq = rsqrtf(ss.x * (1.0f / 384.0f) + EPS), rkv = rsqrtf(ss.y * (1.0f / 128.0f) + EPS);
                bf16_t* rowp = O + (size_t)row * NUP + colw0 + 8 * fq;
#pragma unroll
                for (int bj = 0; bj < 2; ++bj) {
                    const int colw = colw0 + bj * HALF;
                    const float sc = colw < 768 ? rq : rkv;
                    f32x4 v0 = acc[ai][bj][m][0] * sc, v1 = acc[ai][bj][m][1] * sc;
                    if (colw < 768 && u.pm < 32) {
                        const int within = colw % 192;
                        if (within >= 128) { const int axis = (within - 128) >> 5, t = row & (SEQ - 1), pos = axis ? (t & 63) : (t >> 6); rope8(v0, v1, rope + pos * 16 + 4 * fq); }
                    }
                    u32x4 w; w.x = cvt_pk_bf16(v0[0], v0[1]); w.y = cvt_pk_bf16(v0[2], v0[3]); w.z = cvt_pk_bf16(v1[0], v1[1]); w.w = cvt_pk_bf16(v1[2], v1[3]);
                    *(u32x4*)(rowp + bj * HALF) = w;
                }
            }
    }
};
struct EpiRes {
    static constexpr bool PERM = false;
    const float* base_lat; const float* base_ctx; float* out; const float* gate;
    __device__ __forceinline__ void operator()(const f32x4 (&acc)[2][2][4][2], const Unit& u, int wr, int wc, int fr, int fq) const {
        const int row0 = u.pm * BM + wr * 64 + fr, col0 = u.pn * BM + wc * 32 + 4 * fq;
        const int r = u.pm < 16 ? 0 : (u.pm < 32 ? 1 : 2);
        const float* gp = gate + (size_t)r * 6 * DM + col0;
        f32x4 gv[2][2];
#pragma unroll
        for (int bj = 0; bj < 2; ++bj)
#pragma unroll
            for (int n = 0; n < 2; ++n) gv[bj][n] = *(const f32x4*)(gp + bj * HALF + n * 16);
#pragma unroll
        for (int ai = 0; ai < 2; ++ai)
#pragma unroll
            for (int m = 0; m < 4; ++m) {
                const int row = row0 + ai * HALF + m * 16;
                const float* bp = (u.pm < 32 ? base_lat + (size_t)row * DM : base_ctx + (size_t)(row - ML) * DM) + col0;
                float* op = out + (size_t)row * DM + col0;
#pragma unroll
                for (int bj = 0; bj < 2; ++bj)
#pragma unroll
                    for (int n = 0; n < 2; ++n) { const f32x4 b = *(const f32x4*)(bp + bj * HALF + n * 16); *(f32x4*)(op + bj * HALF + n * 16) = b + gv[bj][n] * acc[ai][bj][m][n]; }
            }
    }
};
struct EpiSlab {
    static constexpr bool PERM = false;
    float* slab;
    __device__ __forceinline__ void operator()(const f32x4 (&acc)[2][2][4][2], const Unit& u, int wr, int wc, int fr, int fq) const {
        const int row0 = (u.pm - 32) * BM + wr * 64 + fr, col0 = u.pn * BM + wc * 32 + 4 * fq;
#pragma unroll
        for (int ai = 0; ai < 2; ++ai)
#pragma unroll
            for (int m = 0; m < 4; ++m) { float* op = slab + ((size_t)u.ks * MC + row0 + ai * HALF + m * 16) * DM + col0;
#pragma unroll
                for (int bj = 0; bj < 2; ++bj)
#pragma unroll
                    for (int n = 0; n < 2; ++n) *(f32x4*)(op + bj * HALF + n * 16) = acc[ai][bj][m][n]; }
    }
};
struct EpiResSlab {
    static constexpr bool PERM = false;
    EpiRes r; EpiSlab sl;
    __device__ __forceinline__ void operator()(const f32x4 (&acc)[2][2][4][2], const Unit& u, int wr, int wc, int fr, int fq) const { if (u.pm < 32) r(acc, u, wr, wc, fr, fq); else sl(acc, u, wr, wc, fr, fq); }
};
struct EpiSwiglu {
    static constexpr bool PERM = true;
    bf16_t* U;
    __device__ __forceinline__ void operator()(const f32x4 (&acc)[2][2][4][2], const Unit& u, int wr, int wc, int fr, int fq) const {
        const int row0 = u.pm * BM + wr * 64 + fr, oc = u.pn * HALF + wc * 32 + 8 * fq;
#pragma unroll
        for (int ai = 0; ai < 2; ++ai)
#pragma unroll
            for (int m = 0; m < 4; ++m) {
                const int row = row0 + ai * HALF + m * 16;
                float o[8];
#pragma unroll
                for (int n = 0; n < 2; ++n)
#pragma unroll
                    for (int j = 0; j < 4; ++j) { const float a = acc[ai][0][m][n][j], b = acc[ai][1][m][n][j]; o[n * 4 + j] = a * b * __builtin_amdgcn_rcpf(1.0f + __builtin_amdgcn_exp2f(-1.4426950408889634f * a)); }
                u32x4 w; w.x = cvt_pk_bf16(o[0], o[1]); w.y = cvt_pk_bf16(o[2], o[3]); w.z = cvt_pk_bf16(o[4], o[5]); w.w = cvt_pk_bf16(o[6], o[7]);
                *(u32x4*)(U + (size_t)row * DFF + oc) = w;
            }
    }
};
}

#define XB_TMO      128
#define XB_XCNT(j)  (256  + 64 * (j))
#define XB_XSUB(j)  (1280 + 64 * (j))
#define XB_XGEN(j)  (2304 + 64 * (j))
#define XB_TOP      3328
#define XB_TOPGEN   3392
#define XCD_BAR_WORDS 3456
#define XB_SPIN_CAP (1u << 18)
__device__ __forceinline__ unsigned xb_ld(unsigned* p)              { return __hip_atomic_load(p, __ATOMIC_RELAXED, __HIP_MEMORY_SCOPE_AGENT); }
__device__ __forceinline__ unsigned xb_add(unsigned* p, unsigned v) { return __hip_atomic_fetch_add(p, v, __ATOMIC_RELAXED, __HIP_MEMORY_SCOPE_AGENT); }
__device__ __forceinline__ unsigned xb_xcc_id() { return (unsigned)__builtin_amdgcn_s_getreg((3 << 11) | 20) & 0xFu; }
#define XB_SPIN(cond, bar) do { unsigned _sp = 0; while (cond) { __builtin_amdgcn_s_sleep(1); \
    if ((++_sp & 255u) == 0u) { if (xb_ld(&(bar)[XB_TMO])) break; if (_sp > XB_SPIN_CAP) { atomicAdd(&(bar)[XB_TMO], 1u); break; } } } } while (0)
struct XcdBarrier { unsigned* bar; unsigned x; volatile LAS unsigned* st; };
__device__ __forceinline__ XcdBarrier xcd_barrier_post(unsigned* bar, volatile LAS unsigned* st) {
    XcdBarrier b; b.bar = bar; b.x = xb_xcc_id(); b.st = st;
    if (threadIdx.x == 0) (void)xb_add(&bar[XB_XCNT(b.x)], 1u);
    return b;
}
__device__ __forceinline__ void xcd_barrier_complete(unsigned* bar, unsigned x, unsigned& nloc, unsigned& nx) {
    const unsigned G = gridDim.x * gridDim.y * gridDim.z;
    unsigned sum, cnt, mine, sp = 0u;
    for (;;) {
        sum = 0u; cnt = 0u; mine = 0u;
#pragma unroll
        for (unsigned j = 0; j < 16; ++j) { const unsigned c = xb_ld(&bar[XB_XCNT(j)]); sum += c; cnt += (c > 0u) ? 1u : 0u; mine = (j == x) ? c : mine; }
        if (sum == G) break;
        __builtin_amdgcn_s_sleep(1);
        if ((++sp & 255u) == 0u) { if (xb_ld(&bar[XB_TMO])) break; if (sp > XB_SPIN_CAP) { atomicAdd(&bar[XB_TMO], 1u); break; } }
    }
    nloc = mine > 0u ? mine : 1u; nx = cnt > 0u ? cnt : 1u;
}
__device__ __forceinline__ void xcd_barrier(const XcdBarrier& b) {
    asm volatile("s_waitcnt vmcnt(0)" ::: "memory");
    __syncthreads();
    if (threadIdx.x == 0) {
        unsigned* bar = b.bar;
        __builtin_amdgcn_s_waitcnt(0);
        unsigned nloc = b.st[0], nx = b.st[1];
        if (nloc == 0u) { xcd_barrier_complete(bar, b.x, nloc, nx); b.st[0] = nloc; b.st[1] = nx; }
        const unsigned old = xb_add(&bar[XB_XSUB(b.x)], 1u);
        const unsigned gen = old / nloc;
        if (old + 1u == (gen + 1u) * nloc) {
            __builtin_amdgcn_fence(__ATOMIC_RELEASE, "agent");
            asm volatile("s_waitcnt vmcnt(0)" ::: "memory");
            const unsigned og = xb_add(&bar[XB_TOP], 1u);
            const unsigned tg = og / nx;
            if (og + 1u == (tg + 1u) * nx) xb_add(&bar[XB_TOPGEN], 1u);
            else XB_SPIN(xb_ld(&bar[XB_TOPGEN]) == tg, bar);
            __builtin_amdgcn_fence(__ATOMIC_ACQUIRE, "agent");
            xb_add(&bar[XB_XGEN(b.x)], 1u);
            asm volatile("s_waitcnt vmcnt(0)" ::: "memory");
        } else {
            XB_SPIN(xb_ld(&bar[XB_XGEN(b.x)]) == gen, bar);
            __builtin_amdgcn_fence(__ATOMIC_ACQUIRE, "agent");
            asm volatile("s_waitcnt vmcnt(0)" ::: "memory");
        }
    }
    __syncthreads();
}

struct Params {
    const float *x, *c, *ctx, *c_ctx, *norm1_g, *w_mod, *b_mod, *w_in, *fg_up, *fg_b, *onorm_g, *conf_dw, *conf_dw_b, *conf_ln_g, *conf_ln_b, *sc_dw,
                *qn_g, *kvn_g, *w_uq, *w_ukv, *w_out, *norm2_g, *w1, *w3, *w2, *final_g;
    float* out; unsigned char* ws; int ph_lo, ph_hi;
};

template <class RowMap>
__device__ __forceinline__ void transpose_item64(const float* W, int N, bf16_t* WT, int ldk, int kofs, const RowMap& rm, const float* gain, LAS unsigned* scr, int item, int lane) {
    const int nblk = (N + 63) >> 6, kb = item / nblk, nb = item % nblk, k0 = 64 * kb, n0 = 64 * nb;
    const bool nvalid = (n0 + lane) < N;
    const float* src = W + (size_t)k0 * N + n0 + (nvalid ? lane : 0);
    float v[64];
#pragma unroll
    for (int kk = 0; kk < 64; ++kk) v[kk] = src[(size_t)kk * N];
    if (gain) {
#pragma unroll
        for (int kk = 0; kk < 64; ++kk) v[kk] *= gain[k0 + kk];
    }
#pragma unroll
    for (int j = 0; j < 32; ++j) scr[lane * 33 + j] = cvt_pk_bf16(v[2 * j], v[2 * j + 1]);
    LDS_WAIT(); asm volatile("" ::: "memory");
    const int c = lane & 7;
#pragma unroll
    for (int j = 0; j < 8; ++j) { const int n = (lane >> 3) + 8 * j;
        if (n0 + n < N) { const LAS unsigned* q = scr + n * 33 + 4 * c; u32x4 o; o.x = q[0]; o.y = q[1]; o.z = q[2]; o.w = q[3];
            *(u32x4*)(WT + (size_t)rm(n0 + n) * ldk + kofs + k0 + 8 * c) = o; } }
    LDS_WAIT(); asm volatile("" ::: "memory");
}
struct RmId { __device__ __forceinline__ int operator()(int n) const { return n; } };
struct RmIn { __device__ __forceinline__ int operator()(int n) const { if (n < ZKR) return n; const int rc = n - ZKR, a = rc >> 5, hf = (rc >> 4) & 1, i = rc & 15; return ZKR + a * 32 + 2 * i + hf; } };
struct RmUq { __device__ __forceinline__ int operator()(int n) const { const int hd = n / 192, within = n % 192; if (within < 128) return n; const int rc = within - 128, a = rc >> 5, hf = (rc >> 4) & 1, i = rc & 15; return hd * 192 + 128 + a * 32 + 2 * i + hf; } };
struct RmOff { int off; __device__ __forceinline__ int operator()(int n) const { return off + n; } };
struct RmFf { int off; __device__ __forceinline__ int operator()(int n) const { return (n >> 7) * 256 + off + (n & 127); } };

struct Frame {
    LAS unsigned char* lds; int tid, lane, wave, G, bid; unsigned char* ws; const Params* p;
};

__device__ __forceinline__ void phase_p0a(const Params& P, LAS unsigned char* lds, int tid, int lane, int wave, int G, int bid) {
    unsigned char* ws = P.ws;
    const int gw = bid * 8 + wave, NGW = G * 8;
    const int gt = bid * 512 + tid, NGT = G * 512;
    LAS float* act = (LAS float*)(lds + 8 * 8448);
    for (int i = tid; i < 3 * DM; i += 512) { const int r = i / DM, k = i % DM; const float v = r < 2 ? P.c[r * DM + k] : P.c_ctx[k]; act[i] = v / (1.0f + expf(-v)); }
    __syncthreads();
    {
        float* modp = (float*)(ws + WS_MODP);
        for (int it = gw; it < 4 * 48 * 8; it += NGW) {
            const int layer = it / 384, rem = it % 384, cb = rem / 8, ks = rem % 8;
            const int col0 = cb * 256 + lane * 4;
            const float* Wp = P.w_mod + ((size_t)layer * DM + (size_t)ks * 256) * 12288 + col0;
            const LAS float* a0 = act + ks * 256;
            f32x4 s0 = {0.f, 0.f, 0.f, 0.f}, s1 = s0, s2 = s0;
#pragma unroll 16
            for (int k = 0; k < 256; ++k) { const f32x4 w = *(const f32x4*)(Wp + (size_t)k * 12288); s0 += w * a0[k]; s1 += w * a0[DM + k]; s2 += w * a0[2 * DM + k]; }
            float* o = modp + (((size_t)ks * 4 + layer) * 3) * 12288 + col0;
            *(f32x4*)(o) = s0; *(f32x4*)(o + 12288) = s1; *(f32x4*)(o + 2 * 12288) = s2;
        }
    }
    {
        LAS unsigned* scr = (LAS unsigned*)(lds + wave * 8448);
        constexpr int I_IN = (DM / 64) * ((INW + 63) / 64), I_OUT = (DM / 64) * (DM / 64), I_FF = (DM / 64) * (DFF / 64), I_W2 = (DFF / 64) * (DM / 64), I_UQ = (384 / 64) * (768 / 64), I_UKV = (128 / 64) * (1024 / 64);
        constexpr int PER_LAYER = I_IN + I_OUT + 2 * I_FF + I_W2 + I_UQ + I_UKV;
        for (int it = gw; it < 4 * PER_LAYER; it += NGW) {
            const int layer = it / PER_LAYER; int r = it % PER_LAYER;
            if (r < I_IN) { transpose_item64(P.w_in + (size_t)layer * DM * INW, INW, (bf16_t*)(ws + WS_WIN) + (size_t)layer * INWP * DM, DM, 0, RmIn{}, nullptr, scr, r, lane); continue; } r -= I_IN;
            if (r < I_OUT) { transpose_item64(P.w_out + (size_t)layer * DM * DM, DM, (bf16_t*)(ws + WS_WOUT) + (size_t)layer * DM * DM, DM, 0, RmId{}, nullptr, scr, r, lane); continue; } r -= I_OUT;
            if (r < I_FF) { transpose_item64(P.w1 + (size_t)layer * DM * DFF, DFF, (bf16_t*)(ws + WS_W13) + (size_t)layer * 2 * DFF * DM, DM, 0, RmFf{0}, nullptr, scr, r, lane); continue; } r -= I_FF;
            if (r < I_FF) { transpose_item64(P.w3 + (size_t)layer * DM * DFF, DFF, (bf16_t*)(ws + WS_W13) + (size_t)layer * 2 * DFF * DM, DM, 0, RmFf{128}, nullptr, scr, r, lane); continue; } r -= I_FF;
            if (r < I_W2) { transpose_item64(P.w2 + (size_t)layer * DFF * DM, DM, (bf16_t*)(ws + WS_W2) + (size_t)layer * DM * DFF, DFF, 0, RmId{}, nullptr, scr, r, lane); continue; } r -= I_W2;
            if (r < I_UQ) { transpose_item64(P.w_uq + (size_t)layer * 384 * 768, 768, (bf16_t*)(ws + WS_WUP) + (size_t)layer * NUP * KUP, KUP, 0, RmUq{}, P.qn_g + layer * 384, scr, r, lane); continue; } r -= I_UQ;
            transpose_item64(P.w_ukv + (size_t)layer * 128 * 1024, 1024, (bf16_t*)(ws + WS_WUP) + (size_t)layer * NUP * KUP, KUP, 384, RmOff{768}, P.kvn_g + layer * 128, scr, r, lane);
        }
    }
    {
        constexpr int PADW = (INWP - INW) * DM / 8;
        for (int i = gt; i < 4 * PADW; i += NGT) { const int layer = i / PADW, j = i % PADW;
            *(u32x4*)((bf16_t*)(ws + WS_WIN) + ((size_t)layer * INWP + INW) * DM + (size_t)j * 8) = (u32x4){0u, 0u, 0u, 0u}; }
        constexpr int ZQ_ = 768 * 16, ZKV_ = 1024 * 48;
        for (int i = gt; i < 4 * (ZQ_ + ZKV_); i += NGT) { const int layer = i / (ZQ_ + ZKV_), j = i % (ZQ_ + ZKV_);
            bf16_t* WU = (bf16_t*)(ws + WS_WUP) + (size_t)layer * NUP * KUP;
            if (j < ZQ_) *(u32x4*)(WU + (size_t)(j >> 4) * KUP + 384 + (j & 15) * 8) = (u32x4){0u, 0u, 0u, 0u};
            else { const int jj = j - ZQ_; *(u32x4*)(WU + (size_t)(768 + jj / 48) * KUP + (jj % 48) * 8) = (u32x4){0u, 0u, 0u, 0u}; } }
    }
    {
        f32x2* rope = (f32x2*)(ws + WS_ROPE);
        for (int i = gt; i < 1024; i += NGT) { const int pos = i >> 4, f = i & 15; const float inv = powf(10000.0f, -(float)f * 2.0f / 32.0f); const float ang = (float)pos * inv; rope[i] = (f32x2){cosf(ang), sinf(ang)}; }
        float* rs = (float*)(ws + WS_RSTAT);
        for (int i = gt; i < 4 * MT * 2; i += NGT) rs[i] = 0.f;
    }
}
__device__ __forceinline__ void phase_p0b(const Params& P, int tid, int G, int bid) {
    const float* modp = (const float*)(P.ws + WS_MODP); float* modv = (float*)(P.ws + WS_MODV);
    for (int i = bid * 512 + tid; i < 4 * 3 * 12288; i += G * 512) {
        const int layer = i / (3 * 12288), rem = i % (3 * 12288), r = rem / 12288, c12 = rem % 12288, j = c12 / DM, col = c12 % DM;
        float s = P.b_mod[layer * 12288 + c12];
#pragma unroll
        for (int ks = 0; ks < 8; ++ks) s += modp[(((size_t)ks * 4 + layer) * 3 + r) * 12288 + c12];
        if (j == 1) s = P.norm1_g[layer * DM + col] * (1.0f + s);
        if (j == 4) s = P.norm2_g[layer * DM + col] * (1.0f + s);
        modv[(((size_t)layer * 3 + r) * 6 + j) * DM + col] = s;
    }
}

__device__ __forceinline__ void phase_norm(LAS unsigned char* lds, const float* xlat, const float* xctx, const float* modl  , int jg, int jsh, bf16_t* H, bool with_ctx,
                                           const float* slab, int nslab, const float* sgate, float* xctx_out, int tid, int lane, int wave, int G, int bid) {
    if (with_ctx) {
        LAS float* red = (LAS float*)lds;
        const float* gp = modl + ((size_t)2 * 6 + jg) * DM; const float* sp = modl + ((size_t)2 * 6 + jsh) * DM;
        for (int r0 = bid * 2; r0 < MC; r0 += G * 2) {
            const int col = wave * 256 + lane * 4;
            f32x4 v[2]; float ss[2];
#pragma unroll
            for (int q = 0; q < 2; ++q) { const int row = r0 + q;
                v[q] = *(const f32x4*)(xctx + (size_t)row * DM + col);
                if (nslab > 0) { f32x4 a = {0.f, 0.f, 0.f, 0.f};
                    for (int sI = 0; sI < nslab; ++sI) a += *(const f32x4*)(slab + ((size_t)sI * MC + row) * DM + col);
                    v[q] += *(const f32x4*)(sgate + col) * a;
                    *(f32x4*)(xctx_out + (size_t)row * DM + col) = v[q]; }
                ss[q] = wave_sum(dot4(v[q])); }
            if (lane == 0) { red[wave * 2] = ss[0]; red[wave * 2 + 1] = ss[1]; }
            __syncthreads();
            const f32x4 gs = *(const f32x4*)(gp + col), sh = *(const f32x4*)(sp + col);
#pragma unroll
            for (int q = 0; q < 2; ++q) { float t = 0.f;
#pragma unroll
                for (int w = 0; w < 8; ++w) t += red[w * 2 + q];
                const float rstd = rsqrtf(t * (1.0f / DM) + EPS);
                const f32x4 o = v[q] * rstd * gs + sh; u32x2 w2; w2.x = cvt_pk_bf16(o[0], o[1]); w2.y = cvt_pk_bf16(o[2], o[3]);
                *(u32x2*)(H + (size_t)(ML + r0 + q) * DM + col) = w2; }
            __syncthreads();
        }
    }
    const int rpw = (ML + G - 1) / G;
    int cur = -1; f32x4 gsv[8], shv[8];
    for (int k = wave; k < rpw; k += 8) {
        const int row = bid * rpw + k; if (row >= ML) break;
        const int r = row < SEQ ? 0 : 1;
        if (r != cur) { cur = r; const float* gp = modl + ((size_t)r * 6 + jg) * DM; const float* sp = modl + ((size_t)r * 6 + jsh) * DM;
#pragma unroll
            for (int j = 0; j < 8; ++j) { gsv[j] = *(const f32x4*)(gp + (lane + 64 * j) * 4); shv[j] = *(const f32x4*)(sp + (lane + 64 * j) * 4); } }
        const float* xr = xlat + (size_t)row * DM;
        f32x4 v[8]; float ss = 0.f;
#pragma unroll
        for (int j = 0; j < 8; ++j) { v[j] = *(const f32x4*)(xr + (lane + 64 * j) * 4); ss += dot4(v[j]); }
        const float rstd = rsqrtf(wave_sum(ss) * (1.0f / DM) + EPS);
        bf16_t* hr = H + (size_t)row * DM;
#pragma unroll
        for (int j = 0; j < 8; ++j) { const f32x4 o = v[j] * rstd * gsv[j] + shv[j]; u32x2 w; w.x = cvt_pk_bf16(o[0], o[1]); w.y = cvt_pk_bf16(o[2], o[3]); *(u32x2*)(hr + (lane + 64 * j) * 4) = w; }
    }
}
__device__ __forceinline__ void phase_final(const float* X, const float* g, float* out, int lane, int wave, int G, int bid) {
    for (int row = bid * 8 + wave; row < ML; row += G * 8) {
        const float* xr = X + (size_t)row * DM; f32x4 v[8]; float ss = 0.f;
#pragma unroll
        for (int j = 0; j < 8; ++j) { v[j] = *(const f32x4*)(xr + (lane + 64 * j) * 4); ss += dot4(v[j]); }
        const float rstd = rsqrtf(wave_sum(ss) * (1.0f / DM) + EPS);
#pragma unroll
        for (int j = 0; j < 8; ++j) { const f32x4 gg = *(const f32x4*)(g + (lane + 64 * j) * 4); *(f32x4*)(out + (size_t)row * DM + (lane + 64 * j) * 4) = v[j] * rstd * gg; }
    }
}

constexpr int GL_RQ = 0;
constexpr int GL_RK = 16384;
constexpr int GL_RV = 32768;
constexpr int GL_QT = 49152;
constexpr int GL_KT = 66560;
constexpr int GL_PP = 83968;
constexpr int GL_VT = 93184;
constexpr int GL_LR = 111616;
constexpr int GL_TOT = 119808;
__device__ __forceinline__ int gla_row0(int b, int id) { return id < 4 ? ML + b * CTX + id * 64 : b * SEQ + (id - 4) * 64; }
struct GlaRaw { u32x4 q0, q1, k0, k1, v0, v1, l0, l1, ga, gb; };
template <bool WITH_Q>
__device__ __forceinline__ void gla_load_raw(GlaRaw& R, const bf16_t* Z, int row0, int h, int tid) {
    const int t = tid >> 3, dg = (tid & 7) * 16;
    const bf16_t* zr = Z + (size_t)(row0 + t) * INWP + h * 128 + dg;
    R.k0 = *(const u32x4*)(zr + ZK); R.k1 = *(const u32x4*)(zr + ZK + 8); R.v0 = *(const u32x4*)(zr + ZV); R.v1 = *(const u32x4*)(zr + ZV + 8);
    if (WITH_Q) { R.q0 = *(const u32x4*)(zr + ZQ); R.q1 = *(const u32x4*)(zr + ZQ + 8); R.ga = *(const u32x4*)(zr + ZG); R.gb = *(const u32x4*)(zr + ZG + 8); }
    const bf16_t* lp = Z + (size_t)(row0 + ((tid & 127) >> 1)) * INWP + ZLR + (tid & 1) * 8;
    R.l0 = *(const u32x4*)lp; R.l1 = *(const u32x4*)(lp + 16);
}
template <bool WITH_Q>
__device__ __forceinline__ void gla_store_raw(LAS unsigned char* lds, const GlaRaw& R, int tid) {
    const int t = tid >> 3, dg = (tid & 7) * 16;
    *(LAS u32x4*)(lds + GL_RK + t * 256 + dg * 2) = R.k0; *(LAS u32x4*)(lds + GL_RK + t * 256 + dg * 2 + 16) = R.k1;
    *(LAS u32x4*)(lds + GL_RV + t * 256 + dg * 2) = R.v0; *(LAS u32x4*)(lds + GL_RV + t * 256 + dg * 2 + 16) = R.v1;
    if (WITH_Q) { *(LAS u32x4*)(lds + GL_RQ + t * 256 + dg * 2) = R.q0; *(LAS u32x4*)(lds + GL_RQ + t * 256 + dg * 2 + 16) = R.q1; }
    if (tid < 128) { LAS float* LR = (LAS float*)(lds + GL_LR) + (tid >> 1) * 16 + (tid & 1) * 8; const u32x4 l0 = R.l0, l1 = R.l1;
        LR[0] = bflo(l0.x); LR[1] = bfhi(l0.x); LR[2] = bflo(l0.y); LR[3] = bfhi(l0.y); LR[4] = bflo(l0.z); LR[5] = bfhi(l0.z); LR[6] = bflo(l0.w); LR[7] = bfhi(l0.w);
        LAS float* L1 = LR + 1024;
        L1[0] = bflo(l1.x); L1[1] = bfhi(l1.x); L1[2] = bflo(l1.y); L1[3] = bfhi(l1.y); L1[4] = bflo(l1.z); L1[5] = bfhi(l1.z); L1[6] = bflo(l1.w); L1[7] = bfhi(l1.w); }
}
struct GlaFg { float w[16]; float b; };
__device__ __forceinline__ void gla_load_fg(GlaFg& F, const float* fgup  , const float* fgb  , int h, int tid) {
    const int d = tid & 127;
#pragma unroll
    for (int r = 0; r < 16; ++r) F.w[r] = fgup[r * 512 + h * 128 + d];
    F.b = fgb[h * 128 + d];
}
__device__ __forceinline__ void gla_decay_local(LAS unsigned char* lds, const GlaFg& F, int dir, int tid, float (&p)[16]) {
    const int d = tid & 127, seg = tid >> 7;
    const float (&fg)[16] = F.w; const float fb = F.b;
    const LAS float* LR = (const LAS float*)(lds + GL_LR) + dir * 1024 + seg * 256;
#pragma unroll
    for (int i = 0; i < 16; ++i) { float x = fb;
#pragma unroll
        for (int r4 = 0; r4 < 4; ++r4) { const f32x4 l = *(const LAS f32x4*)(LR + i * 16 + r4 * 4); x += l[0] * fg[r4 * 4] + l[1] * fg[r4 * 4 + 1] + l[2] * fg[r4 * 4 + 2] + l[3] * fg[r4 * 4 + 3]; }
        p[i] = (fminf(x, 0.f) - __logf(1.0f + __expf(-fabsf(x)))) * (1.0f / 16.0f); }
    if (dir == 0) {
#pragma unroll
        for (int i = 1; i < 16; ++i) p[i] += p[i - 1];
        ((LAS float*)(lds + GL_TOT))[seg * 128 + d] = p[15];
    } else {
#pragma unroll
        for (int i = 14; i >= 0; --i) p[i] += p[i + 1];
        ((LAS float*)(lds + GL_TOT))[seg * 128 + d] = p[0];
    }
}
__device__ __forceinline__ float gla_offsets(const LAS unsigned char* lds, int dir, int tid, float (&p)[16]) {
    const int d = tid & 127, seg = tid >> 7;
    const LAS float* T = (const LAS float*)(lds + GL_TOT) + d;
    const float t0 = T[0], t1 = T[128], t2 = T[256], t3 = T[384];
    float off;
    if (dir == 0) off = (seg > 0 ? t0 : 0.f) + (seg > 1 ? t1 : 0.f) + (seg > 2 ? t2 : 0.f);
    else off = (seg < 3 ? t3 : 0.f) + (seg < 2 ? t2 : 0.f) + (seg < 1 ? t1 : 0.f);
#pragma unroll
    for (int i = 0; i < 16; ++i) p[i] += off;
    return (t0 + t1) + (t2 + t3);
}
__device__ __forceinline__ void gla_build_vT(LAS unsigned char* lds, int tid) {
    const int e = tid & 127, seg = tid >> 7;
    const LAS bf16_t* RV = (const LAS bf16_t*)(lds + GL_RV) + (16 * seg) * 128 + e;
    unsigned w[8];
#pragma unroll
    for (int i = 0; i < 8; ++i) w[i] = (unsigned)RV[(2 * i) * 128] | ((unsigned)RV[(2 * i + 1) * 128] << 16);
    LAS u32x4* dst = (LAS u32x4*)(lds + GL_VT + e * 144 + seg * 32);
    dst[0] = (u32x4){w[0], w[1], w[2], w[3]}; dst[1] = (u32x4){w[4], w[5], w[6], w[7]};
}
__device__ __forceinline__ void gla_item_decode(int item, int& b, int& h, int& id) { const int bh = item & 7; id = item >> 3; b = bh >> 2; h = bh & 3; }
__device__ __forceinline__ void gla_g1_loop(LAS unsigned char* lds, const Params& P, int layer, int first, int nitems, int G, int tid, int lane, int wave) {
    if (first >= nitems) return;
    const bf16_t* Z = (const bf16_t*)(P.ws + WS_Z);
    LAS bf16_t* KH = (LAS bf16_t*)(lds + GL_QT);
    const LAS bf16_t* VT = (const LAS bf16_t*)(lds + GL_VT);
    const int d = tid & 127, seg = tid >> 7;
    int b, h, id; gla_item_decode(first, b, h, id);
    GlaRaw R; gla_load_raw<false>(R, Z, gla_row0(b, id), h, tid);
    GlaFg F0, F1; int fh = -1;
    for (int it = first; it < nitems; it += G) {
        gla_item_decode(it, b, h, id);
        if (h != fh) { fh = h; gla_load_fg(F0, P.fg_up + ((size_t)layer * 2 + 0) * 16 * 512, P.fg_b + ((size_t)layer * 2 + 0) * 512, h, tid); gla_load_fg(F1, P.fg_up + ((size_t)layer * 2 + 1) * 16 * 512, P.fg_b + ((size_t)layer * 2 + 1) * 512, h, tid); }
        gla_store_raw<false>(lds, R, tid);
        __syncthreads();
        if (it + G < nitems) { int b2, h2, id2; gla_item_decode(it + G, b2, h2, id2); gla_load_raw<false>(R, Z, gla_row0(b2, id2), h2, tid); }
#pragma unroll
        for (int dir = 0; dir < 2; ++dir) {
            const int seq = (b * 4 + h) * 2 + dir;
            float p[16];
            gla_decay_local(lds, dir == 0 ? F0 : F1, dir, tid, p);
            __syncthreads();
            const float blast = gla_offsets(lds, dir, tid, p);
            {
                const LAS bf16_t* RK = (const LAS bf16_t*)(lds + GL_RK) + (16 * seg) * 128 + d;
                unsigned w[8];
#pragma unroll
                for (int i = 0; i < 8; ++i) w[i] = cvt_pk_bf16(bf2f(RK[(2 * i) * 128]) * __expf(blast - p[2 * i]), bf2f(RK[(2 * i + 1) * 128]) * __expf(blast - p[2 * i + 1]));
                LAS u32x4* dst = (LAS u32x4*)(lds + GL_QT + d * 144 + seg * 32);
                dst[0] = (u32x4){w[0], w[1], w[2], w[3]}; dst[1] = (u32x4){w[4], w[5], w[6], w[7]};
                if (dir == 0) gla_build_vT(lds, tid);
                if (seg == 0) ((float*)(P.ws + WS_GD))[((size_t)seq * NCH + id) * 128 + d] = __expf(blast);
            }
            __syncthreads();
            {
                const int eb = wave >> 1, r32 = lane & 31, hi = lane >> 5;
                float* U = (float*)(P.ws + WS_GU) + ((size_t)seq * NCH + id) * 16384;
#pragma unroll
                for (int q = 0; q < 2; ++q) { const int db = 2 * (wave & 1) + q; f32x16 acc = {};
#pragma unroll
                    for (int kk = 0; kk < 4; ++kk) { const bf16x8 av = *(const LAS bf16x8*)(VT + (32 * eb + r32) * 72 + 16 * kk + 8 * hi), bv = *(const LAS bf16x8*)(KH + (32 * db + r32) * 72 + 16 * kk + 8 * hi);
                        acc = __builtin_amdgcn_mfma_f32_32x32x16_bf16(av, bv, acc, 0, 0, 0); }
#pragma unroll
                    for (int r = 0; r < 16; ++r) { const int e = 32 * eb + (r & 3) + 8 * (r >> 2) + 4 * hi; U[e * 128 + 32 * db + r32] = acc[r]; } }
            }
            __syncthreads();
        }
    }
}
__device__ __forceinline__ void gla_g2(const Params& P, int tid, int G, int bid) {
    const float* U = (const float*)(P.ws + WS_GU); const float* Dv = (const float*)(P.ws + WS_GD); bf16_t* S = (bf16_t*)(P.ws + WS_GS);
    for (int slot = bid * 512 + tid; slot < 16 * 8192; slot += G * 512) {
        const int seq = slot >> 13, el = (slot & 8191) * 2, d = el & 127, dir = seq & 1;
        float s0 = 0.f, s1 = 0.f;
#pragma unroll 4
        for (int p = 0; p < NCH; ++p) {
            const int id = dir == 0 ? p : (p < 4 ? 3 - p : 71 - p);
            const size_t base = ((size_t)seq * NCH + id);
            *(unsigned*)(S + base * 16384 + el) = cvt_pk_bf16(s0, s1);
            const f32x2 u = *(const f32x2*)(U + base * 16384 + el), dd = *(const f32x2*)(Dv + base * 128 + d);
            s0 = dd.x * s0 + u.x; s1 = dd.y * s1 + u.y;
        }
    }
}
__device__ __forceinline__ void gla_g3_loop(LAS unsigned char* lds, const Params& P, int layer, int first, int nitems, int G, int tid, int lane, int wave) {
    if (first >= nitems) return;
    const bf16_t* Z = (const bf16_t*)(P.ws + WS_Z);
    const int r32 = lane & 31, hi = lane >> 5, rb = wave >> 2, cb = wave & 3;
    const int d = tid & 127, seg = tid >> 7;
    LAS bf16_t* QT = (LAS bf16_t*)(lds + GL_QT); LAS bf16_t* KT = (LAS bf16_t*)(lds + GL_KT); LAS bf16_t* PP = (LAS bf16_t*)(lds + GL_PP);
    const LAS bf16_t* VT = (const LAS bf16_t*)(lds + GL_VT);
    int b, h, id; gla_item_decode(first, b, h, id);
    GlaRaw R; gla_load_raw<true>(R, Z, gla_row0(b, id), h, tid);
    GlaFg F0, F1; int fh = -1;
    for (int it = first; it < nitems; it += G) {
        gla_item_decode(it, b, h, id);
        const int row0 = gla_row0(b, id);
        if (h != fh) { fh = h; gla_load_fg(F0, P.fg_up + ((size_t)layer * 2 + 0) * 16 * 512, P.fg_b + ((size_t)layer * 2 + 0) * 512, h, tid); gla_load_fg(F1, P.fg_up + ((size_t)layer * 2 + 1) * 16 * 512, P.fg_b + ((size_t)layer * 2 + 1) * 512, h, tid); }
        const u32x4 ga = R.ga, gb = R.gb;
        gla_store_raw<true>(lds, R, tid);
        bf16x8 sf0[8], sf1[8];
        { const bf16_t* Sg = (const bf16_t*)(P.ws + WS_GS) + ((size_t)((b * 4 + h) * 2) * NCH + id) * 16384 + (size_t)(32 * cb + r32) * 128 + 8 * hi;
#pragma unroll
          for (int kk = 0; kk < 8; ++kk) { sf0[kk] = *(const bf16x8*)(Sg + 16 * kk); sf1[kk] = *(const bf16x8*)(Sg + (size_t)NCH * 16384 + 16 * kk); } }
        __syncthreads();
        if (it + G < nitems) { int b2, h2, id2; gla_item_decode(it + G, b2, h2, id2); gla_load_raw<true>(R, Z, gla_row0(b2, id2), h2, tid); }
        f32x16 o = {};
#pragma unroll
        for (int dir = 0; dir < 2; ++dir) {
            float p[16];
            gla_decay_local(lds, dir == 0 ? F0 : F1, dir, tid, p);
            __syncthreads();
            (void)gla_offsets(lds, dir, tid, p);
            {
                const LAS bf16_t* RQ = (const LAS bf16_t*)(lds + GL_RQ) + (16 * seg) * 128 + d; const LAS bf16_t* RK = (const LAS bf16_t*)(lds + GL_RK) + (16 * seg) * 128 + d;
#pragma unroll
                for (int i = 0; i < 16; ++i) { const int t = 16 * seg + i;
                    QT[t * 136 + d] = f2bf(bf2f(RQ[i * 128]) * (0.08838834764831845f * __expf(p[i])));
                    KT[t * 136 + d] = f2bf(bf2f(RK[i * 128]) * __expf(fminf(-p[i], 80.f))); }
                if (dir == 0) gla_build_vT(lds, tid);
            }
            __syncthreads();
            {
                const int bi = wave >> 1, fr = lane & 15, fq = lane >> 4;
#pragma unroll
                for (int q = 0; q < 2; ++q) { const int bj = 2 * (wave & 1) + q; f32x4 acc = {0.f, 0.f, 0.f, 0.f};
#pragma unroll
                    for (int kk = 0; kk < 4; ++kk) { const bf16x8 av = *(const LAS bf16x8*)(QT + (16 * bi + fr) * 136 + 32 * kk + 8 * fq), bv = *(const LAS bf16x8*)(KT + (16 * bj + fr) * 136 + 32 * kk + 8 * fq);
                        acc = __builtin_amdgcn_mfma_f32_16x16x32_bf16(av, bv, acc, 0, 0, 0); }
                    const int jt = 16 * bj + fr;
#pragma unroll
                    for (int r = 0; r < 4; ++r) { const int itk = 16 * bi + 4 * fq + r; const bool keep = dir == 0 ? (jt <= itk) : (jt >= itk); PP[itk * 72 + jt] = f2bf(keep ? acc[r] : 0.f); } }
            }
            __syncthreads();
            {
#pragma unroll
                for (int kk = 0; kk < 4; ++kk) { const bf16x8 av = *(const LAS bf16x8*)(PP + (32 * rb + r32) * 72 + 16 * kk + 8 * hi), bv = *(const LAS bf16x8*)(VT + (32 * cb + r32) * 72 + 16 * kk + 8 * hi);
                    o = __builtin_amdgcn_mfma_f32_32x32x16_bf16(av, bv, o, 0, 0, 0); }
#pragma unroll
                for (int kk = 0; kk < 8; ++kk) { const bf16x8 av = *(const LAS bf16x8*)(QT + (32 * rb + r32) * 136 + 16 * kk + 8 * hi);
                    o = __builtin_amdgcn_mfma_f32_32x32x16_bf16(av, dir == 0 ? sf0[kk] : sf1[kk], o, 0, 0, 0); }
            }
            __syncthreads();
        }
        LAS float* OS = (LAS float*)(lds + GL_RQ);
#pragma unroll
        for (int r = 0; r < 16; ++r) { const int t = 32 * rb + (r & 3) + 8 * (r >> 2) + 4 * hi; OS[t * 132 + 32 * cb + r32] = o[r]; }
        __syncthreads();
        {
            const int t = tid >> 3, eg = (tid & 7) * 16;
            f32x4 v[4]; float ss = 0.f;
#pragma unroll
            for (int q = 0; q < 4; ++q) { v[q] = *(const LAS f32x4*)(OS + t * 132 + eg + 4 * q); ss += dot4(v[q]); }
            ss += __shfl_xor(ss, 1); ss += __shfl_xor(ss, 2); ss += __shfl_xor(ss, 4);
            const float rstd = rsqrtf(ss * (1.0f / 128.0f) + EPS);
            const unsigned gw[8] = {ga.x, ga.y, ga.z, ga.w, gb.x, gb.y, gb.z, gb.w};
            const float* og = P.onorm_g + layer * 128 + eg;
            unsigned ow[8];
#pragma unroll
            for (int i = 0; i < 8; ++i) { const float g0 = bflo(gw[i]), g1 = bfhi(gw[i]);
                const float o0 = v[i >> 1][(i & 1) * 2] * rstd * og[2 * i] * siluf_(g0), o1 = v[i >> 1][(i & 1) * 2 + 1] * rstd * og[2 * i + 1] * siluf_(g1);
                ow[i] = cvt_pk_bf16(o0, o1); }
            bf16_t* mp = (bf16_t*)(P.ws + WS_MIX) + (size_t)(row0 + t) * DM + h * 128 + eg;
            *(u32x4*)(mp) = (u32x4){ow[0], ow[1], ow[2], ow[3]}; *(u32x4*)(mp + 8) = (u32x4){ow[4], ow[5], ow[6], ow[7]};
        }
        __syncthreads();
    }
}

struct ConfRaw { u32x4 a[6], g[6]; };
__device__ __forceinline__ void conf_load(ConfRaw& R, const bf16_t* Z, int item, int tid) {
    const int r0 = item * 16;
    const int s0 = r0 < ML ? (r0 & ~(SEQ - 1)) : ML + ((r0 - ML) & ~(CTX - 1)), s1 = s0 + (r0 < ML ? SEQ : CTX);
#pragma unroll
    for (int i = 0; i < 6; ++i) { const int pc = tid + 512 * i, rr = pc >> 6, ch = pc & 63, row = r0 - 15 + rr;
        const bool ok = (pc < 46 * 64) && row >= s0 && row < s1; const bf16_t* zp = Z + (size_t)(ok ? row : s0) * INWP + ch * 8;
        R.a[i] = *(const u32x4*)(zp + ZCA); R.g[i] = *(const u32x4*)(zp + ZCG);
        if (!ok) R.a[i] = (u32x4){0u, 0u, 0u, 0u}; }
}
__device__ __forceinline__ void conf_loop(LAS unsigned char* lds, const Params& P, int layer, int first, int nitems, int G, int tid, int lane, int wave) {
    if (first >= nitems) return;
    const bf16_t* Z = (const bf16_t*)(P.ws + WS_Z);
    LAS float* UB = (LAS float*)lds;
    LAS float* YB = (LAS float*)(lds + 46 * 512 * 4);
    const int c = tid;
    ConfRaw R; conf_load(R, Z, first, tid);
    float w[31];
#pragma unroll
    for (int j = 0; j < 31; ++j) w[j] = P.conf_dw[((size_t)layer * 31 + j) * 512 + c];
    const float bias = P.conf_dw_b[layer * 512 + c];
    const float* lg = P.conf_ln_g + layer * 512 + 8 * lane; const float* lb = P.conf_ln_b + layer * 512 + 8 * lane;
    const f32x4 g0 = *(const f32x4*)lg, g1 = *(const f32x4*)(lg + 4), b0 = *(const f32x4*)lb, b1 = *(const f32x4*)(lb + 4);
    for (int it = first; it < nitems; it += G) {
        const int r0 = it * 16;
#pragma unroll
        for (int i = 0; i < 6; ++i) { const int pc = tid + 512 * i, rr = pc >> 6, ch = pc & 63;
            if (pc < 46 * 64) { const unsigned aw[4] = {R.a[i].x, R.a[i].y, R.a[i].z, R.a[i].w}, gw[4] = {R.g[i].x, R.g[i].y, R.g[i].z, R.g[i].w};
                f32x4 u0, u1;
                u0[0] = bflo(aw[0]) * sigmoidf_(bflo(gw[0])); u0[1] = bfhi(aw[0]) * sigmoidf_(bfhi(gw[0])); u0[2] = bflo(aw[1]) * sigmoidf_(bflo(gw[1])); u0[3] = bfhi(aw[1]) * sigmoidf_(bfhi(gw[1]));
                u1[0] = bflo(aw[2]) * sigmoidf_(bflo(gw[2])); u1[1] = bfhi(aw[2]) * sigmoidf_(bfhi(gw[2])); u1[2] = bflo(aw[3]) * sigmoidf_(bflo(gw[3])); u1[3] = bfhi(aw[3]) * sigmoidf_(bfhi(gw[3]));
                *(LAS f32x4*)(UB + rr * 512 + ch * 8) = u0; *(LAS f32x4*)(UB + rr * 512 + ch * 8 + 4) = u1; } }
        __syncthreads();
        if (it + G < nitems) conf_load(R, Z, it + G, tid);
#pragma unroll
        for (int g8 = 0; g8 < 2; ++g8) {
            float win[38];
#pragma unroll
            for (int i = 0; i < 38; ++i) win[i] = UB[(g8 * 8 + i) * 512 + c];
#pragma unroll
            for (int r = 0; r < 8; ++r) { float y = bias;
#pragma unroll
                for (int j = 0; j < 31; ++j) y += w[j] * win[r + j];
                YB[(g8 * 8 + r) * 512 + c] = y; }
        }
        __syncthreads();
#pragma unroll
        for (int q = 0; q < 2; ++q) { const int t = 2 * wave + q;
            f32x4 y0 = *(const LAS f32x4*)(YB + t * 512 + 8 * lane), y1 = *(const LAS f32x4*)(YB + t * 512 + 8 * lane + 4);
            const float mean = wave_sum((y0[0] + y0[1]) + (y0[2] + y0[3]) + (y1[0] + y1[1]) + (y1[2] + y1[3])) * (1.0f / 512.0f);
            y0 = y0 - mean; y1 = y1 - mean;
            const float rstd = rsqrtf(wave_sum(dot4(y0) + dot4(y1)) * (1.0f / 512.0f) + EPS);
            y0 = y0 * rstd * g0 + b0; y1 = y1 * rstd * g1 + b1;
            u32x4 o; o.x = cvt_pk_bf16(siluf_(y0[0]), siluf_(y0[1])); o.y = cvt_pk_bf16(siluf_(y0[2]), siluf_(y0[3])); o.z = cvt_pk_bf16(siluf_(y1[0]), siluf_(y1[1])); o.w = cvt_pk_bf16(siluf_(y1[2]), siluf_(y1[3]));
            *(u32x4*)((bf16_t*)(P.ws + WS_MIX) + (size_t)(r0 + t) * DM + 512 + 8 * lane) = o; }
        __syncthreads();
    }
}
__device__ __forceinline__ void sconv_item(const Params& P, int layer, int item, int tid) {
    const bf16_t* Z = (const bf16_t*)(P.ws + WS_Z);
    const int row = item * 16 + (tid >> 5);
    const int s0 = row < ML ? (row & ~(SEQ - 1)) : ML + ((row - ML) & ~(CTX - 1)), s1 = s0 + (row < ML ? SEQ : CTX);
#pragma unroll
    for (int q = 0; q < 2; ++q) {
        const int c0 = ((tid & 31) + 32 * q) * 8;
        float acc[8];
#pragma unroll
        for (int i = 0; i < 8; ++i) acc[i] = 0.f;
#pragma unroll
        for (int j = 0; j < 3; ++j) { const int rr = row + j - 1;
            if (rr >= s0 && rr < s1) { const u32x4 cg = *(const u32x4*)(Z + (size_t)rr * INWP + ZSC + c0), hh = *(const u32x4*)(Z + (size_t)rr * INWP + ZSH + c0);
                const float* wp = P.sc_dw + ((size_t)layer * 3 + j) * 512 + c0; const f32x4 w0 = *(const f32x4*)wp, w1 = *(const f32x4*)(wp + 4);
                const unsigned cw[4] = {cg.x, cg.y, cg.z, cg.w}, hw[4] = {hh.x, hh.y, hh.z, hh.w};
#pragma unroll
                for (int i = 0; i < 4; ++i) { const float wa = i < 2 ? w0[2 * i] : w1[2 * i - 4], wb = i < 2 ? w0[2 * i + 1] : w1[2 * i - 3];
                    acc[2 * i] += wa * bflo(cw[i]) * bflo(hw[i]); acc[2 * i + 1] += wb * bfhi(cw[i]) * bfhi(hw[i]); } } }
        const u32x4 bg = *(const u32x4*)(Z + (size_t)row * INWP + ZSB + c0); const unsigned bw[4] = {bg.x, bg.y, bg.z, bg.w};
        u32x4 o; unsigned ow[4];
#pragma unroll
        for (int i = 0; i < 4; ++i) ow[i] = cvt_pk_bf16(bflo(bw[i]) * acc[2 * i], bfhi(bw[i]) * acc[2 * i + 1]);
        o.x = ow[0]; o.y = ow[1]; o.z = ow[2]; o.w = ow[3];
        *(u32x4*)((bf16_t*)(P.ws + WS_MIX) + (size_t)row * DM + 1024 + c0) = o;
    }
}

namespace att {
constexpr int NW = 8, QBLK = 32, KVBLK = 64;
constexpr float SCALE = 0.07216878364870322f;
constexpr float THR = 8.f;
constexpr int SHM_V = KVBLK * 128 * 2, SHM_K = KVBLK * 192 * 2;
constexpr int OFF_K = 2 * SHM_V, OFF_WS = OFF_K + 2 * SHM_K, OFF_QR = OFF_WS + 2048;
#define KSWZ(row, colB) ((row) * 384 + ((colB) ^ ((((row) >> 1) & 7) << 4)))
#define SBAR() __builtin_amdgcn_sched_barrier(0)
__device__ __forceinline__ int crow(int r, int hi) { return (r & 3) + 8 * (r >> 2) + 4 * hi; }
__device__ __forceinline__ void partialSM(f32x16& p0, f32x16& p1, float& m_reg, float& mn, float& alpha) {
    constexpr float C = SCALE * 1.4426950408889634f;
    float pmax = p0[0];
#pragma unroll
    for (int r = 1; r < 16; ++r) pmax = fmaxf(pmax, p0[r]);
#pragma unroll
    for (int r = 0; r < 16; ++r) pmax = fmaxf(pmax, p1[r]);
    { auto rr = __builtin_amdgcn_permlane32_swap(__float_as_uint(pmax), __float_as_uint(pmax), false, false);
      pmax = fmaxf(__uint_as_float(rr[0]), __uint_as_float(rr[1])); }
    if (__builtin_expect(__all(pmax - m_reg <= THR / SCALE), 1)) { mn = m_reg; alpha = 1.f; }
    else { mn = fmaxf(m_reg, pmax); alpha = __builtin_amdgcn_exp2f((m_reg - mn) * C); m_reg = mn; }
    const float mnC = -mn * C;
#pragma unroll
    for (int r = 0; r < 16; ++r) p0[r] = fmaf(p0[r], C, mnC);
#pragma unroll
    for (int r = 0; r < 16; ++r) p1[r] = fmaf(p1[r], C, mnC);
#pragma unroll
    for (int r = 0; r < 16; ++r) p0[r] = __builtin_amdgcn_exp2f(p0[r]);
}
__device__ __forceinline__ void finishSM(f32x16& p0, f32x16& p1, float alpha, float& l_reg, bf16x8& pa0, bf16x8& pa1, bf16x8& pa2, bf16x8& pa3) {
#pragma unroll
    for (int r = 0; r < 16; ++r) p1[r] = __builtin_amdgcn_exp2f(p1[r]);
    float ps = 0;
#pragma unroll
    for (int r = 0; r < 16; ++r) ps += p0[r];
#pragma unroll
    for (int r = 0; r < 16; ++r) ps += p1[r];
    { auto rr = __builtin_amdgcn_permlane32_swap(__float_as_uint(ps), __float_as_uint(ps), false, false);
      ps = __uint_as_float(rr[0]) + __uint_as_float(rr[1]); }
    l_reg = l_reg * alpha + ps;
#define PK4(Pv, BASE, OUT) do { unsigned a0 = cvt_pk_bf16(Pv[BASE + 0], Pv[BASE + 1]), a1 = cvt_pk_bf16(Pv[BASE + 2], Pv[BASE + 3]);   \
    unsigned b0 = cvt_pk_bf16(Pv[BASE + 4], Pv[BASE + 5]), b1 = cvt_pk_bf16(Pv[BASE + 6], Pv[BASE + 7]);                              \
    auto r0 = __builtin_amdgcn_permlane32_swap(a0, b0, false, false); auto r1 = __builtin_amdgcn_permlane32_swap(a1, b1, false, false); \
    u32x4 w = {r0[0], r1[0], r0[1], r1[1]}; OUT = *reinterpret_cast<bf16x8*>(&w); } while (0)
    PK4(p0, 0, pa0); PK4(p0, 8, pa1); PK4(p1, 0, pa2); PK4(p1, 8, pa3);
#undef PK4
}
__device__ __forceinline__ void qkt(f32x16& p0, f32x16& p1, const LAS unsigned char* Ks, const bf16x8* qr, const LAS unsigned char* qrp, int qsw, const int (&kq)[4], int hi) {
    p0 = f32x16{}; p1 = f32x16{};
#pragma unroll
    for (int d0 = 0; d0 < 12; ++d0) {
        const bf16x8 b0 = *(const LAS bf16x8*)(Ks + kq[d0 & 3] + 128 * (d0 >> 2));
        const bf16x8 b1 = *(const LAS bf16x8*)(Ks + kq[d0 & 3] + 128 * (d0 >> 2) + 32 * 384);
        bf16x8 qv; if (d0 < 8) qv = qr[d0]; else qv = *(const LAS bf16x8*)(qrp + (((2 * (d0 - 8) + hi) ^ qsw) << 4));
        p0 = __builtin_amdgcn_mfma_f32_32x32x16_bf16(b0, qv, p0, 0, 0, 0);
        p1 = __builtin_amdgcn_mfma_f32_32x32x16_bf16(b1, qv, p1, 0, 0, 0); }
}
__device__ __forceinline__ int v_st(int k, int c) { const int kk = (k & ~0xC) | ((k & 4) << 1) | ((k & 8) >> 1); return ((kk >> 3) * 4 + (c >> 5)) * 512 + ((kk & 7) * 32 + (c & 31)) * 2; }
__device__ __forceinline__ int v_rd_base(int lane) { return ((lane & 3) << 3) | (((lane >> 2) & 3) << 6) | (((lane >> 4) & 1) << 5) | (((lane >> 5) & 1) << 8); }
constexpr int v_rd_off(int d0, int ks, int half) { return d0 * 512 + ks * 4096 + half * 2048; }
template <int OFF> __device__ __forceinline__ s16x4 tr_read(int vb) {
    s16x4 r; asm volatile("ds_read_b64_tr_b16 %0, %1 offset:%2" : "=&v"(r) : "v"(vb), "i"(OFF) : "memory"); return r;
}
template <int D0> __device__ __forceinline__ void pv_one(f32x16& od, int vb, bf16x8 pa0, bf16x8 pa1, bf16x8 pa2, bf16x8 pa3) {
    const s16x4 l0 = tr_read<v_rd_off(D0, 0, 0)>(vb), h0 = tr_read<v_rd_off(D0, 0, 1)>(vb), l1 = tr_read<v_rd_off(D0, 1, 0)>(vb), h1 = tr_read<v_rd_off(D0, 1, 1)>(vb);
    const s16x4 l2 = tr_read<v_rd_off(D0, 2, 0)>(vb), h2 = tr_read<v_rd_off(D0, 2, 1)>(vb), l3 = tr_read<v_rd_off(D0, 3, 0)>(vb), h3 = tr_read<v_rd_off(D0, 3, 1)>(vb);
    asm volatile("s_waitcnt lgkmcnt(0)" ::: "memory"); SBAR();
#define PK(Lo, Hi) (bf16x8){Lo[0], Lo[1], Lo[2], Lo[3], Hi[0], Hi[1], Hi[2], Hi[3]}
    od = __builtin_amdgcn_mfma_f32_32x32x16_bf16(pa0, PK(l0, h0), od, 0, 0, 0);
    od = __builtin_amdgcn_mfma_f32_32x32x16_bf16(pa1, PK(l1, h1), od, 0, 0, 0);
    od = __builtin_amdgcn_mfma_f32_32x32x16_bf16(pa2, PK(l2, h2), od, 0, 0, 0);
    od = __builtin_amdgcn_mfma_f32_32x32x16_bf16(pa3, PK(l3, h3), od, 0, 0, 0);
#undef PK
}
__device__ __forceinline__ void pv_d0(f32x16* o, int vb, bf16x8 pa0, bf16x8 pa1, bf16x8 pa2, bf16x8 pa3) {
    pv_one<0>(o[0], vb, pa0, pa1, pa2, pa3); pv_one<1>(o[1], vb, pa0, pa1, pa2, pa3); pv_one<2>(o[2], vb, pa0, pa1, pa2, pa3); pv_one<3>(o[3], vb, pa0, pa1, pa2, pa3);
}
template <bool DIRECT>
__device__ __forceinline__ void attn_unit(LAS unsigned char* lds, const bf16_t* QKV, const bf16_t* Z, int qrow0, int h, int crow0, int lrow0, int t0, int NT,
                                          float* Opart, float* Lse, bf16_t* MIX, const int tid) {
    const int wid = tid >> 6, lane = tid & 63, r32 = lane & 31, hi = lane >> 5;
    LAS unsigned char* V_lds = lds; LAS unsigned char* K_lds = lds + OFF_K;
    LAS float* ws = (LAS float*)(lds + OFF_WS) + wid * 64; LAS float* li_l = ws; LAS float* al_l = ws + 32;
    float m_reg = -1e30f, l_reg = 0; f32x16 o[4] = {}; bf16x8 qr[8];
    const bf16_t* Qw = QKV + (size_t)(qrow0 + wid * QBLK + r32) * NUP + h * 192 + hi * 8;
#pragma unroll
    for (int d0 = 0; d0 < 8; ++d0) qr[d0] = *(const bf16x8*)(Qw + d0 * 16);
    LAS unsigned char* qrp = lds + OFF_QR + wid * 4096 + r32 * 128; const int qsw = (r32 >> 1) & 7;
    int kq[4];
#pragma unroll
    for (int q = 0; q < 4; ++q) kq[q] = 384 * r32 + (((2 * q + hi) ^ qsw) << 4);
#pragma unroll
    for (int d0 = 8; d0 < 12; ++d0) *(LAS bf16x8*)(qrp + (((2 * (d0 - 8) + hi) ^ qsw) << 4)) = *(const bf16x8*)(Qw + d0 * 16);
    const int sr = tid >> 4, sc = (tid & 15) * 8;
    const int vst0 = v_st(sr, sc);
    const int kst0 = KSWZ(sr, sc * 2);
    const int krst = KSWZ(tid >> 3, 256 + (tid & 7) * 16);
    const unsigned voffV = (unsigned)(sr * NUP + sc) * 2u, voffR = (unsigned)((tid >> 3) * INWP + (tid & 7) * 8) * 2u;
    const char* Vb = (const char*)(QKV + 768 + h * 256 + 128); const char* Kb = (const char*)(QKV + 768 + h * 256); const char* Rb = (const char*)(Z + ZKR);
    const int vb0 = (int)(uintptr_t)V_lds + v_rd_base(lane);
    bf16x8 vs0, vs1, ks0, ks1, ks2;
#define ROW0(kt) (((t0) + (kt)) < 4 ? crow0 + 64 * ((t0) + (kt)) : lrow0 + 64 * ((t0) + (kt) - 4))
#define SLOADV(kt) do { const size_t _r0 = (size_t)__builtin_amdgcn_readfirstlane(ROW0(kt)); const char* _v = Vb + _r0 * (NUP * 2) + voffV; \
    vs0 = *(const bf16x8*)(_v); vs1 = *(const bf16x8*)(_v + 32 * NUP * 2); } while (0)
#define SLOADK(kt) do { const size_t _r0 = (size_t)__builtin_amdgcn_readfirstlane(ROW0(kt)); const char* _k = Kb + _r0 * (NUP * 2) + voffV; \
    ks0 = *(const bf16x8*)(_k); ks1 = *(const bf16x8*)(_k + 32 * NUP * 2); ks2 = *(const bf16x8*)(Rb + _r0 * (INWP * 2) + voffR); } while (0)
#define SLOAD(kt) do { SLOADV(kt); SLOADK(kt); } while (0)
#define SWRITE(b) do { *(LAS bf16x8*)(V_lds + (b) * SHM_V + vst0) = vs0; *(LAS bf16x8*)(V_lds + (b) * SHM_V + vst0 + 8192) = vs1; \
    *(LAS bf16x8*)(K_lds + (b) * SHM_K + kst0) = ks0; *(LAS bf16x8*)(K_lds + (b) * SHM_K + kst0 + 32 * 384) = ks1; *(LAS bf16x8*)(K_lds + (b) * SHM_K + krst) = ks2; } while (0)
#define SWAIT() asm volatile("s_waitcnt vmcnt(0)" ::: "memory")
#define RESC(a) do { if (__any((a) < 1.f)) { if (hi == 0) al_l[r32] = (a); asm volatile("s_waitcnt lgkmcnt(0)" ::: "memory"); \
    _Pragma("unroll") for (int d = 0; d < 4; ++d) _Pragma("unroll") for (int r = 0; r < 16; ++r) o[d][r] *= al_l[crow(r, hi)]; } } while (0)
    f32x16 pA0, pA1, pB0, pB1; float mnA, mnB, alA, alB; bf16x8 pa0, pa1, pa2, pa3;
    SLOAD(0); SWAIT(); SWRITE(0); __syncthreads();
    qkt(pA0, pA1, K_lds, qr, qrp, qsw, kq, hi); partialSM(pA0, pA1, m_reg, mnA, alA);
    SLOAD(1);
    SWAIT(); SWRITE(1); __syncthreads();
    if (2 < NT) SLOAD(2);
    for (int j = 1; j + 1 < NT; j += 2) {
        SBAR(); qkt(pB0, pB1, K_lds + SHM_K, qr, qrp, qsw, kq, hi);
        finishSM(pA0, pA1, alA, l_reg, pa0, pa1, pa2, pa3); SBAR();
        pv_d0(o, vb0, pa0, pa1, pa2, pa3); partialSM(pB0, pB1, m_reg, mnB, alB);
        __syncthreads(); SWAIT(); SWRITE(0); SBAR(); SLOAD(j + 2); SBAR();
        RESC(alB); __syncthreads();
        SBAR(); qkt(pA0, pA1, K_lds, qr, qrp, qsw, kq, hi);
        finishSM(pB0, pB1, alB, l_reg, pa0, pa1, pa2, pa3); SBAR();
        pv_d0(o, vb0 + SHM_V, pa0, pa1, pa2, pa3); partialSM(pA0, pA1, m_reg, mnA, alA);
        __syncthreads(); SWAIT(); SWRITE(1); SBAR(); if (j + 3 < NT) SLOAD(j + 3); SBAR();
        RESC(alA); __syncthreads();
    }
    SBAR(); qkt(pB0, pB1, K_lds + SHM_K, qr, qrp, qsw, kq, hi);
    finishSM(pA0, pA1, alA, l_reg, pa0, pa1, pa2, pa3); SBAR();
    pv_d0(o, vb0, pa0, pa1, pa2, pa3); partialSM(pB0, pB1, m_reg, mnB, alB);
    __syncthreads(); RESC(alB);
    finishSM(pB0, pB1, alB, l_reg, pa0, pa1, pa2, pa3); SBAR();
    pv_d0(o, vb0 + SHM_V, pa0, pa1, pa2, pa3);
    if (hi == 0) li_l[r32] = l_reg; asm volatile("s_waitcnt lgkmcnt(0)" ::: "memory");
    float rli[16];
#pragma unroll
    for (int r = 0; r < 16; ++r) rli[r] = __builtin_amdgcn_rcpf(li_l[crow(r, hi)]);
    const int qw0 = qrow0 + wid * QBLK;
    if constexpr (DIRECT) {
#pragma unroll
        for (int r = 0; r < 16; ++r) { const int orow = crow(r, hi);
#pragma unroll
            for (int d0 = 0; d0 < 4; ++d0) MIX[(size_t)(qw0 + orow) * DM + 1536 + h * 128 + d0 * 32 + r32] = f2bf(o[d0][r] * rli[r]); }
    } else {
#pragma unroll
        for (int r = 0; r < 16; ++r) { const int orow = crow(r, hi);
#pragma unroll
            for (int d0 = 0; d0 < 4; ++d0) Opart[(size_t)(qw0 + orow) * 512 + h * 128 + d0 * 32 + r32] = o[d0][r] * rli[r]; }
        if (hi == 0) Lse[(size_t)(qw0 + r32) * 4 + h] = m_reg * (SCALE * 1.4426950408889634f) + __builtin_amdgcn_logf(l_reg);
    }
    __syncthreads();
#undef ROW0
#undef SLOAD
#undef SWRITE
#undef SWAIT
#undef RESC
}
#undef KSWZ
#undef SBAR
}

__device__ __forceinline__ void attn_combine(const Params& P, int tid, int G, int bid) {
    const float* OP = (const float*)(P.ws + WS_OP); const float* LS = (const float*)(P.ws + WS_LSE); bf16_t* MIX = (bf16_t*)(P.ws + WS_MIX);
    for (int i = bid * 512 + tid; i < ML * 64; i += G * 512) {
        const int row = i >> 6, rem = i & 63, h = rem >> 4, cg = (rem & 15) * 8;
        const float l1 = LS[(size_t)row * 4 + h], l2 = LS[((size_t)ML + row) * 4 + h], m = fmaxf(l1, l2);
        float w1 = __builtin_amdgcn_exp2f(l1 - m), w2 = __builtin_amdgcn_exp2f(l2 - m); const float inv = 1.0f / (w1 + w2); w1 *= inv; w2 *= inv;
        const float* a = OP + (size_t)row * 512 + h * 128 + cg; const float* b = OP + ((size_t)ML + row) * 512 + h * 128 + cg;
        const f32x4 a0 = *(const f32x4*)a, a1 = *(const f32x4*)(a + 4), b0 = *(const f32x4*)b, b1 = *(const f32x4*)(b + 4);
        const f32x4 o0 = a0 * w1 + b0 * w2, o1 = a1 * w1 + b1 * w2;
        u32x4 w; w.x = cvt_pk_bf16(o0[0], o0[1]); w.y = cvt_pk_bf16(o0[2], o0[3]); w.z = cvt_pk_bf16(o1[0], o1[1]); w.w = cvt_pk_bf16(o1[2], o1[3]);
        *(u32x4*)(MIX + (size_t)row * DM + 1536 + h * 128 + cg) = w;
    }
}

constexpr int PH_PER_LAYER = 9, N_PHASES = 2 + DEPTH * PH_PER_LAYER + 1;
typedef const __attribute__((address_space(4))) Params* KParams;
__global__ void __launch_bounds__(512, 2) mk_fwd(Params Pk) {
    extern __shared__ __attribute__((aligned(16))) unsigned char lds_raw[];
    LAS unsigned char* lds = (LAS unsigned char*)lds_raw;
    const int G = gridDim.x, bid = blockIdx.x;
    KParams kp0 = (KParams)__builtin_amdgcn_kernarg_segment_ptr();
    const int wave0 = __builtin_amdgcn_readfirstlane(threadIdx.x >> 6);
#define OPQ int tid; asm volatile("v_mbcnt_lo_u32_b32 %0, -1, 0\n\tv_mbcnt_hi_u32_b32 %0, -1, %0" : "=v"(tid)); tid |= wave0 << 6; const int lane = tid & 63, wave = __builtin_amdgcn_readfirstlane(tid >> 6); (void)lane; (void)wave; \
    KParams kp = kp0; asm volatile("" : "+s"(kp)); Params P; {   \
      const GAS float* const __attribute__((address_space(4)))* _q = (const GAS float* const __attribute__((address_space(4)))*)kp; const float** _d = (const float**)&P; \
      _Pragma("unroll") for (int _i = 0; _i < 28; ++_i) _d[_i] = (const float*)_q[_i]; P.ph_lo = kp->ph_lo; P.ph_hi = kp->ph_hi; } \
    unsigned char* const ws = P.ws; (void)ws;
    volatile LAS unsigned* MISC = (volatile LAS unsigned*)(lds + LDS_MISC);
    for (int u = threadIdx.x; u < 256; u += 512) ((LAS unsigned*)(lds + LDS_MISC))[u] = 0u;
    __syncthreads();
    const int lo = kp0->ph_lo, hi = kp0->ph_hi;
    XcdBarrier bar; bar.bar = (unsigned*)(kp0->ws + WS_CTL) + 1024; bar.x = 0; bar.st = nullptr;
    if (hi - lo > 1) bar = xcd_barrier_post((unsigned*)(kp0->ws + WS_CTL) + 1024, MISC + 8);
#define IN(k) (lo <= (k) && (k) < hi)
#ifndef PROBE_WG
#define PROBE_WG 0
#endif
#ifndef PROBE_SEAM
#define PROBE_SEAM -1
#endif
    unsigned long long bwait = 0;
#define SEAM(k) do { if (IN(k) && IN((k) + 1)) { unsigned long long _t0 = 0; if (PROBE_ID == 22) _t0 = __builtin_amdgcn_s_memrealtime(); xcd_barrier(bar); if (PROBE_ID == 22 && (PROBE_SEAM < 0 || ((k) >= 2 && ((k) - 2) % 9 == PROBE_SEAM))) bwait += __builtin_amdgcn_s_memrealtime() - _t0; if (PROBE_ID == 21) xcd_barrier(bar); } } while (0)
#define XRES ((float*)(ws + WS_XRES))
#define MODL ((const float*)(ws + WS_MODV) + (size_t)layer * 3 * 6 * DM)
#define RSTAT ((float*)(ws + WS_RSTAT) + (size_t)layer * MT * 2)
#define ROPE ((const f32x2*)(ws + WS_ROPE))
#define HB ((bf16_t*)(ws + WS_H))
#define ZB ((bf16_t*)(ws + WS_Z))
#define QKVB ((bf16_t*)(ws + WS_QKV))
#define MIXB ((bf16_t*)(ws + WS_MIX))
#define UB_ ((bf16_t*)(ws + WS_U))
#define SLAB ((float*)(ws + WS_GU))

    for (int rp = 0; rp < PREP(1); ++rp) { if (PHM(0) && IN(0)) { OPQ phase_p0a(P, lds, tid, lane, wave, G, bid); } if (rp + 1 < PREP(1)) { __syncthreads(); } } SEAM(0);
    if (PHM(1) && IN(1)) { OPQ phase_p0b(P, tid, G, bid); } SEAM(1);

    for (int layer = 0; layer < DEPTH; ++layer) {
        const int pb = 2 + layer * PH_PER_LAYER;
        const bool need_ctx = layer < DEPTH - 1;
        const int mrows = need_ctx ? MT : ML;

        for (int rp = 0; rp < PREP(3); ++rp) if (PHM(2) && IN(pb + 0)) { OPQ
            const float* xl = layer == 0 ? P.x : XRES; const float* xc = layer == 0 ? P.ctx : XRES + (size_t)ML * DM;
            phase_norm(lds, xl, xc, MODL, 1, 0, HB, true, SLAB, layer == 0 ? 0 : 11, MODL - (size_t)3 * 6 * DM + ((size_t)2 * 6 + 5) * DM, XRES + (size_t)ML * DM, tid, lane, wave, G, bid); } SEAM(pb + 0);
        for (int rp = 0; rp < PREP(5); ++rp) if (PHM(3) && IN(pb + 1)) { OPQ
            pg8::Gemm g{HB, (const bf16_t*)(ws + WS_WIN) + (size_t)layer * INWP * DM, MT, INWP, DM, DM, DM}; pg8::StaticOrder S; S.init(MT, INWP, DM, G, bid);
            pg8::EpiIn E{ZB, rp == 0 ? RSTAT : (float*)(ws + WS_OP), ROPE};
            pg8::gemm_phase<pg8::EpiIn, pg8::StaticOrder>(lds, g, S, E, tid);
        } SEAM(pb + 1);
        for (int rp = 0; rp < PREP(2); ++rp) {
        for (int rq = 0; rq < PREP(8); ++rq) if (IN(pb + 2)) { OPQ
            for (int r2 = 0; r2 < PREP(16); ++r2) if (PHM(4)) {
                pg8::Gemm g{ZB + ZCQ, (const bf16_t*)(ws + WS_WUP) + (size_t)layer * NUP * KUP, MT, NUP, KUP, INWP, KUP}; pg8::StaticOrder S; S.init(MT, NUP, KUP, G, bid);
                pg8::EpiUp E{QKVB, RSTAT, ROPE};
                pg8::gemm_phase<pg8::EpiUp, pg8::StaticOrder>(lds, g, S, E, tid);
            }
            const int nup_units = (MT / 256) * (NUP / 256);
            int start = bid - (nup_units % G); if (start < 0) start += G;
            for (int r2 = 0; r2 < PREP(11); ++r2) if (PHM(5)) gla_g1_loop(lds, P, layer, start, 2 * 4 * NCH, G, tid, lane, wave);
        } SEAM(pb + 2);
        for (int rq = 0; rq < PREP(9); ++rq) if (IN(pb + 3)) { OPQ
            for (int r2 = 0; r2 < PREP(14); ++r2) if (PHM(8)) gla_g2(P, tid, G, bid);
            for (int r2 = 0; r2 < PREP(13); ++r2) if (PHM(9)) for (int u = bid; u < 256; u += G) {
                const int bh = u & 7, sub = u >> 3, b = bh >> 2, h = bh & 3, qb = sub >> 1, half = sub & 1;
                att::attn_unit<false>(lds, QKVB, ZB, b * SEQ + qb * 256, h, ML + b * CTX, b * SEQ, half * 34, 34,
                                      (float*)(ws + WS_OP) + (size_t)half * ML * 512, (float*)(ws + WS_LSE) + (size_t)half * ML * 4, MIXB, tid);
            }
        } SEAM(pb + 3);
        for (int rq = 0; rq < PREP(10); ++rq) if (IN(pb + 4)) {
            const int n3 = need_ctx ? 8 * NCH : 8 * (NCH - 4), ncv = need_ctx ? MT / 16 : ML / 16;
#define FIRST_OF(base) (((((int)bid) - (base)) % G + G) % G)
            { OPQ
            for (int r2 = 0; r2 < PREP(15); ++r2) if (PHM(10)) gla_g3_loop(lds, P, layer, (8 * NCH - n3) + FIRST_OF(0), 8 * NCH, G, tid, lane, wave);
            }
            { OPQ
            for (int r2 = 0; r2 < PREP(12); ++r2) if (PHM(6)) conf_loop(lds, P, layer, FIRST_OF(n3), ncv, G, tid, lane, wave);
            }
            { OPQ
            for (int r2 = 0; r2 < PREP(17); ++r2) if (PHM(7)) for (int it = FIRST_OF(n3 + ncv); it < ncv; it += G) sconv_item(P, layer, it, tid);
            for (int r2 = 0; r2 < PREP(18); ++r2) if (PHM(11)) attn_combine(P, tid, G, bid);
            }
            { OPQ
            if (PHM(12) && need_ctx) {
                for (int u = FIRST_OF(n3 + 2 * ncv); u < 8; u += G) { const int b = u >> 2, h = u & 3;
                    att::attn_unit<true>(lds, QKVB, ZB, ML + b * CTX, h, ML + b * CTX, 0, 0, 4, nullptr, nullptr, MIXB, tid); }
            }
            }
#undef FIRST_OF
        } SEAM(pb + 4);
        }
        for (int rp = 0; rp < PREP(6); ++rp) if (PHM(13) && IN(pb + 5)) { OPQ
            const float* xl = layer == 0 ? P.x : XRES; const float* xc = layer == 0 ? P.ctx : XRES + (size_t)ML * DM;
            pg8::Gemm g{MIXB, (const bf16_t*)(ws + WS_WOUT) + (size_t)layer * DM * DM, MT, DM, DM, DM, DM}; pg8::ResOrder S; S.init(DM, need_ctx ? 8 : 0, G, bid);
            pg8::EpiResSlab E{pg8::EpiRes{xl, xc, rp == 0 ? XRES : (float*)(ws + WS_OP), MODL + 2 * DM}, pg8::EpiSlab{SLAB}};
            pg8::gemm_phase<pg8::EpiResSlab, pg8::ResOrder>(lds, g, S, E, tid);
        } SEAM(pb + 5);
        for (int rp = 0; rp < PREP(3); ++rp) if (PHM(2) && IN(pb + 6)) { OPQ
            const float* xc = layer == 0 ? P.ctx : XRES + (size_t)ML * DM;
            phase_norm(lds, XRES, xc, MODL, 4, 3, HB, need_ctx, SLAB, 8, MODL + ((size_t)2 * 6 + 2) * DM, XRES + (size_t)ML * DM, tid, lane, wave, G, bid); } SEAM(pb + 6);
        for (int rp = 0; rp < PREP(4); ++rp) if (PHM(14) && IN(pb + 7)) { OPQ
            pg8::Gemm g{HB, (const bf16_t*)(ws + WS_W13) + (size_t)layer * 2 * DFF * DM, mrows, 2 * DFF, DM, DM, DM}; pg8::StaticOrder S; S.init(mrows, 2 * DFF, DM, G, bid);
            pg8::EpiSwiglu E{UB_};
            pg8::gemm_phase<pg8::EpiSwiglu, pg8::StaticOrder>(lds, g, S, E, tid);
        } SEAM(pb + 7);
        for (int rp = 0; rp < PREP(7); ++rp) if (PHM(15) && IN(pb + 8)) { OPQ
            pg8::Gemm g{UB_, (const bf16_t*)(ws + WS_W2) + (size_t)layer * DM * DFF, MT, DM, DFF, DFF, DFF}; pg8::ResOrder S; S.init(DFF, need_ctx ? 11 : 0, G, bid);
            pg8::EpiResSlab E{pg8::EpiRes{XRES, XRES + (size_t)ML * DM, rp == 0 ? XRES : (float*)(ws + WS_OP), MODL + 5 * DM}, pg8::EpiSlab{SLAB}};
            pg8::gemm_phase<pg8::EpiResSlab, pg8::ResOrder>(lds, g, S, E, tid);
        } SEAM(pb + 8);
    }
    if (PHM(16) && IN(N_PHASES - 1)) { OPQ phase_final(XRES, P.final_g, P.out, lane, wave, G, bid); }
    if (PROBE_ID == 22 && bid == PROBE_WG) { const unsigned long long t0 = __builtin_amdgcn_s_memrealtime(); while (__builtin_amdgcn_s_memrealtime() - t0 < bwait) __builtin_amdgcn_s_sleep(8); }
#undef IN
#undef SEAM
}

extern "C" void kernel_launch(void* const* d_in, const int* in_sizes, int n_in, void* d_out, int out_size, void* d_ws, size_t ws_size, hipStream_t stream) {
    static int grid = 0;
    if (grid == 0) {
        if (n_in != 26 || in_sizes[0] != ML * DM || out_size != ML * DM || ws_size < WS_END) {
            fprintf(stderr, "kernel_launch: shape mismatch: n_in %d in0 %d out %d ws %zu (need %zu); nothing launched\n", n_in, n_in > 0 ? in_sizes[0] : -1, out_size, ws_size, (size_t)WS_END); grid = -1; return; }
        int dev = 0, cus = 0, per_cu = 0;
        if (hipGetDevice(&dev) != hipSuccess || hipDeviceGetAttribute(&cus, hipDeviceAttributeMultiprocessorCount, dev) != hipSuccess) { fprintf(stderr, "kernel_launch: device query failed\n"); grid = -1; return; }
        if (hipFuncSetAttribute((const void*)mk_fwd, hipFuncAttributeMaxDynamicSharedMemorySize, LDS_BYTES) != hipSuccess) { fprintf(stderr, "kernel_launch: hipFuncSetAttribute failed\n"); grid = -1; return; }
        if (hipOccupancyMaxActiveBlocksPerMultiprocessor(&per_cu, (const void*)mk_fwd, 512, LDS_BYTES) != hipSuccess || per_cu < 1)
            fprintf(stderr, "kernel_launch: note: occupancy query reports %d workgroups per CU\n", per_cu);
        (void)hipGetLastError();
        grid = cus;
    }
    if (grid < 0) return;
    if (hipMemsetAsync((char*)d_ws + WS_CTL, 0, CTL_BYTES, stream) != hipSuccess) { fprintf(stderr, "kernel_launch: memset failed\n"); return; }
    Params p{};
    const float** pp = (const float**)&p;
    for (int i = 0; i < 26; ++i) pp[i] = (const float*)d_in[i];
    p.out = (float*)d_out; p.ws = (unsigned char*)d_ws;
#if MK_MULTI
    for (int ph = 0; ph < N_PHASES; ++ph) { p.ph_lo = ph; p.ph_hi = ph + 1; hipLaunchKernelGGL(mk_fwd, dim3(grid), dim3(512), LDS_BYTES, stream, p); }
#else
    p.ph_lo = 0; p.ph_hi = N_PHASES;
    hipLaunchKernelGGL(mk_fwd, dim3(grid), dim3(512), LDS_BYTES, stream, p);
#endif
    const hipError_t le = hipPeekAtLastError();
    if (le != hipSuccess) fprintf(stderr, "kernel_launch: launch failed: %s\n", hipGetErrorName(le));
}
```
